# Optimizing an MI355X kernel written in HIP

```python
import jax, jax.numpy as jnp
from jax import lax
import numpy as np

D_MODEL = 1024
BATCH = 2
SEQ = 8192
DEPTH = 2

MIX_WIDTH = D_MODEL
HGRN_WIDTH = D_MODEL // 2
HGRN_EXPAND = 128
HGRN_HEADS = HGRN_WIDTH // HGRN_EXPAND
HGRN_DV = HGRN_WIDTH // HGRN_HEADS
HGRN_CHUNK = 64
FOX_WIDTH = MIX_WIDTH - HGRN_WIDTH
FOX_HEAD_DIM = 64
FOX_HEADS = FOX_WIDTH // FOX_HEAD_DIM
Q_BLOCK = 128
D_FF = 4 * D_MODEL
NORM_EPS = 1e-6
SPLIT_SIZES = (HGRN_WIDTH, HGRN_WIDTH, HGRN_WIDTH, HGRN_WIDTH,
               FOX_WIDTH, FOX_WIDTH, FOX_WIDTH, FOX_HEADS)
IN_COLS = sum(SPLIT_SIZES)
SPLIT_POINTS = tuple(int(v) for v in np.cumsum(SPLIT_SIZES)[:-1])

kernel_name = "hymba_hgrn2_fox_hybrid"


def rms_norm(x, w):
    xf = x.astype(jnp.float32)
    y = xf * lax.rsqrt(jnp.mean(xf * xf, axis=-1, keepdims=True) + NORM_EPS)
    return (y * w.astype(jnp.float32)).astype(x.dtype)


def layer_lower_bounds(lower_bounds):
    p = jax.nn.softmax(lower_bounds.astype(jnp.float32), axis=0)
    c = jnp.cumsum(p, axis=0)
    return c - c[0:1]


def hgrn2_mixer(q, f_pre, i_in, g, lb, norm_w):
    B, S, _ = q.shape
    nc = S // HGRN_CHUNK
    f = lb + (1.0 - lb) * jax.nn.sigmoid(f_pre.astype(jnp.float32))
    log_f = jnp.log(f)
    k = 1.0 - f
    qf = q.astype(jnp.float32) * (HGRN_EXPAND ** -0.5)
    vf = i_in.astype(jnp.float32)

    def to_chunks(t, d):
        t = t.reshape(B, nc, HGRN_CHUNK, HGRN_HEADS, d)
        return jnp.transpose(t, (1, 0, 3, 2, 4))

    qc = to_chunks(qf, HGRN_EXPAND)
    kc = to_chunks(k, HGRN_EXPAND)
    vc = to_chunks(vf, HGRN_DV)
    lfc = to_chunks(log_f, HGRN_EXPAND)
    causal = jnp.tril(jnp.ones((HGRN_CHUNK, HGRN_CHUNK), dtype=bool))

    def step(state, inp):
        qb, kb, vb, lfb = inp
        b = jnp.cumsum(lfb, axis=2)
        inter = jnp.einsum('bhtk,bhkv->bhtv', qb * jnp.exp(b), state)
        diff = b[:, :, :, None, :] - b[:, :, None, :, :]
        decay = jnp.exp(jnp.where(causal[None, None, :, :, None], diff, -jnp.inf))
        a = jnp.einsum('bhtk,bhsk,bhtsk->bhts', qb, kb, decay)
        intra = jnp.einsum('bhts,bhsv->bhtv', a, vb)
        b_last = b[:, :, -1:, :]
        new_state = (jnp.exp(b_last[:, :, 0, :])[..., None] * state
                     + jnp.einsum('bhsk,bhsv->bhkv', kb * jnp.exp(b_last - b), vb))
        return new_state, inter + intra

    s0 = jnp.zeros((B, HGRN_HEADS, HGRN_EXPAND, HGRN_DV), jnp.float32)
    _, o = lax.scan(step, s0, (qc, kc, vc, lfc))
    o = jnp.transpose(o, (1, 0, 3, 2, 4)).reshape(B, S, HGRN_HEADS, HGRN_DV)
    o = rms_norm(o, norm_w)
    gate = jax.nn.silu(g.astype(jnp.float32)).reshape(B, S, HGRN_HEADS, HGRN_DV)
    return (o * gate).reshape(B, S, HGRN_WIDTH).astype(q.dtype)


def fox_mixer(q, k, v, f_logit, f_bias, q_norm_w, k_norm_w):
    B, S, _ = q.shape

    def heads(t):
        return jnp.transpose(t.reshape(B, S, FOX_HEADS, FOX_HEAD_DIM), (0, 2, 1, 3)).astype(jnp.float32)

    qh = rms_norm(heads(q), q_norm_w) * (FOX_HEAD_DIM ** -0.5)
    kh = rms_norm(heads(k), k_norm_w)
    vh = heads(v)
    log_f = jax.nn.log_sigmoid(f_logit.astype(jnp.float32) + f_bias.astype(jnp.float32))
    c = jnp.cumsum(jnp.transpose(log_f, (0, 2, 1)), axis=-1)
    kpos = jnp.arange(S)

    def block(bi):
        start = bi * Q_BLOCK
        qb = lax.dynamic_slice_in_dim(qh, start, Q_BLOCK, axis=2)
        cb = lax.dynamic_slice_in_dim(c, start, Q_BLOCK, axis=2)
        s = jnp.einsum('bhqd,bhkd->bhqk', qb, kh) + (cb[..., :, None] - c[..., None, :])
        qpos = start + jnp.arange(Q_BLOCK)
        mask = kpos[None, :] <= qpos[:, None]
        p = jax.nn.softmax(jnp.where(mask[None, None], s, -jnp.inf), axis=-1)
        return jnp.einsum('bhqk,bhkd->bhqd', p, vh)

    o = lax.map(block, jnp.arange(S // Q_BLOCK))
    o = jnp.transpose(o, (1, 0, 3, 2, 4)).reshape(B, S, FOX_WIDTH)
    return o.astype(q.dtype)


def setup_inputs(seed: int = 0) -> dict:
    key = jax.random.key(seed)
    ks = jax.random.split(key, 12)
    f32 = jnp.float32
    x = jax.random.normal(ks[0], (BATCH, SEQ, D_MODEL), f32)
    lower_bounds = 0.1 * jax.random.normal(ks[1], (DEPTH, HGRN_WIDTH), f32)
    norm1_w = 1.0 + 0.02 * jax.random.normal(ks[2], (DEPTH, D_MODEL), f32)
    w_in = jax.random.normal(ks[3], (DEPTH, D_MODEL, IN_COLS), f32) * D_MODEL ** -0.5
    fox_f_bias = jax.random.uniform(ks[4], (DEPTH, FOX_HEADS), f32, minval=0.0, maxval=3.0)
    q_norm_w = 1.0 + 0.02 * jax.random.normal(ks[5], (DEPTH, FOX_HEAD_DIM), f32)
    k_norm_w = 1.0 + 0.02 * jax.random.normal(ks[6], (DEPTH, FOX_HEAD_DIM), f32)
    hgrn_norm_w = 1.0 + 0.02 * jax.random.normal(ks[7], (DEPTH, HGRN_DV), f32)
    w_out = jax.random.normal(ks[8], (DEPTH, MIX_WIDTH, D_MODEL), f32) * MIX_WIDTH ** -0.5
    norm2_w = 1.0 + 0.02 * jax.random.normal(ks[9], (DEPTH, D_MODEL), f32)
    w_up = jax.random.normal(ks[10], (DEPTH, D_MODEL, D_FF), f32) * D_MODEL ** -0.5
    w_down = jax.random.normal(ks[11], (DEPTH, D_FF, D_MODEL), f32) * D_FF ** -0.5
    return {"x": x, "lower_bounds": lower_bounds, "norm1_w": norm1_w, "w_in": w_in,
            "fox_f_bias": fox_f_bias, "q_norm_w": q_norm_w, "k_norm_w": k_norm_w,
            "hgrn_norm_w": hgrn_norm_w, "w_out": w_out, "norm2_w": norm2_w,
            "w_up": w_up, "w_down": w_down}


def reference(x, lower_bounds, norm1_w, w_in, fox_f_bias, q_norm_w, k_norm_w,
              hgrn_norm_w, w_out, norm2_w, w_up, w_down):
    lbs = layer_lower_bounds(lower_bounds)
    for l in range(DEPTH):
        h = rms_norm(x, norm1_w[l])
        proj = jnp.einsum('bsd,dc->bsc', h, w_in[l])
        hq, hf, hi, hg, fq, fk, fv, ff = jnp.split(proj, SPLIT_POINTS, axis=-1)
        o_a = hgrn2_mixer(hq, hf, hi, hg, lbs[l], hgrn_norm_w[l])
        o_b = fox_mixer(fq, fk, fv, ff, fox_f_bias[l], q_norm_w[l], k_norm_w[l])
        mix = jnp.concatenate([o_a, o_b], axis=-1)
        x = x + jnp.einsum('bsc,cd->bsd', mix, w_out[l])
        h2 = rms_norm(x, norm2_w[l])
        u = jax.nn.relu(jnp.einsum('bsd,df->bsf', h2, w_up[l]))
        x = x + jnp.einsum('bsf,fd->bsd', u * u, w_down[l])
    return x
```

```cpp
#include <hip/hip_runtime.h>
#include <hip/hip_cooperative_groups.h>
#include <cstdio>
#include <cstdint>
namespace cg = cooperative_groups;
namespace pg8 {
#define PG8_LAS __attribute__((address_space(3)))
typedef unsigned short bf16_t;
typedef short bf16x8 __attribute__((ext_vector_type(8)));
typedef float f32x4 __attribute__((ext_vector_type(4)));
typedef unsigned u32x4 __attribute__((ext_vector_type(4)));
constexpr int BM = 256, BK = 64, HALF = 128, HTB = HALF * BK * 2  , STAGE_BYTES = 8 * HTB, NXCD = 8, WGM = 8;

__host__ __device__ __forceinline__ int lds_byte(int r, int c) { const int st = (r >> 4) * 2 + (c >> 5), rr = r & 15, cc = c & 31, ob = rr * 64 + cc * 2; return st * 1024 + (ob ^ (((ob >> 9) & 1) << 5)); }
__host__ __device__ __forceinline__ void stage_rc(int b, int& R, int& C) { const int st = b / 1024, sb = b % 1024, swz = sb ^ (((sb >> 9) & 1) << 5); R = (st >> 1) * 16 + swz / 64; C = (st & 1) * 32 + (swz % 64) / 2; }
__host__ __device__ __forceinline__ int perm32(int rho) { const int n = rho >> 4, i = rho & 15; return 8 * (i >> 2) + 4 * n + (i & 3); }

struct Unit { int pm, pn; };
struct Gemm { const bf16_t* A; const bf16_t* Bt; int M, N, K; };

struct StaticOrder {
    int nM, nN, nwg, G, c;
    __host__ __device__ void init(int M, int N, int G_, int c_) { nM = M / BM; nN = N / BM; nwg = nM * nN; G = G_; c = c_; }
    __host__ __device__ bool next(int i, Unit& u) const {
        const long L = (long)i * G + c; if (L >= nwg) return false;
        int wgid = (int)L; { const int q = nwg / NXCD, r = nwg % NXCD, xcd = wgid % NXCD, off = wgid / NXCD; wgid = (xcd < r ? xcd * (q + 1) : r * (q + 1) + (xcd - r) * q) + off; }
        const int nig = WGM * nN, gid = wgid / nig, fm = gid * WGM, gsz = (nM - fm) < WGM ? (nM - fm) : WGM;
        u.pm = fm + ((wgid % nig) % gsz); u.pn = (wgid % nig) / gsz; return true;
    }
    __device__ __forceinline__ void a_ready(const Unit&) const {}
    __device__ __forceinline__ void done(const Unit&) const {}
};

__device__ __forceinline__ unsigned cvt_pk_bf16(float lo, float hi) { unsigned r; asm volatile("v_cvt_pk_bf16_f32 %0, %1, %2" : "=v"(r) : "v"(lo), "v"(hi)); return r; }
typedef float f32x2 __attribute__((ext_vector_type(2)));
template <class Epi, class Sched, bool ALIGN_EPI = false, bool SP2 = false>
__device__ __forceinline__ void gemm_phase(PG8_LAS unsigned char* lds, const Gemm g, const Sched& S, const Epi& E) {
    int tid_o = threadIdx.x; asm volatile("" : "+v"(tid_o));
    const int tid = tid_o, wid = __builtin_amdgcn_readfirstlane(tid >> 6), lane = tid & 63, wr = wid >> 2, wc = wid & 3, fr = lane & 15, fq = lane >> 4;
    const int K = g.K, nt = K / BK;
    unsigned voffA[2], voffB[2];
#pragma unroll
    for (int i = 0; i < 2; ++i) { int R, C; stage_rc(tid * 16 + i * 8192, R, C); const int Rb = Epi::PERM ? ((R & ~31) + perm32(R & 31)) : R;
        voffA[i] = (unsigned)(R * K + C) * 2u; voffB[i] = (unsigned)(Rb * K + C) * 2u; }
    const size_t kstep = (size_t)(BK * 2);
    const size_t hstep = (size_t)HALF * K * 2;
    const size_t tstep = 2 * hstep;
    const unsigned ldsw = (unsigned)wid * 1024u;
    const int aoff = lds_byte(wr * 64 + fr, fq * 8), boff = lds_byte(wc * 32 + fr, fq * 8);
#define PG8_SA(b, h) (((b) * 2 + (h)) * HTB)
#define PG8_SB(b, h) ((4 + (b) * 2 + (h)) * HTB)
#define PG8_STAGE(bufoff, gbase, voff) do { _Pragma("unroll") for (int _i = 0; _i < 2; ++_i) \
        __builtin_amdgcn_global_load_lds((const unsigned*)((const char*)(gbase) + (voff)[_i]), (PG8_LAS unsigned*)(lds + (bufoff) + ldsw + _i * 8192), 16, 0, 0); } while (0)
#define PG8_LDA(dst, b, h) do { _Pragma("unroll") for (int m = 0; m < 4; ++m) _Pragma("unroll") for (int k = 0; k < 2; ++k) dst[m][k] = *(const PG8_LAS bf16x8*)(lds + PG8_SA(b, h) + aoff + m * 2048 + k * 1024); } while (0)
#define PG8_LDB(dst, b, h) do { _Pragma("unroll") for (int n = 0; n < 2; ++n) _Pragma("unroll") for (int k = 0; k < 2; ++k) dst[n][k] = *(const PG8_LAS bf16x8*)(lds + PG8_SB(b, h) + boff + n * 2048 + k * 1024); } while (0)
#define PG8_MMA(ai, bj, At, Bt) do { __builtin_amdgcn_s_setprio(1); _Pragma("unroll") for (int m = 0; m < 4; ++m) _Pragma("unroll") for (int n = 0; n < 2; ++n) _Pragma("unroll") for (int k = 0; k < 2; ++k) \
        acc[ai][bj][m][n] = __builtin_amdgcn_mfma_f32_16x16x32_bf16(Bt[n][k], At[m][k], acc[ai][bj][m][n], 0, 0, 0); __builtin_amdgcn_s_setprio(0); } while (0)
#define PG8_WAIT_V(n) asm volatile("s_waitcnt vmcnt(" #n ")" ::: "memory")
#define PG8_WAIT_L(n) asm volatile("s_waitcnt lgkmcnt(" #n ")" ::: "memory")
#define PG8_BAR __builtin_amdgcn_s_barrier()
#define PG8_SCHED __builtin_amdgcn_sched_barrier(0)
    Unit cur, nxt; int ui = 0;
    if (!S.next(0, cur)) return;
    f32x4 acc[2][2][4][2];
#pragma unroll
    for (int a = 0; a < 2; ++a)
#pragma unroll
        for (int b = 0; b < 2; ++b)
#pragma unroll
            for (int m = 0; m < 4; ++m)
#pragma unroll
                for (int n = 0; n < 2; ++n) acc[a][b][m][n] = (f32x4){0.f, 0.f, 0.f, 0.f};
    bf16x8 At[4][2], B0[2][2], B1[2][2];
    const char* cA = (const char*)g.A + (size_t)cur.pm * tstep; const char* cB = (const char*)g.Bt + (size_t)cur.pn * tstep;
    S.a_ready(cur);
    if constexpr (SP2) {
        PG8_STAGE(PG8_SB(0, 0), cB, voffB); PG8_STAGE(PG8_SB(0, 1), cB + hstep, voffB); PG8_STAGE(PG8_SA(0, 0), cA, voffA); PG8_STAGE(PG8_SA(0, 1), cA + hstep, voffA);
        if (wr == 1) PG8_BAR;
        PG8_WAIT_V(2); PG8_BAR;
        PG8_STAGE(PG8_SB(1, 0), cB + kstep, voffB); PG8_STAGE(PG8_SA(1, 0), cA + kstep, voffA); PG8_STAGE(PG8_SB(1, 1), cB + hstep + kstep, voffB);
        PG8_WAIT_V(6); PG8_BAR;
    } else {
        PG8_STAGE(PG8_SB(0, 0), cB, voffB); PG8_STAGE(PG8_SA(0, 0), cA, voffA); PG8_STAGE(PG8_SB(0, 1), cB + hstep, voffB); PG8_STAGE(PG8_SA(0, 1), cA + hstep, voffA);
        if (wr == 1) PG8_BAR;
        PG8_WAIT_V(4); PG8_BAR;
        PG8_STAGE(PG8_SB(1, 0), cB + kstep, voffB); PG8_STAGE(PG8_SA(1, 0), cA + kstep, voffA); PG8_STAGE(PG8_SB(1, 1), cB + hstep + kstep, voffB);
        PG8_WAIT_V(6); PG8_BAR;
    }
    for (;;) {
        const bool has_next = S.next(ui + 1, nxt);
        const char* nA = has_next ? (const char*)g.A + (size_t)nxt.pm * tstep : cA; const char* nB = has_next ? (const char*)g.Bt + (size_t)nxt.pn * tstep : cB;
        for (int t = 0; t < nt; t += 2) {
            const bool last = (t == nt - 2);
            const char* a1 = cA + (size_t)(t + 1) * kstep;
            const char* a2 = last ? nA : cA + (size_t)(t + 2) * kstep; const char* b2 = last ? nB : cB + (size_t)(t + 2) * kstep;
            const char* a3 = a2 + kstep; const char* b3 = b2 + kstep;
            if (last && has_next) S.a_ready(nxt);
            if constexpr (SP2) {
            PG8_LDB(B0, 0, 0); PG8_LDB(B1, 0, 1); PG8_SCHED; PG8_LDA(At, 0, 0); PG8_STAGE(PG8_SA(1, 1), a1 + hstep, voffA);
            PG8_WAIT_V(8); PG8_WAIT_L(0); PG8_BAR; PG8_MMA(0, 0, At, B0); PG8_MMA(0, 1, At, B1); PG8_BAR; PG8_SCHED;
            PG8_LDA(At, 0, 1); PG8_STAGE(PG8_SB(0, 0), b2, voffB); PG8_STAGE(PG8_SB(0, 1), b2 + hstep, voffB); PG8_STAGE(PG8_SA(0, 0), a2, voffA);
            PG8_WAIT_V(8); PG8_WAIT_L(0); PG8_BAR; PG8_MMA(1, 0, At, B0); PG8_MMA(1, 1, At, B1); PG8_BAR; PG8_SCHED;
            PG8_LDB(B0, 1, 0); PG8_LDB(B1, 1, 1); PG8_SCHED; PG8_LDA(At, 1, 0); PG8_STAGE(PG8_SA(0, 1), a2 + hstep, voffA);
            PG8_WAIT_V(8); PG8_WAIT_L(0); PG8_BAR; PG8_MMA(0, 0, At, B0); PG8_MMA(0, 1, At, B1); PG8_BAR; PG8_SCHED;
            PG8_LDA(At, 1, 1); PG8_STAGE(PG8_SB(1, 0), b3, voffB); PG8_STAGE(PG8_SB(1, 1), b3 + hstep, voffB); PG8_STAGE(PG8_SA(1, 0), a3, voffA);
            PG8_WAIT_V(8); PG8_WAIT_L(0); PG8_BAR; PG8_MMA(1, 0, At, B0); PG8_MMA(1, 1, At, B1); PG8_BAR; PG8_SCHED;
            } else {
            PG8_LDB(B0, 0, 0); PG8_SCHED; PG8_LDA(At, 0, 0); PG8_STAGE(PG8_SA(1, 1), a1 + hstep, voffA);
            PG8_WAIT_L(8); PG8_BAR; PG8_WAIT_L(0); PG8_MMA(0, 0, At, B0); PG8_BAR; PG8_SCHED;
            PG8_LDB(B1, 0, 1); PG8_STAGE(PG8_SB(0, 0), b2, voffB);
            PG8_BAR; PG8_WAIT_L(0); PG8_MMA(0, 1, At, B1); PG8_BAR;
            PG8_LDA(At, 0, 1); PG8_STAGE(PG8_SA(0, 0), a2, voffA);
            PG8_BAR; PG8_WAIT_L(0); PG8_MMA(1, 0, At, B0); PG8_BAR; PG8_SCHED;
            PG8_STAGE(PG8_SB(0, 1), b2 + hstep, voffB);
            PG8_WAIT_V(6); PG8_BAR; PG8_MMA(1, 1, At, B1); PG8_BAR;
            PG8_LDB(B0, 1, 0); PG8_SCHED; PG8_LDA(At, 1, 0); PG8_STAGE(PG8_SA(0, 1), a2 + hstep, voffA);
            PG8_WAIT_L(8); PG8_BAR; PG8_WAIT_L(0); PG8_MMA(0, 0, At, B0); PG8_BAR; PG8_SCHED;
            PG8_LDB(B1, 1, 1); PG8_STAGE(PG8_SB(1, 0), b3, voffB);
            PG8_BAR; PG8_WAIT_L(0); PG8_MMA(0, 1, At, B1); PG8_BAR;
            PG8_LDA(At, 1, 1); PG8_STAGE(PG8_SA(1, 0), a3, voffA);
            PG8_BAR; PG8_WAIT_L(0); PG8_MMA(1, 0, At, B0); PG8_BAR; PG8_SCHED;
            PG8_STAGE(PG8_SB(1, 1), b3 + hstep, voffB);
            PG8_WAIT_V(6); PG8_BAR; PG8_MMA(1, 1, At, B1); PG8_BAR;
            }
        }
        if constexpr (ALIGN_EPI) { if (wr == 0) PG8_BAR; }
        if constexpr (!Epi::AFTER_DRAIN) { E(acc, cur, wr, wc, fr, fq); S.done(cur); }
        if (!has_next) break;
#pragma unroll
        for (int a = 0; a < 2; ++a)
#pragma unroll
            for (int b = 0; b < 2; ++b)
#pragma unroll
                for (int m = 0; m < 4; ++m)
#pragma unroll
                    for (int n = 0; n < 2; ++n) acc[a][b][m][n] = (f32x4){0.f, 0.f, 0.f, 0.f};
        cur = nxt; cA = nA; cB = nB; ++ui;
        if constexpr (ALIGN_EPI) { if (wr == 1) PG8_BAR; }
    }
    PG8_WAIT_V(0);
    if constexpr (!ALIGN_EPI) { if (wr == 0) PG8_BAR; }
    PG8_BAR;
    if constexpr (Epi::AFTER_DRAIN) { E.fused(acc, cur, wr, wc, fr, fq, lds, wid, lane); S.done(cur); }
#undef PG8_SA
#undef PG8_SB
#undef PG8_STAGE
#undef PG8_LDA
#undef PG8_LDB
#undef PG8_MMA
#undef PG8_WAIT_V
#undef PG8_WAIT_L
#undef PG8_BAR
#undef PG8_SCHED
}
}
namespace pg8 {
typedef unsigned u32x2 __attribute__((ext_vector_type(2)));
__device__ __forceinline__ float fsigmoid(float v) { return 1.0f / (1.0f + __expf(-v)); }
struct EpiIn {
    static constexpr bool PERM = true, AFTER_DRAIN = false;
    const float* ssq;
    bf16_t *hq, *hv, *hg, *Q, *Kb, *V; float* lf; float* lsig;
    const float* lba; const float* lbb;
    int layer; const float* qw; const float* kw; const float* fbias;
    __device__ __forceinline__ void operator()(const f32x4 (&acc)[2][2][4][2], const Unit& u, int wr, int wc, int fr, int fq) const {
        const int pn = u.pn, g = pn >> 1, half = pn & 1;
        const int row0 = u.pm * BM + wr * 64 + fr;
        if (pn == 14) {
            if (wc == 0 && fq == 0) {
                const f32x4 b0 = *(const f32x4*)(fbias), b1 = *(const f32x4*)(fbias + 4);
#pragma unroll
                for (int ai = 0; ai < 2; ++ai)
#pragma unroll
                    for (int m = 0; m < 4; ++m) { const int row = row0 + ai * HALF + m * 16; const float rs = rsqrtf(ssq[row] * (1.0f / 1024.0f) + 1e-6f);
                        f32x4 v0 = acc[ai][0][m][0] * rs + b0, v1 = acc[ai][0][m][1] * rs + b1;
#pragma unroll
                        for (int j = 0; j < 4; ++j) { v0[j] = fminf(v0[j], 0.f) - log1pf(__expf(-fabsf(v0[j]))); v1[j] = fminf(v1[j], 0.f) - log1pf(__expf(-fabsf(v1[j]))); }
                        *(f32x4*)(lsig + (size_t)row * 8) = v0; *(f32x4*)(lsig + (size_t)row * 8 + 4) = v1; }
            }
            return;
        }
        if (g == 4 || g == 5) {
            bf16_t* dst = (g == 4) ? Q : Kb; const float* nw = (g == 4) ? qw : kw; const float osc = (g == 4) ? 0.125f * 1.4426950408889634f : 1.0f;
            f32x4 w[2][2];
#pragma unroll
            for (int bj = 0; bj < 2; ++bj)
#pragma unroll
                for (int n = 0; n < 2; ++n) w[bj][n] = *(const f32x4*)(nw + 32 * bj + 8 * fq + 4 * n) * osc;
            const int col0 = (half * 4 + wc) * 64 + 8 * fq;
#pragma unroll
            for (int ai = 0; ai < 2; ++ai)
#pragma unroll
                for (int m = 0; m < 4; ++m) { const int row = row0 + ai * HALF + m * 16; const float rs = rsqrtf(ssq[row] * (1.0f / 1024.0f) + 1e-6f);
                    f32x4 v[2][2]; float ss = 0.f;
#pragma unroll
                    for (int bj = 0; bj < 2; ++bj)
#pragma unroll
                        for (int n = 0; n < 2; ++n) { v[bj][n] = acc[ai][bj][m][n] * rs; ss += (v[bj][n][0] * v[bj][n][0] + v[bj][n][1] * v[bj][n][1]) + (v[bj][n][2] * v[bj][n][2] + v[bj][n][3] * v[bj][n][3]); }
                    ss += __shfl_xor(ss, 16); ss += __shfl_xor(ss, 32);
                    const float hr = rsqrtf(ss * (1.0f / 64.0f) + 1e-6f);
#pragma unroll
                    for (int bj = 0; bj < 2; ++bj) { const f32x4 a = v[bj][0] * hr * w[bj][0], b = v[bj][1] * hr * w[bj][1];
                        u32x4 o; o.x = cvt_pk_bf16(a[0], a[1]); o.y = cvt_pk_bf16(a[2], a[3]); o.z = cvt_pk_bf16(b[0], b[1]); o.w = cvt_pk_bf16(b[2], b[3]);
                        *(u32x4*)(dst + (size_t)row * 512 + col0 + 32 * bj) = o; } }
            return;
        }
        const int col0 = half * 256 + wc * 32 + 8 * fq;
        if (g == 1) {
            f32x4 lbv[2][2];
#pragma unroll
            for (int bj = 0; bj < 2; ++bj)
#pragma unroll
                for (int n = 0; n < 2; ++n) { f32x4 t = (f32x4){0.f, 0.f, 0.f, 0.f};
                    if (layer == 1) { const f32x4 a0 = *(const f32x4*)(lba + col0 + 128 * bj + 4 * n), a1 = *(const f32x4*)(lbb + col0 + 128 * bj + 4 * n);
#pragma unroll
                        for (int j = 0; j < 4; ++j) t[j] = fsigmoid(a1[j] - a0[j]); }
                    lbv[bj][n] = t; }
#pragma unroll
            for (int ai = 0; ai < 2; ++ai)
#pragma unroll
                for (int m = 0; m < 4; ++m) { const int row = row0 + ai * HALF + m * 16; const float rs = rsqrtf(ssq[row] * (1.0f / 1024.0f) + 1e-6f);
#pragma unroll
                    for (int bj = 0; bj < 2; ++bj)
#pragma unroll
                        for (int n = 0; n < 2; ++n) { f32x4 v = acc[ai][bj][m][n] * rs;
#pragma unroll
                            for (int j = 0; j < 4; ++j) v[j] = __logf(lbv[bj][n][j] + (1.0f - lbv[bj][n][j]) * fsigmoid(v[j]));
                            *(f32x4*)(lf + (size_t)row * 512 + col0 + 128 * bj + 4 * n) = v; } }
            return;
        }
        bf16_t* dst = (g == 0) ? hq : (g == 2) ? hv : (g == 3) ? hg : V;
        const float sc = (g == 0) ? 0.08838834764831845f : 1.0f;
#pragma unroll
        for (int ai = 0; ai < 2; ++ai)
#pragma unroll
            for (int m = 0; m < 4; ++m) { const int row = row0 + ai * HALF + m * 16; const float rs = rsqrtf(ssq[row] * (1.0f / 1024.0f) + 1e-6f) * sc;
#pragma unroll
                for (int bj = 0; bj < 2; ++bj) { f32x4 a = acc[ai][bj][m][0] * rs, b = acc[ai][bj][m][1] * rs;
                    if (g == 3) {
#pragma unroll
                        for (int j = 0; j < 4; ++j) { a[j] = a[j] * fsigmoid(a[j]); b[j] = b[j] * fsigmoid(b[j]); } }
                    u32x4 o; o.x = cvt_pk_bf16(a[0], a[1]); o.y = cvt_pk_bf16(a[2], a[3]); o.z = cvt_pk_bf16(b[0], b[1]); o.w = cvt_pk_bf16(b[2], b[3]);
                    *(u32x4*)(dst + (size_t)row * 512 + col0 + 128 * bj) = o; } }
    }
};
struct EpiRes {
    static constexpr bool PERM = false, AFTER_DRAIN = false;
    const float* base; float* out; bf16_t* xb; float* ssq;
    __device__ __forceinline__ void operator()(const f32x4 (&acc)[2][2][4][2], const Unit& u, int wr, int wc, int fr, int fq) const {
        const int col0 = u.pn * BM + wc * 32 + 4 * fq;
#pragma unroll
        for (int ai = 0; ai < 2; ++ai)
#pragma unroll
            for (int m = 0; m < 4; ++m) { const int row = u.pm * BM + ai * HALF + wr * 64 + m * 16 + fr; const size_t off = (size_t)row * 1024 + col0; float ss = 0.f;
#pragma unroll
                for (int bj = 0; bj < 2; ++bj)
#pragma unroll
                    for (int n = 0; n < 2; ++n) { const f32x4 o = *(const f32x4*)(base + off + bj * HALF + n * 16) + acc[ai][bj][m][n];
                        *(f32x4*)(out + off + bj * HALF + n * 16) = o; ss += (o[0] * o[0] + o[1] * o[1]) + (o[2] * o[2] + o[3] * o[3]);
                        if (xb) { u32x2 w; w.x = cvt_pk_bf16(o[0], o[1]); w.y = cvt_pk_bf16(o[2], o[3]); *(u32x2*)(xb + off + bj * HALF + n * 16) = w; } }
                if (ssq) { ss += __shfl_xor(ss, 16); ss += __shfl_xor(ss, 32); if (fq == 0) unsafeAtomicAdd(ssq + row, ss); } }
    }
};
struct EpiUp {
    static constexpr bool PERM = true, AFTER_DRAIN = false;
    const float* ssq; bf16_t* H;
    __device__ __forceinline__ void operator()(const f32x4 (&acc)[2][2][4][2], const Unit& u, int wr, int wc, int fr, int fq) const {
        const int row0 = u.pm * BM + wr * 64 + fr, col0 = u.pn * BM + wc * 32 + 8 * fq;
#pragma unroll
        for (int ai = 0; ai < 2; ++ai)
#pragma unroll
            for (int m = 0; m < 4; ++m) { const int row = row0 + ai * HALF + m * 16; const float rs = rsqrtf(ssq[row] * (1.0f / 1024.0f) + 1e-6f);
#pragma unroll
                for (int bj = 0; bj < 2; ++bj) { f32x4 a = acc[ai][bj][m][0] * rs, b = acc[ai][bj][m][1] * rs;
#pragma unroll
                    for (int j = 0; j < 4; ++j) { a[j] = fmaxf(a[j], 0.f); a[j] *= a[j]; b[j] = fmaxf(b[j], 0.f); b[j] *= b[j]; }
                    u32x4 o; o.x = cvt_pk_bf16(a[0], a[1]); o.y = cvt_pk_bf16(a[2], a[3]); o.z = cvt_pk_bf16(b[0], b[1]); o.w = cvt_pk_bf16(b[2], b[3]);
                    *(u32x4*)(H + (size_t)row * 4096 + col0 + 128 * bj) = o; } }
    }
};
}
#include <hip/hip_bf16.h>
#include <cmath>
namespace attn_body {
using bf16=__hip_bfloat16;
using bf16x8=__attribute__((ext_vector_type(8)))short;
using s16x4=__attribute__((ext_vector_type(4)))short;
using f32x16=__attribute__((ext_vector_type(16)))float;
using u32x4=__attribute__((ext_vector_type(4)))unsigned;
using f32x4v=__attribute__((ext_vector_type(4)))float;
constexpr int BATCH=2,NHEAD=8,SEQ=8192,D=64,DM=NHEAD*D,ODM=1024;
constexpr int NW=8,QBLK=32,QB=QBLK*NW,KVBLK=64,NQB=SEQ/QB;
constexpr int ATTN_PITCH=DM, ATTN_UNIT_ROWS=QB;
__device__ __forceinline__ int crow(int r,int hi){return (r&3)+8*(r>>2)+4*hi;}
#define SBAR() __builtin_amdgcn_sched_barrier(0)
__device__ __forceinline__ void cmask(f32x16&p0,f32x16&p1,int jb,int qrel,int hi){
  const float NEG=-INFINITY; int kb=64*jb+4*hi;
  #pragma unroll
  for(int r=0;r<16;++r){int kv=kb+(r&3)+8*(r>>2); if(kv>qrel)p0[r]=NEG; if(kv+32>qrel)p1[r]=NEG;}
}

constexpr int NSLOT=3, SLOTB=8192;
constexpr int LDS_K=0, LDS_V=NSLOT*SLOTB, LDS_WS=2*NSLOT*SLOTB, LDS_OST=LDS_WS+NW*64*4, LDS_BYTES=LDS_OST+NW*4096, LDS_DK=86016, LDS_END=LDS_DK+SEQ*4;
constexpr float C2=0.125f*1.4426950408889634f;
__device__ __forceinline__ void glds16(const void*gsrc,unsigned lds_dst){unsigned keep;
  asm volatile("s_mov_b32 %0, m0\n\ts_mov_b32 m0, %2\n\ts_nop 0\n\tglobal_load_lds_dwordx4 %1, off\n\ts_mov_b32 m0, %0":"=&s"(keep):"v"(gsrc),"s"(lds_dst):"memory");}
__device__ __forceinline__ float max3f(float a,float b,float c){float r;asm("v_max3_f32 %0, %1, %2, %3":"=v"(r):"v"(a),"v"(b),"v"(c));return r;}
__device__ __forceinline__ float max2f(float a,float b){float r;asm("v_max_f32_e32 %0, %1, %2":"=v"(r):"v"(a),"v"(b));return r;}
__device__ __forceinline__ float fadd_s(float a,float b){float r;asm("v_add_f32_e32 %0, %1, %2":"=v"(r):"v"(a),"v"(b));return r;}
__device__ __forceinline__ float fsub_s(float a,float b){float r;asm("v_sub_f32_e32 %0, %1, %2":"=v"(r):"v"(a),"v"(b));return r;}
typedef float f32x2_t __attribute__((ext_vector_type(2))); typedef __bf16 bf16x2_t __attribute__((ext_vector_type(2)));
__device__ __forceinline__ unsigned cvtpk_s(float lo,float hi){f32x2_t v={lo,hi};bf16x2_t b=__builtin_convertvector(v,bf16x2_t);return __builtin_bit_cast(unsigned,b);}
#define WAIT_BAR(N) asm volatile("s_waitcnt vmcnt(" #N ") lgkmcnt(0)\n\ts_barrier":::"memory")

__device__ __forceinline__ void qkt(f32x16&p0,f32x16&p1,const char*Kslot,const bf16x8*qr,int r32,int hi){
  const char*kb=Kslot+hi*1024+r32*16;
  #pragma unroll
  for(int d0=0;d0<4;++d0){
    const bf16x8 b0=*reinterpret_cast<const bf16x8*>(kb+d0*2048);
    const bf16x8 b1=*reinterpret_cast<const bf16x8*>(kb+d0*2048+512);
    {p0=__builtin_amdgcn_mfma_f32_32x32x16_bf16(b0,qr[d0],p0,0,0,0);p1=__builtin_amdgcn_mfma_f32_32x32x16_bf16(b1,qr[d0],p1,0,0,0);}}
}
typedef __attribute__((address_space(3))) const char* lds_cptr;
typedef short v4i16_t __attribute__((ext_vector_type(4)));
__device__ __forceinline__ void kload8(bf16x8*kf,lds_cptr kp){
  kf[0]=*(const __attribute__((address_space(3))) bf16x8*)(kp);      kf[1]=*(const __attribute__((address_space(3))) bf16x8*)(kp+512);
  kf[2]=*(const __attribute__((address_space(3))) bf16x8*)(kp+2048); kf[3]=*(const __attribute__((address_space(3))) bf16x8*)(kp+2560);
  kf[4]=*(const __attribute__((address_space(3))) bf16x8*)(kp+4096); kf[5]=*(const __attribute__((address_space(3))) bf16x8*)(kp+4608);
  kf[6]=*(const __attribute__((address_space(3))) bf16x8*)(kp+6144); kf[7]=*(const __attribute__((address_space(3))) bf16x8*)(kp+6656);
}
__device__ __forceinline__ void kload2(bf16x8*kf,lds_cptr kp,int j){ kf[2*j]=*(const __attribute__((address_space(3))) bf16x8*)(kp+j*2048); kf[2*j+1]=*(const __attribute__((address_space(3))) bf16x8*)(kp+j*2048+512); }
__device__ __forceinline__ s16x4 vtr(lds_cptr p){ return __builtin_bit_cast(s16x4,__builtin_amdgcn_ds_read_tr16_b64_v4i16((__attribute__((address_space(3))) v4i16_t*)p)); }
__device__ __forceinline__ float rowmax(const f32x16&p0,const f32x16&p1){
  float a=max3f(p0[0],p0[1],p1[0]),b=max3f(p0[2],p0[3],p1[1]);a=max3f(a,p1[2],p1[3]);
  #pragma unroll
  for(int r=4;r<16;r+=4){a=max3f(a,p0[r],p0[r+1]);b=max3f(b,p0[r+2],p0[r+3]);a=max3f(a,p1[r],p1[r+1]);b=max3f(b,p1[r+2],p1[r+3]);}
  const float m=max2f(a,b);
  auto rr=__builtin_amdgcn_permlane32_swap(__float_as_uint(m),__float_as_uint(m),false,false);
  return max2f(__uint_as_float(rr[0]),__uint_as_float(rr[1]));
}
__device__ __forceinline__ void pv(f32x16*o,int vb,bf16x8 pa0,bf16x8 pa1,bf16x8 pa2,bf16x8 pa3){
  #pragma unroll
  for(int d0=0;d0<2;++d0){s16x4 lo[4],hi[4];
    #pragma unroll
    for(int ks=0;ks<4;++ks){
      asm volatile("ds_read_b64_tr_b16 %0,%1 offset:%c2":"=&v"(lo[ks]):"v"(vb),"i"(d0*4096+ks*1024):"memory");
      asm volatile("ds_read_b64_tr_b16 %0,%1 offset:%c2":"=&v"(hi[ks]):"v"(vb),"i"(d0*4096+ks*1024+512):"memory");}
    asm volatile("s_waitcnt lgkmcnt(0)":::"memory");SBAR();
    #define PK(k) (bf16x8){lo[k][0],lo[k][1],lo[k][2],lo[k][3],hi[k][0],hi[k][1],hi[k][2],hi[k][3]}
    o[d0]=__builtin_amdgcn_mfma_f32_32x32x16_bf16(pa0,PK(0),o[d0],0,0,0);
    o[d0]=__builtin_amdgcn_mfma_f32_32x32x16_bf16(pa1,PK(1),o[d0],0,0,0);
    o[d0]=__builtin_amdgcn_mfma_f32_32x32x16_bf16(pa2,PK(2),o[d0],0,0,0);
    o[d0]=__builtin_amdgcn_mfma_f32_32x32x16_bf16(pa3,PK(3),o[d0],0,0,0);
    #undef PK
  }
}

#ifndef ATTN_STORE16
#define ATTN_STORE16(p,v) (*(u32x4*)(p)=(v))
#endif
template<int THRL> __device__ __forceinline__ void attn_unit(int b,int h,int qb,int NT,const bf16*Q,const bf16*__restrict__ K,const bf16*__restrict__ V,bf16*O,char*shm){
  int tid_o=threadIdx.x; asm volatile("":"+v"(tid_o));
  const int tid=tid_o,lane=tid&63,r32=lane&31,hi=lane>>5; const int wid=__builtin_amdgcn_readfirstlane(tid>>6);
  const long rowbase=(long)b*SEQ; const int q0=qb*QB;
  const bf16*Qw=Q+(rowbase+q0+wid*QBLK)*DM+h*D;
  const bf16*Kh=K+rowbase*DM+h*D,*Vh=V+rowbase*DM+h*D;
  const unsigned lds0=(unsigned)(uintptr_t)shm;
  float*wsf=(float*)(shm+LDS_WS)+wid*64;
  const bf16*ksrc=Kh+(long)lane*DM+wid*8;
  const bf16*vsrc=Vh+(long)(16*(wid&3)+(lane>>2))*DM+(wid>>2)*32+(lane&3)*8;
  const unsigned kdst=lds0+LDS_K+wid*1024, vdst=lds0+LDS_V+wid*1024;
  #define TA(t) (((t)<4)?(NTA-4+(t)):(NTA-1-(t)))
  #define DMA_K(t,slot) glds16(ksrc+(long)TA(t)*KVBLK*DM,(unsigned)__builtin_amdgcn_readfirstlane(kdst+(slot)))
  #define DMA_V(t,slot) glds16(vsrc+(long)TA(t)*KVBLK*DM,(unsigned)__builtin_amdgcn_readfirstlane(vdst+(slot)))
  const int vb0=(int)(lds0+LDS_V)+((lane>>4)&1)*32+(lane&3)*8+(4*hi+((lane&15)>>2))*64;
  const char*Kbase=shm+LDS_K; bf16x8 kf[8];
  const lds_cptr shm3=(lds_cptr)shm; const lds_cptr kp0=shm3+LDS_K+hi*1024+r32*16; const lds_cptr vp0=shm3+LDS_V+((lane>>4)&1)*32+(lane&3)*8+(4*hi+((lane&15)>>2))*64;
  const int NTA=(q0+QB)/KVBLK;
  typedef __attribute__((address_space(3))) const f32x4v* dk_cptr; const dk_cptr dkp=(dk_cptr)(shm3+LDS_DK+hi*16);
  #define CINIT1(C0,t,o8) do{ const dk_cptr dp_=dkp+TA(t)*16+(o8); _Pragma("unroll") for(int j_=0;j_<4;++j_){ const f32x4v a_=dp_[2*j_]; \
      C0[4*j_]=a_[0]+nmh;C0[4*j_+1]=a_[1]+nmh;C0[4*j_+2]=a_[2]+nmh;C0[4*j_+3]=a_[3]+nmh; } }while(0)
  #define CINIT(C0,C1,t) do{ CINIT1(C0,t,0); SBAR(); CINIT1(C1,t,8); }while(0)
  DMA_K(0,0);DMA_V(0,0);DMA_K(1,SLOTB);
  bf16x8 qr[4];
  #pragma unroll
  for(int d0=0;d0<4;++d0)qr[d0]=*reinterpret_cast<const bf16x8*>(&Qw[(long)r32*DM+d0*16+hi*8]);
  float mhat=0.f,l_reg=0.f,nmh=0.f;f32x16 o[2];o[0]=f32x16{};o[1]=f32x16{};
  const int qrel=wid*QBLK+r32;
  #define CMASK(P0,P1,t) do{int jb_=(t); if(jb_<4)cmask(P0,P1,jb_,qrel,hi);}while(0)
  bool resc=false;
  #define START(P0,P1) do{ const float rm=rowmax(P0,P1); resc=false; \
    { const float dl=rm; mhat=fadd_s(mhat,dl); \
      _Pragma("unroll") for(int r=0;r<16;++r){P0[r]=fsub_s(P0[r],dl);P1[r]=fsub_s(P1[r],dl);} \
      nmh=-mhat; } \
    _Pragma("unroll") for(int r=0;r<16;++r)P0[r]=__builtin_amdgcn_exp2f(P0[r]); }while(0)
  #define RESC() do{ if(resc){ asm volatile("s_waitcnt lgkmcnt(0)":::"memory"); \
      _Pragma("unroll") for(int d_=0;d_<2;++d_) _Pragma("unroll") for(int r=0;r<16;++r)o[d_][r]*=wsf[crow(r,hi)]; } }while(0)
  f32x16 pA0,pA1,pB0,pB1;
  int sl_prev=0,sl_cur=0,sl_next=SLOTB;
  #define ROT() do{sl_prev=sl_cur;sl_cur=sl_next;sl_next=(sl_next==(NSLOT-1)*SLOTB)?0:sl_next+SLOTB;}while(0)
  DMA_K(2,2*SLOTB);
  WAIT_BAR(3);
  CINIT(pA0,pA1,0); qkt(pA0,pA1,Kbase,qr,r32,hi);asm volatile("s_nop 15\n\ts_nop 7":"+v"(pA0),"+v"(pA1));CMASK(pA0,pA1,0);
  START(pA0,pA1);
  _Pragma("unroll") for(int r=0;r<16;++r)pA1[r]=__builtin_amdgcn_exp2f(pA1[r]);
  WAIT_BAR(0);
  DMA_K(3,0);DMA_V(1,SLOTB);
  ROT();
  kload8(kf,kp0+sl_cur);
  WAIT_BAR(2);
  s16x4 vlo[8],vhi[8]; u32x4 pw0,pw1,pw2,pw3;
  #define PKW(P,B) cvtpk_s(P[B],P[B+1])
  #define PAF(k) __builtin_bit_cast(bf16x8,pw##k)
  #define VFR(i) (bf16x8){vlo[i][0],vlo[i][1],vlo[i][2],vlo[i][3],vhi[i][0],vhi[i][1],vhi[i][2],vhi[i][3]}
  #define PIN(x) asm volatile("":"+v"(x))
  #define MX3(a,b,c) __builtin_fmaxf(__builtin_fmaxf((a),(b)),(c))
  #define GAPA(MF,A0,A1,A2,A3,W0,W1,PW) do{ MF; sacc+=A0; sacc+=A1; sacc+=A2; sacc+=A3; PIN(sacc); W0; W1; PIN(PW); SBAR(); }while(0)
  #define EX(v) __builtin_amdgcn_exp2f(v)
  #define GAPB(MF,X,B) do{ MF; X[B]=EX(X[B]); X[B+1]=EX(X[B+1]); X[B+2]=EX(X[B+2]); X[B+3]=EX(X[B+3]); PIN(X); SBAR(); }while(0)
  #define VRD(i) do{ vlo[i]=vtr(vp_+(((i)>>2)*4096+((i)&3)*1024)); vhi[i]=vtr(vp_+(((i)>>2)*4096+((i)&3)*1024+512)); }while(0)
  #define KRD(G,j) do{ if(G){ kload2(kf,kp0+sl_next,j); SBAR(); } }while(0)
  #define STEP(C0,C1,P0,P1,t,GK,GV,GL) do{ SBAR(); CINIT(C0,C1,t); SBAR(); \
    const lds_cptr vp_=vp0+sl_prev; \
    float sacc=(P0[0]+P0[1]); \
    GAPA(C0=__builtin_amdgcn_mfma_f32_32x32x16_bf16(kf[0],qr[0],C0,0,0,0), P0[2],P0[3],P0[4],P0[5],     pw0[0]=PKW(P0,0), pw0[1]=PKW(P0,2), pw0); \
    GAPA(C1=__builtin_amdgcn_mfma_f32_32x32x16_bf16(kf[1],qr[0],C1,0,0,0), P0[6],P0[7],P0[8],P0[9],     pw0[2]=PKW(P0,4), pw0[3]=PKW(P0,6), pw0); \
    GAPA(C0=__builtin_amdgcn_mfma_f32_32x32x16_bf16(kf[2],qr[1],C0,0,0,0),   P0[10],P0[11],P0[12],P0[13], pw1[0]=PKW(P0,8), pw1[1]=PKW(P0,10), pw1); \
    GAPA(C1=__builtin_amdgcn_mfma_f32_32x32x16_bf16(kf[3],qr[1],C1,0,0,0),   P0[14],P0[15],P1[0],P1[1],   pw1[2]=PKW(P0,12),pw1[3]=PKW(P0,14), pw1); \
    GAPA(C0=__builtin_amdgcn_mfma_f32_32x32x16_bf16(kf[4],qr[2],C0,0,0,0),   P1[2],P1[3],P1[4],P1[5],     pw2[0]=PKW(P1,0), pw2[1]=PKW(P1,2), pw2); \
    GAPA(C1=__builtin_amdgcn_mfma_f32_32x32x16_bf16(kf[5],qr[2],C1,0,0,0),   P1[6],P1[7],P1[8],P1[9],     pw2[2]=PKW(P1,4), pw2[3]=PKW(P1,6), pw2); \
    GAPA(C0=__builtin_amdgcn_mfma_f32_32x32x16_bf16(kf[6],qr[3],C0,0,0,0),   P1[10],P1[11],P1[12],P1[13], pw3[0]=PKW(P1,8), pw3[1]=PKW(P1,10), pw3); \
    GAPA(C1=__builtin_amdgcn_mfma_f32_32x32x16_bf16(kf[7],qr[3],C1,0,0,0),   P1[14],P1[15],0.f,0.f,       pw3[2]=PKW(P1,12),pw3[3]=PKW(P1,14), pw3); \
    l_reg+=sacc; VRD(0); VRD(4); \
    if(GK){DMA_K((t)+3,sl_cur);} if(GV){DMA_V((t)+1,sl_next);} \
    CMASK(C0,C1,t); \
    { float a=MX3(C0[0],C0[1],C1[0]),b=MX3(C0[2],C0[3],C1[1]); a=MX3(a,C1[2],C1[3]); \
      _Pragma("unroll") for(int r=4;r<16;r+=4){a=MX3(a,C0[r],C0[r+1]);b=MX3(b,C0[r+2],C0[r+3]);a=MX3(a,C1[r],C1[r+1]);b=MX3(b,C1[r+2],C1[r+3]);} \
      float rm=__builtin_fmaxf(a,b); { auto rr=__builtin_amdgcn_permlane32_swap(__float_as_uint(rm),__float_as_uint(rm),false,false); rm=__builtin_fmaxf(__uint_as_float(rr[0]),__uint_as_float(rr[1])); } \
      resc=false; \
      if(__builtin_expect(__any(rm>(float)THRL),0)){ const float dl=__builtin_fmaxf(rm,0.f); mhat+=dl; \
        _Pragma("unroll") for(int r=0;r<16;++r){C0[r]-=dl;C1[r]-=dl;} \
        nmh=-mhat; \
        const float f=__builtin_amdgcn_exp2f(-dl); l_reg*=f; if(hi==0)wsf[r32]=f; resc=true; } } \
    SBAR(); \
    VRD(1); GAPB(o[0]=__builtin_amdgcn_mfma_f32_32x32x16_bf16(PAF(0),VFR(0),o[0],0,0,0), C0,0); \
    VRD(5); GAPB(o[1]=__builtin_amdgcn_mfma_f32_32x32x16_bf16(PAF(0),VFR(4),o[1],0,0,0), C0,4); \
    KRD(GL,0); VRD(2); GAPB(o[0]=__builtin_amdgcn_mfma_f32_32x32x16_bf16(PAF(1),VFR(1),o[0],0,0,0), C0,8); \
    KRD(GL,1); VRD(6); GAPB(o[1]=__builtin_amdgcn_mfma_f32_32x32x16_bf16(PAF(1),VFR(5),o[1],0,0,0), C0,12); \
    KRD(GL,2); VRD(3); GAPB(o[0]=__builtin_amdgcn_mfma_f32_32x32x16_bf16(PAF(2),VFR(2),o[0],0,0,0), C1,0); \
    KRD(GL,3); VRD(7); GAPB(o[1]=__builtin_amdgcn_mfma_f32_32x32x16_bf16(PAF(2),VFR(6),o[1],0,0,0), C1,4); \
    GAPB(o[0]=__builtin_amdgcn_mfma_f32_32x32x16_bf16(PAF(3),VFR(3),o[0],0,0,0), C1,8); \
    GAPB(o[1]=__builtin_amdgcn_mfma_f32_32x32x16_bf16(PAF(3),VFR(7),o[1],0,0,0), C1,12); \
    }while(0)
  int t=1;
  #define ENDW(tt) do{ if((tt)+3<NT){WAIT_BAR(2);} else if((tt)+2<NT){WAIT_BAR(1);} else {WAIT_BAR(0);} }while(0)
  for(;t+1<NT;t+=2){
    STEP(pB0,pB1,pA0,pA1,t,(t+3<NT),(t+1<NT),(t+1<NT));       ENDW(t);   RESC(); ROT();
    STEP(pA0,pA1,pB0,pB1,t+1,(t+4<NT),(t+2<NT),(t+2<NT));     ENDW(t+1); RESC(); ROT();
  }
  STEP(pB0,pB1,pA0,pA1,NT-1,false,false,false); RESC();
  { float sacc=pB0[0]+pB0[1]; _Pragma("unroll") for(int r=2;r<16;++r)sacc+=pB0[r]; _Pragma("unroll") for(int r=0;r<16;++r)sacc+=pB1[r]; l_reg+=sacc;
    pw0=(u32x4){PKW(pB0,0),PKW(pB0,2),PKW(pB0,4),PKW(pB0,6)};pw1=(u32x4){PKW(pB0,8),PKW(pB0,10),PKW(pB0,12),PKW(pB0,14)};pw2=(u32x4){PKW(pB1,0),PKW(pB1,2),PKW(pB1,4),PKW(pB1,6)};pw3=(u32x4){PKW(pB1,8),PKW(pB1,10),PKW(pB1,12),PKW(pB1,14)};
    SBAR(); pv(o,vb0+sl_cur,PAF(0),PAF(1),PAF(2),PAF(3)); }
  #undef PKW
  #undef PAF
  #undef VFR
  #undef PIN
  #undef MX3
  #undef GAPA
  #undef GAPB
  #undef EX
  #undef VRD
  #undef KRD
  #undef STEP
  #undef ENDW
  {auto rr=__builtin_amdgcn_permlane32_swap(__float_as_uint(l_reg),__float_as_uint(l_reg),false,false);l_reg=__uint_as_float(rr[0])+__uint_as_float(rr[1]);}
  if(hi==0)wsf[32+r32]=l_reg;asm volatile("s_waitcnt lgkmcnt(0)":::"memory");
  float rli[16];
  #pragma unroll
  for(int r=0;r<16;++r)rli[r]=__builtin_amdgcn_rcpf(wsf[32+crow(r,hi)]);
  bf16*Ow=O+(rowbase+q0+wid*QBLK)*ODM+h*D;
  { bf16*stg=(bf16*)(shm+LDS_OST)+wid*2048;
    #pragma unroll
    for(int r=0;r<16;++r){const int orow=crow(r,hi);
      #pragma unroll
      for(int d0=0;d0<2;++d0)stg[orow*64+d0*32+r32]=__float2bfloat16(o[d0][r]*rli[r]);}
    asm volatile("s_waitcnt lgkmcnt(0)":::"memory");
    #pragma unroll
    for(int i=0;i<4;++i){const int row=i*8+(lane>>3),ch=lane&7; const u32x4 v=*(const u32x4*)(stg+row*64+ch*8); ATTN_STORE16(Ow+(long)row*ODM+ch*8,v);} }
  asm volatile("s_waitcnt lgkmcnt(0)\n\ts_barrier":::"memory");
  #undef DMA_K
  #undef TA
  #undef CINIT
  #undef CINIT1
  #undef DMA_V
  #undef CMASK
  #undef START
  #undef RESC
  #undef ROT
}
constexpr int ATTN_LDS_BYTES=LDS_END;
#undef SBAR
#undef WAIT_BAR
}
constexpr int NWAVES = 8, NTHREADS = 512;
constexpr int BATCH = 2, T = 8192, D = 1024, FF = 4096, M = BATCH * T, DEPTH = 2;
constexpr int IN_COLS = 3592, NIN = 3840;
constexpr size_t MiB = 1u << 20;
constexpr size_t WS_CTL = 0, CTL_ZERO_BYTES = 1 * MiB;
constexpr size_t WS_SSQ = 64 * 1024;
constexpr size_t WS_LSIG = 512 * 1024;
constexpr size_t WS_WIN = 1 * MiB, WIN_BYTES = (size_t)NIN * D * 2;
constexpr size_t WS_WOUT = 16 * MiB, WS_WUP = 20 * MiB, WS_WDN = 36 * MiB;
constexpr size_t WS_XB = 52 * MiB;
constexpr size_t WS_ST = 84 * MiB;
constexpr size_t WS_HQ = 116 * MiB, WS_LF = 132 * MiB, WS_HV = 164 * MiB, WS_HG = 180 * MiB, WS_Q = 196 * MiB, WS_K = 212 * MiB, WS_V = 228 * MiB, WS_END = 244 * MiB;
constexpr size_t WS_H = 116 * MiB;
constexpr size_t WS_DL = 244 * MiB;
constexpr int LDS_BYTES = 147456;

#define GAS __attribute__((address_space(1)))
#define LAS __attribute__((address_space(3)))
typedef unsigned short bf16;
typedef unsigned v4u __attribute__((ext_vector_type(4)));
typedef float f32x4 __attribute__((ext_vector_type(4)));
typedef float f32x16 __attribute__((ext_vector_type(16)));
typedef short bf16x8 __attribute__((ext_vector_type(8)));
#define LDS_WAIT() asm volatile("s_waitcnt lgkmcnt(0)" ::: "memory")
__device__ __forceinline__ unsigned f2bf(float f) { unsigned u = __builtin_bit_cast(unsigned, f); return (u + 0x7fffu + ((u >> 16) & 1u)) >> 16; }
__device__ __forceinline__ unsigned pk2(float lo, float hi) { return f2bf(lo) | (f2bf(hi) << 16); }
__device__ __forceinline__ float bf2f(unsigned short b) { return __builtin_bit_cast(float, (unsigned)b << 16); }
__device__ __forceinline__ int crow16(int r, int hi) { return (r & 3) + 8 * (r >> 2) + 4 * hi; }

struct Frame {
    LAS unsigned char* lds; int tid, lane, wave, vcu, G;
};
__device__ __forceinline__ float wave_sum(float v) {
#pragma unroll
    for (int o = 1; o < 64; o <<= 1) v += __shfl_xor(v, o);
    return v;
}
__device__ __forceinline__ void p0_transpose_item(const float* W, int pitch, int K, const float* sc, bf16* WT, int dst_row0, int k0, int n0, LAS float* scr, int lane) {
#pragma unroll 8
    for (int i = 0; i < 32; ++i) { const int kk = 2 * i + (lane >> 5); float v = W[(size_t)(k0 + kk) * pitch + n0 + (lane & 31)]; if (sc) v *= sc[k0 + kk]; scr[kk * 33 + (lane & 31)] = v; }
    LDS_WAIT(); asm volatile("" ::: "memory");
    const int c = lane & 7;
#pragma unroll
    for (int j = 0; j < 4; ++j) { const int n = (lane >> 3) + 8 * j; const LAS float* s = scr + (8 * c) * 33 + n;
        v4u o; o.x = pk2(s[0 * 33], s[1 * 33]); o.y = pk2(s[2 * 33], s[3 * 33]); o.z = pk2(s[4 * 33], s[5 * 33]); o.w = pk2(s[6 * 33], s[7 * 33]);
        *(GAS v4u*)(WT + (size_t)(dst_row0 + n) * K + k0 + 8 * c) = o; }
    LDS_WAIT(); asm volatile("" ::: "memory");
}
__device__ __forceinline__ int map_in_row(int n) {
    if (n < 2048 || n >= 3072) return n;
    const int local = n - 2048, tile = local >> 8, o = local & 255, wc = o >> 6, w = o & 63, bj = w >> 5, x = w & 31;
    return 2048 + tile * 256 + bj * 128 + wc * 32 + x;
}
struct Ptrs {
    const float *x, *lower_bounds, *norm1_w, *w_in, *fox_f_bias, *q_norm_w, *k_norm_w, *hgrn_norm_w, *w_out, *norm2_w, *w_up, *w_down;
    float* out; unsigned char* ws;
};
__device__ __forceinline__ void p0_prologue(Frame& F, const Ptrs& P) {
    LAS float* scr = (LAS float*)(F.lds + F.wave * 16384);
    const int gw = F.vcu * NWAVES + F.wave, NGW = F.G * NWAVES;
    constexpr int I_IN = 16 * 112, I_OUT = 16 * 32, I_UP = 16 * 128, I_DN = 64 * 32, I_L = I_IN + I_OUT + I_UP + I_DN;
    for (int it = gw; it < DEPTH * I_L; it += NGW) {
        const int l = it / I_L; int r = it % I_L;
        if (r < I_IN) { const int kb = r / 112, nb = r % 112; p0_transpose_item(P.w_in + (size_t)l * D * IN_COLS, IN_COLS, D, P.norm1_w + l * D, (bf16*)(P.ws + WS_WIN + l * WIN_BYTES), map_in_row(32 * nb), 64 * kb, 32 * nb, scr, F.lane); continue; } r -= I_IN;
        if (r < I_OUT) { const int kb = r / 32, nb = r % 32; p0_transpose_item(P.w_out + (size_t)l * D * D, D, D, nullptr, (bf16*)(P.ws + WS_WOUT + l * 2 * MiB), 32 * nb, 64 * kb, 32 * nb, scr, F.lane); continue; } r -= I_OUT;
        if (r < I_UP) { const int kb = r / 128, nb = r % 128; p0_transpose_item(P.w_up + (size_t)l * D * FF, FF, D, P.norm2_w + l * D, (bf16*)(P.ws + WS_WUP + l * 8 * MiB), 32 * nb, 64 * kb, 32 * nb, scr, F.lane); continue; } r -= I_UP;
        { const int kb = r / 32, nb = r % 32; p0_transpose_item(P.w_down + (size_t)l * FF * D, D, FF, nullptr, (bf16*)(P.ws + WS_WDN + l * 8 * MiB), 32 * nb, 64 * kb, 32 * nb, scr, F.lane); }
    }
    { const int gt = F.vcu * NTHREADS + F.tid;
      for (int e = gt; e < DEPTH * 256 * 128; e += F.G * NTHREADS) { const int l = e >> 15, j = (e >> 7) & 255, kc = e & 127; float v[8];
#pragma unroll
          for (int i = 0; i < 8; ++i) v[i] = (j < 8) ? P.w_in[(size_t)l * D * IN_COLS + (size_t)(8 * kc + i) * IN_COLS + 3584 + j] * P.norm1_w[l * D + 8 * kc + i] : 0.f;
          v4u o; o.x = pk2(v[0], v[1]); o.y = pk2(v[2], v[3]); o.z = pk2(v[4], v[5]); o.w = pk2(v[6], v[7]);
          *(GAS v4u*)((bf16*)(P.ws + WS_WIN + l * WIN_BYTES) + (size_t)(3584 + j) * D + 8 * kc) = o; } }
    bf16* XB = (bf16*)(P.ws + WS_XB); float* ssq = (float*)(P.ws + WS_SSQ);
    for (int m = gw; m < M; m += NGW) { const GAS f32x4* xr = (const GAS f32x4*)(P.x + (size_t)m * D) + F.lane; f32x4 v[4]; float s = 0.f;
#pragma unroll
        for (int j = 0; j < 4; ++j) { v[j] = xr[64 * j]; s += (v[j].x * v[j].x + v[j].y * v[j].y) + (v[j].z * v[j].z + v[j].w * v[j].w); }
        s = wave_sum(s); if (F.lane == 0) ssq[m] = s;
        GAS unsigned long long* o8 = (GAS unsigned long long*)(XB + (size_t)m * D) + F.lane;
#pragma unroll
        for (int j = 0; j < 4; ++j) o8[64 * j] = (unsigned long long)pk2(v[j].x, v[j].y) | ((unsigned long long)pk2(v[j].z, v[j].w) << 32); }
}

constexpr int HC = 64, NCH = T / HC;
constexpr int H_KD = 0, H_QE = 0, H_QM = 17408, H_KM = 34816, H_VT = 52224, H_AM = 70656, H_OS = 79872, H_TOT = 113664, H_BM = 115712;
__device__ __forceinline__ f32x16 mfma32(bf16x8 a, bf16x8 b, f32x16 c) { return __builtin_amdgcn_mfma_f32_32x32x16_bf16(a, b, c, 0, 0, 0); }
#define HGRN_SCAN(lfv, bv, blast)  \
    float lfv[16], bv[16]; float blast; { const float* lfp = lf + (size_t)(m0 + part * 16) * 512 + h * 128 + k; \
      _Pragma("unroll") for (int i = 0; i < 16; ++i) lfv[i] = lfp[(size_t)i * 512]; \
      float run = 0.f; _Pragma("unroll") for (int i = 0; i < 16; ++i) { run += lfv[i]; bv[i] = run; } \
      LAS float* TOT = (LAS float*)(F.lds + H_TOT); TOT[part * 128 + k] = run; __syncthreads(); \
      const float t0 = TOT[k], t1 = TOT[128 + k], t2 = TOT[256 + k], t3 = TOT[384 + k]; \
      const float off = (part > 0 ? t0 : 0.f) + (part > 1 ? t1 : 0.f) + (part > 2 ? t2 : 0.f); blast = (t0 + t1) + (t2 + t3); \
      _Pragma("unroll") for (int i = 0; i < 16; ++i) bv[i] += off; }
#define HGRN_VT() { const bf16* vp = hv + (size_t)(m0 + part * 16) * 512 + h * 128 + k; unsigned w_[8]; \
      _Pragma("unroll") for (int i = 0; i < 8; ++i) w_[i] = (unsigned)vp[(size_t)(2 * i) * 512] | ((unsigned)vp[(size_t)(2 * i + 1) * 512] << 16); \
      LAS v4u* d_ = (LAS v4u*)(F.lds + H_VT + k * 144 + part * 32); d_[0] = (v4u){w_[0], w_[1], w_[2], w_[3]}; d_[1] = (v4u){w_[4], w_[5], w_[6], w_[7]}; }
__device__ __forceinline__ void hgrn_pass_a(Frame& F, const float* lf, const bf16* hv, bf16* ST, float* DL) {
    const int k = F.tid & 127, part = F.tid >> 7, l31 = F.lane & 31, hi = F.lane >> 5;
    for (int it = F.vcu; it < 8 * NCH; it += F.G) {
        const int bh = it >> 7, c = it & 127, b = bh >> 2, h = bh & 3; const int m0 = b * T + c * HC;
        HGRN_SCAN(lfv, bv, blast)
        { unsigned w_[8];
#pragma unroll
          for (int i = 0; i < 8; ++i) { const float a0 = (1.0f - __expf(lfv[2 * i])) * __expf(blast - bv[2 * i]), a1 = (1.0f - __expf(lfv[2 * i + 1])) * __expf(blast - bv[2 * i + 1]); w_[i] = pk2(a0, a1); }
          LAS v4u* d_ = (LAS v4u*)(F.lds + H_KD + k * 144 + part * 32); d_[0] = (v4u){w_[0], w_[1], w_[2], w_[3]}; d_[1] = (v4u){w_[4], w_[5], w_[6], w_[7]}; }
        if (part == 0) DL[(size_t)it * 128 + k] = __expf(blast);
        HGRN_VT()
        __syncthreads();
        const int mt = F.wave >> 1, nt0 = (F.wave & 1) * 2; f32x16 a0 = {}, a1 = {};
#pragma unroll
        for (int ks = 0; ks < 4; ++ks) { const bf16x8 av = *(const LAS bf16x8*)(F.lds + H_VT + (32 * mt + l31) * 144 + (16 * ks + 8 * hi) * 2);
            const bf16x8 b0 = *(const LAS bf16x8*)(F.lds + H_KD + (32 * nt0 + l31) * 144 + (16 * ks + 8 * hi) * 2), b1 = *(const LAS bf16x8*)(F.lds + H_KD + (32 * nt0 + 32 + l31) * 144 + (16 * ks + 8 * hi) * 2);
            a0 = mfma32(av, b0, a0); a1 = mfma32(av, b1, a1); }
        bf16* U = ST + (size_t)it * 16384;
#pragma unroll
        for (int r = 0; r < 16; ++r) { const int v = 32 * mt + crow16(r, hi); U[v * 128 + 32 * nt0 + l31] = (bf16)f2bf(a0[r]); U[v * 128 + 32 * nt0 + 32 + l31] = (bf16)f2bf(a1[r]); }
        __syncthreads();
    }
}
__device__ __forceinline__ void hgrn_pass_b(Frame& F, bf16* ST, const float* DL) {
    if (F.tid >= 256) return;
    for (int e = F.vcu * 256 + F.tid; e < 8 * 8192; e += F.G * 256) {
        const int bh = e >> 13, rem = e & 8191, k = (rem & 63) * 2;
        unsigned* up = (unsigned*)(ST + (size_t)bh * NCH * 16384) + rem; const float* dp = DL + (size_t)bh * NCH * 128 + k;
        float s0 = 0.f, s1 = 0.f;
        for (int c0 = 0; c0 < NCH; c0 += 8) { unsigned u[8]; float d0[8], d1[8];
#pragma unroll
            for (int j = 0; j < 8; ++j) { u[j] = up[(size_t)(c0 + j) * 8192]; d0[j] = dp[(c0 + j) * 128]; d1[j] = dp[(c0 + j) * 128 + 1]; }
#pragma unroll
            for (int j = 0; j < 8; ++j) { up[(size_t)(c0 + j) * 8192] = pk2(s0, s1); s0 = d0[j] * s0 + bf2f((unsigned short)(u[j] & 0xffffu)); s1 = d1[j] * s1 + bf2f((unsigned short)(u[j] >> 16)); } }
    }
}
__device__ __forceinline__ void hgrn_pass_c(Frame& F, const bf16* hq, const float* lf, const bf16* hv, const bf16* hg, const bf16* ST, const float* nw, bf16* mix) {
    const int k = F.tid & 127, part = F.tid >> 7, l31 = F.lane & 31, hi = F.lane >> 5;
    for (int it = F.vcu; it < 8 * NCH; it += F.G) {
        const int bh = it >> 7, c = it & 127, b = bh >> 2, h = bh & 3; const int m0 = b * T + c * HC;
        HGRN_SCAN(lfv, bv, blast)
        (void)blast;
        LAS float* BMID = (LAS float*)(F.lds + H_BM);
        if (part == 1) BMID[k] = bv[15];
        __syncthreads();
        const float bm = BMID[k];
        { const bf16* qp = hq + (size_t)(m0 + part * 16) * 512 + h * 128 + k;
#pragma unroll
          for (int i = 0; i < 16; ++i) { const int t = part * 16 + i; const float q = bf2f(qp[(size_t)i * 512]);
              *(LAS bf16*)(F.lds + H_QE + t * 272 + k * 2) = (bf16)f2bf(q * __expf(bv[i]));
              *(LAS bf16*)(F.lds + H_QM + t * 272 + k * 2) = (bf16)f2bf(q * __expf(fminf(bv[i] - bm, 80.f)));
              *(LAS bf16*)(F.lds + H_KM + t * 272 + k * 2) = (bf16)f2bf((1.0f - __expf(lfv[i])) * __expf(fminf(bm - bv[i], 80.f))); } }
        HGRN_VT()
        __syncthreads();
        const int mt = F.wave >> 2, nt = F.wave & 3; f32x16 acc = {};
        { const bf16* sp = ST + (size_t)it * 16384 + (size_t)(32 * nt + l31) * 128 + 8 * hi;
#pragma unroll
          for (int ks = 0; ks < 8; ++ks) { const bf16x8 av = *(const LAS bf16x8*)(F.lds + H_QE + (32 * mt + l31) * 272 + (16 * ks + 8 * hi) * 2); const bf16x8 bvv = *(const bf16x8*)(sp + 16 * ks); acc = mfma32(av, bvv, acc); } }
        if (F.wave < 4) { const int mt2 = F.wave >> 1, nt2 = F.wave & 1; f32x16 am = {};
#pragma unroll
            for (int ks = 0; ks < 8; ++ks) { const bf16x8 av = *(const LAS bf16x8*)(F.lds + H_QM + (32 * mt2 + l31) * 272 + (16 * ks + 8 * hi) * 2), bvv = *(const LAS bf16x8*)(F.lds + H_KM + (32 * nt2 + l31) * 272 + (16 * ks + 8 * hi) * 2); am = mfma32(av, bvv, am); }
#pragma unroll
            for (int r = 0; r < 16; ++r) { const int t = 32 * mt2 + crow16(r, hi), s = 32 * nt2 + l31; *(LAS bf16*)(F.lds + H_AM + t * 144 + s * 2) = (bf16)f2bf(s <= t ? am[r] : 0.f); } }
        __syncthreads();
#pragma unroll
        for (int ks = 0; ks < 4; ++ks) { const bf16x8 av = *(const LAS bf16x8*)(F.lds + H_AM + (32 * mt + l31) * 144 + (16 * ks + 8 * hi) * 2), bvv = *(const LAS bf16x8*)(F.lds + H_VT + (32 * nt + l31) * 144 + (16 * ks + 8 * hi) * 2); acc = mfma32(av, bvv, acc); }
#pragma unroll
        for (int r = 0; r < 16; ++r) *(LAS float*)(F.lds + H_OS + (32 * mt + crow16(r, hi)) * 528 + (32 * nt + l31) * 4) = acc[r];
        __syncthreads();
        { const int t = F.tid >> 3, seg = F.tid & 7; f32x4 o[4]; float ss = 0.f;
#pragma unroll
          for (int j = 0; j < 4; ++j) { o[j] = *(const LAS f32x4*)(F.lds + H_OS + t * 528 + (seg * 16 + 4 * j) * 4); ss += (o[j][0] * o[j][0] + o[j][1] * o[j][1]) + (o[j][2] * o[j][2] + o[j][3] * o[j][3]); }
          ss += __shfl_xor(ss, 1); ss += __shfl_xor(ss, 2); ss += __shfl_xor(ss, 4);
          const float rs = rsqrtf(ss * (1.0f / 128.0f) + 1e-6f);
          const v4u g0 = *(const v4u*)(hg + (size_t)(m0 + t) * 512 + h * 128 + seg * 16), g1 = *(const v4u*)(hg + (size_t)(m0 + t) * 512 + h * 128 + seg * 16 + 8);
          const unsigned gw_[8] = {g0.x, g0.y, g0.z, g0.w, g1.x, g1.y, g1.z, g1.w}; unsigned w_[8];
#pragma unroll
          for (int j = 0; j < 4; ++j) { const f32x4 wv = *(const f32x4*)(nw + seg * 16 + 4 * j);
              const float e0 = o[j][0] * rs * wv[0] * bf2f((unsigned short)(gw_[2 * j] & 0xffffu)), e1 = o[j][1] * rs * wv[1] * bf2f((unsigned short)(gw_[2 * j] >> 16));
              const float e2 = o[j][2] * rs * wv[2] * bf2f((unsigned short)(gw_[2 * j + 1] & 0xffffu)), e3 = o[j][3] * rs * wv[3] * bf2f((unsigned short)(gw_[2 * j + 1] >> 16));
              w_[2 * j] = pk2(e0, e1); w_[2 * j + 1] = pk2(e2, e3); }
          v4u* op = (v4u*)(mix + (size_t)(m0 + t) * 1024 + h * 128 + seg * 16); op[0] = (v4u){w_[0], w_[1], w_[2], w_[3]}; op[1] = (v4u){w_[4], w_[5], w_[6], w_[7]}; }
        __syncthreads();
    }
}
#ifndef FOX_SKIP
#define FOX_SKIP 0
#endif
__device__ __forceinline__ void fox_phase(Frame& F, unsigned char* lds_generic, const float* lsig, const bf16* Q, const bf16* Kb, const bf16* V, bf16* mix) {
    using attn_body::LDS_DK; using attn_body::LDS_WS; using attn_body::attn_unit;
    LAS float* dk = (LAS float*)(F.lds + LDS_DK);
    LAS double* wtot = (LAS double*)(F.lds + LDS_WS);
    for (int pr = F.vcu; pr < 256; pr += F.G) {
        const int bh = pr >> 4, s = pr & 15, b = bh >> 3, h = bh & 7;
        { int tid_ = F.tid; asm volatile("" : "+v"(tid_)); const int lane_ = tid_ & 63;
          const float* lp = lsig + ((size_t)b * T + tid_ * 16) * 8 + h; double v[16]; double run = 0.0;
#pragma unroll
          for (int i = 0; i < 16; ++i) { run -= (double)lp[i * 8]; v[i] = run; }
          double inc = run;
#pragma unroll
          for (int o = 1; o < 64; o <<= 1) { const double t = __shfl_up(inc, o); if (lane_ >= o) inc += t; }
          if (lane_ == 63) wtot[F.wave] = inc;
          __syncthreads();
          double off = inc - run;
          for (int w = 0; w < F.wave; ++w) off += wtot[w];
#pragma unroll
          for (int i = 0; i < 16; ++i) dk[tid_ * 16 + i] = (float)((v[i] + off) * 1.4426950408889634);
          __syncthreads(); }
#pragma unroll 1
        for (int i = 0; i < 2; ++i) {
            const int qb = (i == 0) ? 31 - s : s; const int NTA = 4 * qb + 4; int NT = NTA;
#if FOX_SKIP
            { const float ref = dk[qb * 256]; int lo = 0, hi_ = NTA - 4;
              while (lo < hi_) { const int mid = (lo + hi_) >> 1; if (dk[64 * mid + 63] - ref < -200.0f) lo = mid + 1; else hi_ = mid; }
              int nold = (NTA - 4) - lo; nold += (nold & 1); NT = 4 + nold; }
#endif
            attn_unit<8>(b, h, qb, NT, (const attn_body::bf16*)Q, (const attn_body::bf16*)Kb, (const attn_body::bf16*)V, (attn_body::bf16*)(mix + 512), (char*)lds_generic);
        }
        __syncthreads();
    }
}

struct Args { Ptrs p; int ph_lo, ph_hi; };
constexpr int N_PHASES = 1 + 7 * DEPTH;
__global__ void __launch_bounds__(NTHREADS, 2) hymba_fwd(Args args) {
    extern __shared__ __attribute__((aligned(16))) unsigned char lds[];
    Frame F; F.lds = (LAS unsigned char*)lds; F.tid = threadIdx.x; F.lane = F.tid & 63; F.wave = __builtin_amdgcn_readfirstlane(F.tid >> 6);
    F.G = gridDim.x; { const int bx = blockIdx.x; F.vcu = (F.G % 8 == 0) ? (bx % 8) * (F.G / 8) + bx / 8 : bx; }
    const Ptrs& P = args.p;
    const int lo = args.ph_lo, hi = args.ph_hi;
#define PHASE_ENV() int t__ = threadIdx.x; asm volatile("" : "+v"(t__)); F.tid = t__; F.lane = t__ & 63; unsigned char* ws = P.ws; asm volatile("" : "+s"(ws)); \
    float* ssq = (float*)(ws + WS_SSQ); float* lsig = (float*)(ws + WS_LSIG); \
    bf16* XB = (bf16*)(ws + WS_XB); bf16* ST = (bf16*)(ws + WS_ST); float* DL = (float*)(ws + WS_DL); \
    bf16* HQ = (bf16*)(ws + WS_HQ); float* LF = (float*)(ws + WS_LF); bf16* HV = (bf16*)(ws + WS_HV); bf16* HG = (bf16*)(ws + WS_HG); \
    bf16* Qb = (bf16*)(ws + WS_Q); bf16* Kb = (bf16*)(ws + WS_K); bf16* Vb = (bf16*)(ws + WS_V); bf16* HB = (bf16*)(ws + WS_H); \
    (void)ssq; (void)lsig; (void)XB; (void)ST; (void)DL; (void)HQ; (void)LF; (void)HV; (void)HG; (void)Qb; (void)Kb; (void)Vb; (void)HB;
#define IN(k) (lo <= (k) && (k) < hi)
#define SEAM(k) do { if (IN(k) && IN((k) + 1)) cg::this_grid().sync(); } while (0)
    if (IN(0)) { PHASE_ENV() p0_prologue(F, P); }
    SEAM(0);
#pragma unroll 1
    for (int l = 0; l < DEPTH; ++l) {
        const int pb = 1 + 7 * l;
        if (IN(pb)) { PHASE_ENV()
            pg8::Gemm g{XB, (const bf16*)(ws + WS_WIN + l * WIN_BYTES), M, NIN, D}; pg8::StaticOrder S; S.init(M, NIN, F.G, (int)blockIdx.x);
            pg8::EpiIn E{ssq + (size_t)(2 * l) * M, HQ, HV, HG, Qb, Kb, Vb, LF, lsig, P.lower_bounds, P.lower_bounds + 512, l, P.q_norm_w + l * 64, P.k_norm_w + l * 64, P.fox_f_bias + l * 8};
            pg8::gemm_phase<pg8::EpiIn, pg8::StaticOrder, true, true>(F.lds, g, S, E);
        }
        SEAM(pb);
        if (IN(pb + 1)) { PHASE_ENV()
            fox_phase(F, lds, lsig, Qb, Kb, Vb, XB);
            hgrn_pass_a(F, LF, HV, ST, DL);
        }
        SEAM(pb + 1);
        if (IN(pb + 2)) { PHASE_ENV() hgrn_pass_b(F, ST, DL); }
        SEAM(pb + 2);
        if (IN(pb + 3)) { PHASE_ENV() hgrn_pass_c(F, HQ, LF, HV, HG, ST, P.hgrn_norm_w + l * 128, XB); }
        SEAM(pb + 3);
        if (IN(pb + 4)) { PHASE_ENV()
            pg8::Gemm g{XB, (const bf16*)(ws + WS_WOUT + l * 2 * MiB), M, D, D}; pg8::StaticOrder S; S.init(M, D, F.G, (int)blockIdx.x);
            pg8::EpiRes E{l == 0 ? P.x : P.out, P.out, ST, ssq + (size_t)(2 * l + 1) * M};
            pg8::gemm_phase<pg8::EpiRes, pg8::StaticOrder, true, true>(F.lds, g, S, E);
        }
        SEAM(pb + 4);
        if (IN(pb + 5)) { PHASE_ENV()
            pg8::Gemm g{ST, (const bf16*)(ws + WS_WUP + l * 8 * MiB), M, FF, D}; pg8::StaticOrder S; S.init(M, FF, F.G, (int)blockIdx.x);
            pg8::EpiUp E{ssq + (size_t)(2 * l + 1) * M, HB};
            pg8::gemm_phase<pg8::EpiUp, pg8::StaticOrder, true, true>(F.lds, g, S, E);
        }
        SEAM(pb + 5);
        if (IN(pb + 6)) { PHASE_ENV()
            pg8::Gemm g{HB, (const bf16*)(ws + WS_WDN + l * 8 * MiB), M, D, FF}; pg8::StaticOrder S; S.init(M, D, F.G, (int)blockIdx.x);
            const bool last = (l == DEPTH - 1);
            pg8::EpiRes E{P.out, P.out, last ? nullptr : XB, last ? nullptr : ssq + (size_t)(2 * l + 2) * M};
            pg8::gemm_phase<pg8::EpiRes, pg8::StaticOrder, true, true>(F.lds, g, S, E);
        }
        SEAM(pb + 6);
    }
#undef IN
#undef SEAM
}

#ifndef MK_PER_PHASE
#define MK_PER_PHASE 0
#endif
extern "C" void kernel_launch(void* const* d_in, const int* in_sizes, int n_in, void* d_out, int out_size, void* d_ws, size_t ws_size, hipStream_t stream) {
    static int grid = 0;
    if (grid == 0) {
        if (n_in != 12 || out_size != M * D || ws_size < WS_DL + MiB) { fprintf(stderr, "kernel_launch: unexpected sizes (n_in %d out %d ws %zu)\n", n_in, out_size, ws_size); grid = -1; return; }
        int dev = 0, cus = 0, per_cu = 0;
        (void)hipGetDevice(&dev); (void)hipDeviceGetAttribute(&cus, hipDeviceAttributeMultiprocessorCount, dev);
        if (hipFuncSetAttribute((const void*)hymba_fwd, hipFuncAttributeMaxDynamicSharedMemorySize, LDS_BYTES) != hipSuccess) { fprintf(stderr, "kernel_launch: hipFuncSetAttribute failed\n"); grid = -1; return; }
        if (hipOccupancyMaxActiveBlocksPerMultiprocessor(&per_cu, (const void*)hymba_fwd, NTHREADS, LDS_BYTES) != hipSuccess || per_cu < 1) { fprintf(stderr, "kernel_launch: occupancy query gave %d\n", per_cu); per_cu = 1; }
        (void)hipGetLastError();
        grid = cus * 1;
        fprintf(stderr, "kernel_launch: cus %d per_cu %d grid %d\n", cus, per_cu, grid);
    }
    if (grid < 0) return;
    (void)hipMemsetAsync((char*)d_ws + WS_CTL, 0, CTL_ZERO_BYTES, stream);
    Args a{};
    a.p.x = (const float*)d_in[0]; a.p.lower_bounds = (const float*)d_in[1]; a.p.norm1_w = (const float*)d_in[2]; a.p.w_in = (const float*)d_in[3];
    a.p.fox_f_bias = (const float*)d_in[4]; a.p.q_norm_w = (const float*)d_in[5]; a.p.k_norm_w = (const float*)d_in[6]; a.p.hgrn_norm_w = (const float*)d_in[7];
    a.p.w_out = (const float*)d_in[8]; a.p.norm2_w = (const float*)d_in[9]; a.p.w_up = (const float*)d_in[10]; a.p.w_down = (const float*)d_in[11];
    a.p.out = (float*)d_out; a.p.ws = (unsigned char*)d_ws;
#if MK_PER_PHASE
    for (int ph = 0; ph < N_PHASES; ++ph) { a.ph_lo = ph; a.ph_hi = ph + 1; hipLaunchKernelGGL(hymba_fwd, dim3(grid), dim3(NTHREADS), LDS_BYTES, stream, a); }
#else
    a.ph_lo = 0; a.ph_hi = N_PHASES;
    void* kargs[] = {&a};
    const hipError_t e = hipLaunchCooperativeKernel((const void*)hymba_fwd, dim3(grid), dim3(NTHREADS), kargs, LDS_BYTES, stream);
    if (e != hipSuccess) fprintf(stderr, "kernel_launch: cooperative launch failed: %s (grid %d)\n", hipGetErrorString(e), grid);
#endif
}
```

```cpp
#include <hip/hip_runtime.h>
#include <hip/hip_cooperative_groups.h>
#include <cstdio>
#include <cstdint>
namespace cg = cooperative_groups;
namespace pg8 {
#define PG8_LAS __attribute__((address_space(3)))
typedef unsigned short bf16_t;
typedef short bf16x8 __attribute__((ext_vector_type(8)));
typedef float f32x4 __attribute__((ext_vector_type(4)));
typedef unsigned u32x4 __attribute__((ext_vector_type(4)));
constexpr int BM = 256, BK = 64, HALF = 128, HTB = HALF * BK * 2  , STAGE_BYTES = 8 * HTB, NXCD = 8, WGM = 8;

__host__ __device__ __forceinline__ int lds_byte(int r, int c) { const int st = (r >> 4) * 2 + (c >> 5), rr = r & 15, cc = c & 31, ob = rr * 64 + cc * 2; return st * 1024 + (ob ^ (((ob >> 9) & 1) << 5)); }
__host__ __device__ __forceinline__ void stage_rc(int b, int& R, int& C) { const int st = b / 1024, sb = b % 1024, swz = sb ^ (((sb >> 9) & 1) << 5); R = (st >> 1) * 16 + swz / 64; C = (st & 1) * 32 + (swz % 64) / 2; }
__host__ __device__ __forceinline__ int perm32(int rho) { const int n = rho >> 4, i = rho & 15; return 8 * (i >> 2) + 4 * n + (i & 3); }

struct Unit { int pm, pn; };
struct Gemm { const bf16_t* A; const bf16_t* Bt; int M, N, K; };

struct StaticOrder {
    int nM, nN, nwg, G, c;
    __host__ __device__ void init(int M, int N, int G_, int c_) { nM = M / BM; nN = N / BM; nwg = nM * nN; G = G_; c = c_; }
    __host__ __device__ bool next(int i, Unit& u) const {
        const long L = (long)i * G + c; if (L >= nwg) return false;
        int wgid = (int)L; { const int q = nwg / NXCD, r = nwg % NXCD, xcd = wgid % NXCD, off = wgid / NXCD; wgid = (xcd < r ? xcd * (q + 1) : r * (q + 1) + (xcd - r) * q) + off; }
        const int nig = WGM * nN, gid = wgid / nig, fm = gid * WGM, gsz = (nM - fm) < WGM ? (nM - fm) : WGM;
        u.pm = fm + ((wgid % nig) % gsz); u.pn = (wgid % nig) / gsz; return true;
    }
    __device__ __forceinline__ void a_ready(const Unit&) const {}
    __device__ __forceinline__ void done(const Unit&) const {}
};

__device__ __forceinline__ unsigned cvt_pk_bf16(float lo, float hi) { unsigned r; asm volatile("v_cvt_pk_bf16_f32 %0, %1, %2" : "=v"(r) : "v"(lo), "v"(hi)); return r; }
typedef float f32x2 __attribute__((ext_vector_type(2)));
template <class Epi, class Sched, bool ALIGN_EPI = false, bool SP2 = false>
__device__ __forceinline__ void gemm_phase(PG8_LAS unsigned char* lds, const Gemm g, const Sched& S, const Epi& E) {
    int tid_o = threadIdx.x; asm volatile("" : "+v"(tid_o));
    const int tid = tid_o, wid = __builtin_amdgcn_readfirstlane(tid >> 6), lane = tid & 63, wr = wid >> 2, wc = wid & 3, fr = lane & 15, fq = lane >> 4;
    const int K = g.K, nt = K / BK;
    unsigned voffA[2], voffB[2];
#pragma unroll
    for (int i = 0; i < 2; ++i) { int R, C; stage_rc(tid * 16 + i * 8192, R, C); const int Rb = Epi::PERM ? ((R & ~31) + perm32(R & 31)) : R;
        voffA[i] = (unsigned)(R * K + C) * 2u; voffB[i] = (unsigned)(Rb * K + C) * 2u; }
    const size_t kstep = (size_t)(BK * 2);
    const size_t hstep = (size_t)HALF * K * 2;
    const size_t tstep = 2 * hstep;
    const unsigned ldsw = (unsigned)wid * 1024u;
    const int aoff = lds_byte(wr * 64 + fr, fq * 8), boff = lds_byte(wc * 32 + fr, fq * 8);
#define PG8_SA(b, h) (((b) * 2 + (h)) * HTB)
#define PG8_SB(b, h) ((4 + (b) * 2 + (h)) * HTB)
#define PG8_STAGE(bufoff, gbase, voff) do { _Pragma("unroll") for (int _i = 0; _i < 2; ++_i) \
        __builtin_amdgcn_global_load_lds((const unsigned*)((const char*)(gbase) + (voff)[_i]), (PG8_LAS unsigned*)(lds + (bufoff) + ldsw + _i * 8192), 16, 0, 0); } while (0)
#define PG8_LDA(dst, b, h) do { _Pragma("unroll") for (int m = 0; m < 4; ++m) _Pragma("unroll") for (int k = 0; k < 2; ++k) dst[m][k] = *(const PG8_LAS bf16x8*)(lds + PG8_SA(b, h) + aoff + m * 2048 + k * 1024); } while (0)
#define PG8_LDB(dst, b, h) do { _Pragma("unroll") for (int n = 0; n < 2; ++n) _Pragma("unroll") for (int k = 0; k < 2; ++k) dst[n][k] = *(const PG8_LAS bf16x8*)(lds + PG8_SB(b, h) + boff + n * 2048 + k * 1024); } while (0)
#define PG8_MMA(ai, bj, At, Bt) do { __builtin_amdgcn_s_setprio(1); _Pragma("unroll") for (int m = 0; m < 4; ++m) _Pragma("unroll") for (int n = 0; n < 2; ++n) _Pragma("unroll") for (int k = 0; k < 2; ++k) \
        acc[ai][bj][m][n] = __builtin_amdgcn_mfma_f32_16x16x32_bf16(Bt[n][k], At[m][k], acc[ai][bj][m][n], 0, 0, 0); __builtin_amdgcn_s_setprio(0); } while (0)
#define PG8_WAIT_V(n) asm volatile("s_waitcnt vmcnt(" #n ")" ::: "memory")
#define PG8_WAIT_L(n) asm volatile("s_waitcnt lgkmcnt(" #n ")" ::: "memory")
#define PG8_BAR __builtin_amdgcn_s_barrier()
#define PG8_SCHED __builtin_amdgcn_sched_barrier(0)
    Unit cur, nxt; int ui = 0;
    if (!S.next(0, cur)) return;
    f32x4 acc[2][2][4][2];
#pragma unroll
    for (int a = 0; a < 2; ++a)
#pragma unroll
        for (int b = 0; b < 2; ++b)
#pragma unroll
            for (int m = 0; m < 4; ++m)
#pragma unroll
                for (int n = 0; n < 2; ++n) acc[a][b][m][n] = (f32x4){0.f, 0.f, 0.f, 0.f};
    bf16x8 At[4][2], B0[2][2], B1[2][2];
    const char* cA = (const char*)g.A + (size_t)cur.pm * tstep; const char* cB = (const char*)g.Bt + (size_t)cur.pn * tstep;
    S.a_ready(cur);
    if constexpr (SP2) {
        PG8_STAGE(PG8_SB(0, 0), cB, voffB); PG8_STAGE(PG8_SB(0, 1), cB + hstep, voffB); PG8_STAGE(PG8_SA(0, 0), cA, voffA); PG8_STAGE(PG8_SA(0, 1), cA + hstep, voffA);
        if (wr == 1) PG8_BAR;
        PG8_WAIT_V(2); PG8_BAR;
        PG8_STAGE(PG8_SB(1, 0), cB + kstep, voffB); PG8_STAGE(PG8_SA(1, 0), cA + kstep, voffA); PG8_STAGE(PG8_SB(1, 1), cB + hstep + kstep, voffB);
        PG8_WAIT_V(6); PG8_BAR;
    } else {
        PG8_STAGE(PG8_SB(0, 0), cB, voffB); PG8_STAGE(PG8_SA(0, 0), cA, voffA); PG8_STAGE(PG8_SB(0, 1), cB + hstep, voffB); PG8_STAGE(PG8_SA(0, 1), cA + hstep, voffA);
        if (wr == 1) PG8_BAR;
        PG8_WAIT_V(4); PG8_BAR;
        PG8_STAGE(PG8_SB(1, 0), cB + kstep, voffB); PG8_STAGE(PG8_SA(1, 0), cA + kstep, voffA); PG8_STAGE(PG8_SB(1, 1), cB + hstep + kstep, voffB);
        PG8_WAIT_V(6); PG8_BAR;
    }
    for (;;) {
        const bool has_next = S.next(ui + 1, nxt);
        const char* nA = has_next ? (const char*)g.A + (size_t)nxt.pm * tstep : cA; const char* nB = has_next ? (const char*)g.Bt + (size_t)nxt.pn * tstep : cB;
        for (int t = 0; t < nt; t += 2) {
            const bool last = (t == nt - 2);
            const char* a1 = cA + (size_t)(t + 1) * kstep;
            const char* a2 = last ? nA : cA + (size_t)(t + 2) * kstep; const char* b2 = last ? nB : cB + (size_t)(t + 2) * kstep;
            const char* a3 = a2 + kstep; const char* b3 = b2 + kstep;
            if (last && has_next) S.a_ready(nxt);
            if constexpr (SP2) {
            PG8_LDB(B0, 0, 0); PG8_LDB(B1, 0, 1); PG8_SCHED; PG8_LDA(At, 0, 0); PG8_STAGE(PG8_SA(1, 1), a1 + hstep, voffA);
            PG8_WAIT_V(8); PG8_WAIT_L(0); PG8_BAR; PG8_MMA(0, 0, At, B0); PG8_MMA(0, 1, At, B1); PG8_BAR; PG8_SCHED;
            PG8_LDA(At, 0, 1); PG8_STAGE(PG8_SB(0, 0), b2, voffB); PG8_STAGE(PG8_SB(0, 1), b2 + hstep, voffB); PG8_STAGE(PG8_SA(0, 0), a2, voffA);
            PG8_WAIT_V(8); PG8_WAIT_L(0); PG8_BAR; PG8_MMA(1, 0, At, B0); PG8_MMA(1, 1, At, B1); PG8_BAR; PG8_SCHED;
            PG8_LDB(B0, 1, 0); PG8_LDB(B1, 1, 1); PG8_SCHED; PG8_LDA(At, 1, 0); PG8_STAGE(PG8_SA(0, 1), a2 + hstep, voffA);
            PG8_WAIT_V(8); PG8_WAIT_L(0); PG8_BAR; PG8_MMA(0, 0, At, B0); PG8_MMA(0, 1, At, B1); PG8_BAR; PG8_SCHED;
            PG8_LDA(At, 1, 1); PG8_STAGE(PG8_SB(1, 0), b3, voffB); PG8_STAGE(PG8_SB(1, 1), b3 + hstep, voffB); PG8_STAGE(PG8_SA(1, 0), a3, voffA);
            PG8_WAIT_V(8); PG8_WAIT_L(0); PG8_BAR; PG8_MMA(1, 0, At, B0); PG8_MMA(1, 1, At, B1); PG8_BAR; PG8_SCHED;
            } else {
            PG8_LDB(B0, 0, 0); PG8_SCHED; PG8_LDA(At, 0, 0); PG8_STAGE(PG8_SA(1, 1), a1 + hstep, voffA);
            PG8_WAIT_L(8); PG8_BAR; PG8_WAIT_L(0); PG8_MMA(0, 0, At, B0); PG8_BAR; PG8_SCHED;
            PG8_LDB(B1, 0, 1); PG8_STAGE(PG8_SB(0, 0), b2, voffB);
            PG8_BAR; PG8_WAIT_L(0); PG8_MMA(0, 1, At, B1); PG8_BAR;
            PG8_LDA(At, 0, 1); PG8_STAGE(PG8_SA(0, 0), a2, voffA);
            PG8_BAR; PG8_WAIT_L(0); PG8_MMA(1, 0, At, B0); PG8_BAR; PG8_SCHED;
            PG8_STAGE(PG8_SB(0, 1), b2 + hstep, voffB);
            PG8_WAIT_V(6); PG8_BAR; PG8_MMA(1, 1, At, B1); PG8_BAR;
            PG8_LDB(B0, 1, 0); PG8_SCHED; PG8_LDA(At, 1, 0); PG8_STAGE(PG8_SA(0, 1), a2 + hstep, voffA);
            PG8_WAIT_L(8); PG8_BAR; PG8_WAIT_L(0); PG8_MMA(0, 0, At, B0); PG8_BAR; PG8_SCHED;
            PG8_LDB(B1, 1, 1); PG8_STAGE(PG8_SB(1, 0), b3, voffB);
            PG8_BAR; PG8_WAIT_L(0); PG8_MMA(0, 1, At, B1); PG8_BAR;
            PG8_LDA(At, 1, 1); PG8_STAGE(PG8_SA(1, 0), a3, voffA);
            PG8_BAR; PG8_WAIT_L(0); PG8_MMA(1, 0, At, B0); PG8_BAR; PG8_SCHED;
            PG8_STAGE(PG8_SB(1, 1), b3 + hstep, voffB);
            PG8_WAIT_V(6); PG8_BAR; PG8_MMA(1, 1, At, B1); PG8_BAR;
            }
        }
        if constexpr (ALIGN_EPI) { if (wr == 0) PG8_BAR; }
        if constexpr (!Epi::AFTER_DRAIN) { E(acc, cur, wr, wc, fr, fq); S.done(cur); }
        if (!has_next) break;
#pragma unroll
        for (int a = 0; a < 2; ++a)
#pragma unroll
            for (int b = 0; b < 2; ++b)
#pragma unroll
                for (int m = 0; m < 4; ++m)
#pragma unroll
                    for (int n = 0; n < 2; ++n) acc[a][b][m][n] = (f32x4){0.f, 0.f, 0.f, 0.f};
        cur = nxt; cA = nA; cB = nB; ++ui;
        if constexpr (ALIGN_EPI) { if (wr == 1) PG8_BAR; }
    }
    PG8_WAIT_V(0);
    if constexpr (!ALIGN_EPI) { if (wr == 0) PG8_BAR; }
    PG8_BAR;
    if constexpr (Epi::AFTER_DRAIN) { E.fused(acc, cur, wr, wc, fr, fq, lds, wid, lane); S.done(cur); }
#undef PG8_SA
#undef PG8_SB
#undef PG8_STAGE
#undef PG8_LDA
#undef PG8_LDB
#undef PG8_MMA
#undef PG8_WAIT_V
#undef PG8_WAIT_L
#undef PG8_BAR
#undef PG8_SCHED
}
}
namespace pg8 {
typedef unsigned u32x2 __attribute__((ext_vector_type(2)));
__device__ __forceinline__ float fsigmoid(float v) { return 1.0f / (1.0f + __expf(-v)); }
struct EpiIn {
    static constexpr bool PERM = true, AFTER_DRAIN = false;
    const float* ssq;
    bf16_t *hq, *hv, *hg, *Q, *Kb, *V; float* lf; float* lsig;
    const float* lba; const float* lbb;
    int layer; const float* qw; const float* kw; const float* fbias;
    __device__ __forceinline__ void operator()(const f32x4 (&acc)[2][2][4][2], const Unit& u, int wr, int wc, int fr, int fq) const {
        const int pn = u.pn, g = pn >> 1, half = pn & 1;
        const int row0 = u.pm * BM + wr * 64 + fr;
        if (pn == 14) {
            if (wc == 0 && fq == 0) {
                const f32x4 b0 = *(const f32x4*)(fbias), b1 = *(const f32x4*)(fbias + 4);
#pragma unroll
                for (int ai = 0; ai < 2; ++ai)
#pragma unroll
                    for (int m = 0; m < 4; ++m) { const int row = row0 + ai * HALF + m * 16; const float rs = rsqrtf(ssq[row] * (1.0f / 1024.0f) + 1e-6f);
                        f32x4 v0 = acc[ai][0][m][0] * rs + b0, v1 = acc[ai][0][m][1] * rs + b1;
#pragma unroll
                        for (int j = 0; j < 4; ++j) { v0[j] = fminf(v0[j], 0.f) - log1pf(__expf(-fabsf(v0[j]))); v1[j] = fminf(v1[j], 0.f) - log1pf(__expf(-fabsf(v1[j]))); }
                        *(f32x4*)(lsig + (size_t)row * 8) = v0; *(f32x4*)(lsig + (size_t)row * 8 + 4) = v1; }
            }
            return;
        }
        if (g == 4 || g == 5) {
            bf16_t* dst = (g == 4) ? Q : Kb; const float* nw = (g == 4) ? qw : kw; const float osc = (g == 4) ? 0.125f * 1.4426950408889634f : 1.0f;
            f32x4 w[2][2];
#pragma unroll
            for (int bj = 0; bj < 2; ++bj)
#pragma unroll
                for (int n = 0; n < 2; ++n) w[bj][n] = *(const f32x4*)(nw + 32 * bj + 8 * fq + 4 * n) * osc;
            const int col0 = (half * 4 + wc) * 64 + 8 * fq;
#pragma unroll
            for (int ai = 0; ai < 2; ++ai)
#pragma unroll
                for (int m = 0; m < 4; ++m) { const int row = row0 + ai * HALF + m * 16; const float rs = rsqrtf(ssq[row] * (1.0f / 1024.0f) + 1e-6f);
                    f32x4 v[2][2]; float ss = 0.f;
#pragma unroll
                    for (int bj = 0; bj < 2; ++bj)
#pragma unroll
                        for (int n = 0; n < 2; ++n) { v[bj][n] = acc[ai][bj][m][n] * rs; ss += (v[bj][n][0] * v[bj][n][0] + v[bj][n][1] * v[bj][n][1]) + (v[bj][n][2] * v[bj][n][2] + v[bj][n][3] * v[bj][n][3]); }
                    ss += __shfl_xor(ss, 16); ss += __shfl_xor(ss, 32);
                    const float hr = rsqrtf(ss * (1.0f / 64.0f) + 1e-6f);
#pragma unroll
                    for (int bj = 0; bj < 2; ++bj) { const f32x4 a = v[bj][0] * hr * w[bj][0], b = v[bj][1] * hr * w[bj][1];
                        u32x4 o; o.x = cvt_pk_bf16(a[0], a[1]); o.y = cvt_pk_bf16(a[2], a[3]); o.z = cvt_pk_bf16(b[0], b[1]); o.w = cvt_pk_bf16(b[2], b[3]);
                        *(u32x4*)(dst + (size_t)row * 512 + col0 + 32 * bj) = o; } }
            return;
        }
        const int col0 = half * 256 + wc * 32 + 8 * fq;
        if (g == 1) {
            f32x4 lbv[2][2];
#pragma unroll
            for (int bj = 0; bj < 2; ++bj)
#pragma unroll
                for (int n = 0; n < 2; ++n) { f32x4 t = (f32x4){0.f, 0.f, 0.f, 0.f};
                    if (layer == 1) { const f32x4 a0 = *(const f32x4*)(lba + col0 + 128 * bj + 4 * n), a1 = *(const f32x4*)(lbb + col0 + 128 * bj + 4 * n);
#pragma unroll
                        for (int j = 0; j < 4; ++j) t[j] = fsigmoid(a1[j] - a0[j]); }
                    lbv[bj][n] = t; }
#pragma unroll
            for (int ai = 0; ai < 2; ++ai)
#pragma unroll
                for (int m = 0; m < 4; ++m) { const int row = row0 + ai * HALF + m * 16; const float rs = rsqrtf(ssq[row] * (1.0f / 1024.0f) + 1e-6f);
#pragma unroll
                    for (int bj = 0; bj < 2; ++bj)
#pragma unroll
                        for (int n = 0; n < 2; ++n) { f32x4 v = acc[ai][bj][m][n] * rs;
#pragma unroll
                            for (int j = 0; j < 4; ++j) v[j] = __logf(lbv[bj][n][j] + (1.0f - lbv[bj][n][j]) * fsigmoid(v[j]));
                            *(f32x4*)(lf + (size_t)row * 512 + col0 + 128 * bj + 4 * n) = v; } }
            return;
        }
        bf16_t* dst = (g == 0) ? hq : (g == 2) ? hv : (g == 3) ? hg : V;
        const float sc = (g == 0) ? 0.08838834764831845f : 1.0f;
#pragma unroll
        for (int ai = 0; ai < 2; ++ai)
#pragma unroll
            for (int m = 0; m < 4; ++m) { const int row = row0 + ai * HALF + m * 16; const float rs = rsqrtf(ssq[row] * (1.0f / 1024.0f) + 1e-6f) * sc;
#pragma unroll
                for (int bj = 0; bj < 2; ++bj) { f32x4 a = acc[ai][bj][m][0] * rs, b = acc[ai][bj][m][1] * rs;
                    if (g == 3) {
#pragma unroll
                        for (int j = 0; j < 4; ++j) { a[j] = a[j] * fsigmoid(a[j]); b[j] = b[j] * fsigmoid(b[j]); } }
                    u32x4 o; o.x = cvt_pk_bf16(a[0], a[1]); o.y = cvt_pk_bf16(a[2], a[3]); o.z = cvt_pk_bf16(b[0], b[1]); o.w = cvt_pk_bf16(b[2], b[3]);
                    *(u32x4*)(dst + (size_t)row * 512 + col0 + 128 * bj) = o; } }
    }
};
struct EpiRes {
    static constexpr bool PERM = false, AFTER_DRAIN = false;
    const float* base; float* out; bf16_t* xb; float* ssq;
    __device__ __forceinline__ void operator()(const f32x4 (&acc)[2][2][4][2], const Unit& u, int wr, int wc, int fr, int fq) const {
        const int col0 = u.pn * BM + wc * 32 + 4 * fq;
#pragma unroll
        for (int ai = 0; ai < 2; ++ai)
#pragma unroll
            for (int m = 0; m < 4; ++m) { const int row = u.pm * BM + ai * HALF + wr * 64 + m * 16 + fr; const size_t off = (size_t)row * 1024 + col0; float ss = 0.f;
#pragma unroll
                for (int bj = 0; bj < 2; ++bj)
#pragma unroll
                    for (int n = 0; n < 2; ++n) { const f32x4 o = *(const f32x4*)(base + off + bj * HALF + n * 16) + acc[ai][bj][m][n];
                        *(f32x4*)(out + off + bj * HALF + n * 16) = o; ss += (o[0] * o[0] + o[1] * o[1]) + (o[2] * o[2] + o[3] * o[3]);
                        if (xb) { u32x2 w; w.x = cvt_pk_bf16(o[0], o[1]); w.y = cvt_pk_bf16(o[2], o[3]); *(u32x2*)(xb + off + bj * HALF + n * 16) = w; } }
                if (ssq) { ss += __shfl_xor(ss, 16); ss += __shfl_xor(ss, 32); if (fq == 0) unsafeAtomicAdd(ssq + row, ss); } }
    }
};
struct EpiUp {
    static constexpr bool PERM = true, AFTER_DRAIN = false;
    const float* ssq; bf16_t* H;
    __device__ __forceinline__ void operator()(const f32x4 (&acc)[2][2][4][2], const Unit& u, int wr, int wc, int fr, int fq) const {
        const int row0 = u.pm * BM + wr * 64 + fr, col0 = u.pn * BM + wc * 32 + 8 * fq;
#pragma unroll
        for (int ai = 0; ai < 2; ++ai)
#pragma unroll
            for (int m = 0; m < 4; ++m) { const int row = row0 + ai * HALF + m * 16; const float rs = rsqrtf(ssq[row] * (1.0f / 1024.0f) + 1e-6f);
#pragma unroll
                for (int bj = 0; bj < 2; ++bj) { f32x4 a = acc[ai][bj][m][0] * rs, b = acc[ai][bj][m][1] * rs;
#pragma unroll
                    for (int j = 0; j < 4; ++j) { a[j] = fmaxf(a[j], 0.f); a[j] *= a[j]; b[j] = fmaxf(b[j], 0.f); b[j] *= b[j]; }
                    u32x4 o; o.x = cvt_pk_bf16(a[0], a[1]); o.y = cvt_pk_bf16(a[2], a[3]); o.z = cvt_pk_bf16(b[0], b[1]); o.w = cvt_pk_bf16(b[2], b[3]);
                    *(u32x4*)(H + (size_t)row * 4096 + col0 + 128 * bj) = o; } }
    }
};
}
#include <hip/hip_bf16.h>
#include <cmath>
namespace attn_body {
using bf16=__hip_bfloat16;
using bf16x8=__attribute__((ext_vector_type(8)))short;
using s16x4=__attribute__((ext_vector_type(4)))short;
using f32x16=__attribute__((ext_vector_type(16)))float;
using u32x4=__attribute__((ext_vector_type(4)))unsigned;
using f32x4v=__attribute__((ext_vector_type(4)))float;
constexpr int BATCH=2,NHEAD=8,SEQ=8192,D=64,DM=NHEAD*D,ODM=1024;
constexpr int NW=8,QBLK=32,QB=QBLK*NW,KVBLK=64,NQB=SEQ/QB;
constexpr int ATTN_PITCH=DM, ATTN_UNIT_ROWS=QB;
__device__ __forceinline__ int crow(int r,int hi){return (r&3)+8*(r>>2)+4*hi;}
#define SBAR() __builtin_amdgcn_sched_barrier(0)
__device__ __forceinline__ void cmask(f32x16&p0,f32x16&p1,int jb,int qrel,int hi){
  const float NEG=-INFINITY; int kb=64*jb+4*hi;
  #pragma unroll
  for(int r=0;r<16;++r){int kv=kb+(r&3)+8*(r>>2); if(kv>qrel)p0[r]=NEG; if(kv+32>qrel)p1[r]=NEG;}
}

constexpr int NSLOT=3, SLOTB=8192;
constexpr int LDS_K=0, LDS_V=NSLOT*SLOTB, LDS_WS=2*NSLOT*SLOTB, LDS_OST=LDS_WS+NW*64*4, LDS_BYTES=LDS_OST+NW*4096, LDS_DK=86016, LDS_END=LDS_DK+SEQ*4;
constexpr float C2=0.125f*1.4426950408889634f;
__device__ __forceinline__ void glds16(const void*gsrc,unsigned lds_dst){unsigned keep;
  asm volatile("s_mov_b32 %0, m0\n\ts_mov_b32 m0, %2\n\ts_nop 0\n\tglobal_load_lds_dwordx4 %1, off\n\ts_mov_b32 m0, %0":"=&s"(keep):"v"(gsrc),"s"(lds_dst):"memory");}
__device__ __forceinline__ float max3f(float a,float b,float c){float r;asm("v_max3_f32 %0, %1, %2, %3":"=v"(r):"v"(a),"v"(b),"v"(c));return r;}
__device__ __forceinline__ float max2f(float a,float b){float r;asm("v_max_f32_e32 %0, %1, %2":"=v"(r):"v"(a),"v"(b));return r;}
__device__ __forceinline__ float fadd_s(float a,float b){float r;asm("v_add_f32_e32 %0, %1, %2":"=v"(r):"v"(a),"v"(b));return r;}
__device__ __forceinline__ float fsub_s(float a,float b){float r;asm("v_sub_f32_e32 %0, %1, %2":"=v"(r):"v"(a),"v"(b));return r;}
typedef float f32x2_t __attribute__((ext_vector_type(2))); typedef __bf16 bf16x2_t __attribute__((ext_vector_type(2)));
__device__ __forceinline__ unsigned cvtpk_s(float lo,float hi){f32x2_t v={lo,hi};bf16x2_t b=__builtin_convertvector(v,bf16x2_t);return __builtin_bit_cast(unsigned,b);}
#define WAIT_BAR(N) asm volatile("s_waitcnt vmcnt(" #N ") lgkmcnt(0)\n\ts_barrier":::"memory")

__device__ __forceinline__ void qkt(f32x16&p0,f32x16&p1,const char*Kslot,const bf16x8*qr,int r32,int hi){
  const char*kb=Kslot+hi*1024+r32*16;
  #pragma unroll
  for(int d0=0;d0<4;++d0){
    const bf16x8 b0=*reinterpret_cast<const bf16x8*>(kb+d0*2048);
    const bf16x8 b1=*reinterpret_cast<const bf16x8*>(kb+d0*2048+512);
    {p0=__builtin_amdgcn_mfma_f32_32x32x16_bf16(b0,qr[d0],p0,0,0,0);p1=__builtin_amdgcn_mfma_f32_32x32x16_bf16(b1,qr[d0],p1,0,0,0);}}
}
typedef __attribute__((address_space(3))) const char* lds_cptr;
typedef short v4i16_t __attribute__((ext_vector_type(4)));
__device__ __forceinline__ void kload8(bf16x8*kf,lds_cptr kp){
  kf[0]=*(const __attribute__((address_space(3))) bf16x8*)(kp);      kf[1]=*(const __attribute__((address_space(3))) bf16x8*)(kp+512);
  kf[2]=*(const __attribute__((address_space(3))) bf16x8*)(kp+2048); kf[3]=*(const __attribute__((address_space(3))) bf16x8*)(kp+2560);
  kf[4]=*(const __attribute__((address_space(3))) bf16x8*)(kp+4096); kf[5]=*(const __attribute__((address_space(3))) bf16x8*)(kp+4608);
  kf[6]=*(const __attribute__((address_space(3))) bf16x8*)(kp+6144); kf[7]=*(const __attribute__((address_space(3))) bf16x8*)(kp+6656);
}
__device__ __forceinline__ void kload2(bf16x8*kf,lds_cptr kp,int j){ kf[2*j]=*(const __attribute__((address_space(3))) bf16x8*)(kp+j*2048); kf[2*j+1]=*(const __attribute__((address_space(3))) bf16x8*)(kp+j*2048+512); }
__device__ __forceinline__ s16x4 vtr(lds_cptr p){ return __builtin_bit_cast(s16x4,__builtin_amdgcn_ds_read_tr16_b64_v4i16((__attribute__((address_space(3))) v4i16_t*)p)); }
__device__ __forceinline__ float rowmax(const f32x16&p0,const f32x16&p1){
  float a=max3f(p0[0],p0[1],p1[0]),b=max3f(p0[2],p0[3],p1[1]);a=max3f(a,p1[2],p1[3]);
  #pragma unroll
  for(int r=4;r<16;r+=4){a=max3f(a,p0[r],p0[r+1]);b=max3f(b,p0[r+2],p0[r+3]);a=max3f(a,p1[r],p1[r+1]);b=max3f(b,p1[r+2],p1[r+3]);}
  const float m=max2f(a,b);
  auto rr=__builtin_amdgcn_permlane32_swap(__float_as_uint(m),__float_as_uint(m),false,false);
  return max2f(__uint_as_float(rr[0]),__uint_as_float(rr[1]));
}
__device__ __forceinline__ void pv(f32x16*o,int vb,bf16x8 pa0,bf16x8 pa1,bf16x8 pa2,bf16x8 pa3){
  #pragma unroll
  for(int d0=0;d0<2;++d0){s16x4 lo[4],hi[4];
    #pragma unroll
    for(int ks=0;ks<4;++ks){
      asm volatile("ds_read_b64_tr_b16 %0,%1 offset:%c2":"=&v"(lo[ks]):"v"(vb),"i"(d0*4096+ks*1024):"memory");
      asm volatile("ds_read_b64_tr_b16 %0,%1 offset:%c2":"=&v"(hi[ks]):"v"(vb),"i"(d0*4096+ks*1024+512):"memory");}
    asm volatile("s_waitcnt lgkmcnt(0)":::"memory");SBAR();
    #define PK(k) (bf16x8){lo[k][0],lo[k][1],lo[k][2],lo[k][3],hi[k][0],hi[k][1],hi[k][2],hi[k][3]}
    o[d0]=__builtin_amdgcn_mfma_f32_32x32x16_bf16(pa0,PK(0),o[d0],0,0,0);
    o[d0]=__builtin_amdgcn_mfma_f32_32x32x16_bf16(pa1,PK(1),o[d0],0,0,0);
    o[d0]=__builtin_amdgcn_mfma_f32_32x32x16_bf16(pa2,PK(2),o[d0],0,0,0);
    o[d0]=__builtin_amdgcn_mfma_f32_32x32x16_bf16(pa3,PK(3),o[d0],0,0,0);
    #undef PK
  }
}

#ifndef ATTN_STORE16
#define ATTN_STORE16(p,v) (*(u32x4*)(p)=(v))
#endif
template<int THRL> __device__ __forceinline__ void attn_unit(int b,int h,int qb,int NT,const bf16*Q,const bf16*__restrict__ K,const bf16*__restrict__ V,bf16*O,char*shm){
  int tid_o=threadIdx.x; asm volatile("":"+v"(tid_o));
  const int tid=tid_o,lane=tid&63,r32=lane&31,hi=lane>>5; const int wid=__builtin_amdgcn_readfirstlane(tid>>6);
  const long rowbase=(long)b*SEQ; const int q0=qb*QB;
  const bf16*Qw=Q+(rowbase+q0+wid*QBLK)*DM+h*D;
  const bf16*Kh=K+rowbase*DM+h*D,*Vh=V+rowbase*DM+h*D;
  const unsigned lds0=(unsigned)(uintptr_t)shm;
  float*wsf=(float*)(shm+LDS_WS)+wid*64;
  const bf16*ksrc=Kh+(long)lane*DM+wid*8;
  const bf16*vsrc=Vh+(long)(16*(wid&3)+(lane>>2))*DM+(wid>>2)*32+(lane&3)*8;
  const unsigned kdst=lds0+LDS_K+wid*1024, vdst=lds0+LDS_V+wid*1024;
  #define TA(t) (((t)<4)?(NTA-4+(t)):(NTA-1-(t)))
  #define DMA_K(t,slot) glds16(ksrc+(long)TA(t)*KVBLK*DM,(unsigned)__builtin_amdgcn_readfirstlane(kdst+(slot)))
  #define DMA_V(t,slot) glds16(vsrc+(long)TA(t)*KVBLK*DM,(unsigned)__builtin_amdgcn_readfirstlane(vdst+(slot)))
  const int vb0=(int)(lds0+LDS_V)+((lane>>4)&1)*32+(lane&3)*8+(4*hi+((lane&15)>>2))*64;
  const char*Kbase=shm+LDS_K; bf16x8 kf[8];
  const lds_cptr shm3=(lds_cptr)shm; const lds_cptr kp0=shm3+LDS_K+hi*1024+r32*16; const lds_cptr vp0=shm3+LDS_V+((lane>>4)&1)*32+(lane&3)*8+(4*hi+((lane&15)>>2))*64;
  const int NTA=(q0+QB)/KVBLK;
  typedef __attribute__((address_space(3))) const f32x4v* dk_cptr; const dk_cptr dkp=(dk_cptr)(shm3+LDS_DK+hi*16);
  #define CINIT1(C0,t,o8) do{ const dk_cptr dp_=dkp+TA(t)*16+(o8); _Pragma("unroll") for(int j_=0;j_<4;++j_){ const f32x4v a_=dp_[2*j_]; \
      C0[4*j_]=a_[0]+nmh;C0[4*j_+1]=a_[1]+nmh;C0[4*j_+2]=a_[2]+nmh;C0[4*j_+3]=a_[3]+nmh; } }while(0)
  #define CINIT(C0,C1,t) do{ CINIT1(C0,t,0); SBAR(); CINIT1(C1,t,8); }while(0)
  DMA_K(0,0);DMA_V(0,0);DMA_K(1,SLOTB);
  bf16x8 qr[4];
  #pragma unroll
  for(int d0=0;d0<4;++d0)qr[d0]=*reinterpret_cast<const bf16x8*>(&Qw[(long)r32*DM+d0*16+hi*8]);
  float mhat=0.f,l_reg=0.f,nmh=0.f;f32x16 o[2];o[0]=f32x16{};o[1]=f32x16{};
  const int qrel=wid*QBLK+r32;
  #define CMASK(P0,P1,t) do{int jb_=(t); if(jb_<4)cmask(P0,P1,jb_,qrel,hi);}while(0)
  bool resc=false;
  #define START(P0,P1) do{ const float rm=rowmax(P0,P1); resc=false; \
    { const float dl=rm; mhat=fadd_s(mhat,dl); \
      _Pragma("unroll") for(int r=0;r<16;++r){P0[r]=fsub_s(P0[r],dl);P1[r]=fsub_s(P1[r],dl);} \
      nmh=-mhat; } \
    _Pragma("unroll") for(int r=0;r<16;++r)P0[r]=__builtin_amdgcn_exp2f(P0[r]); }while(0)
  #define RESC() do{ if(resc){ asm volatile("s_waitcnt lgkmcnt(0)":::"memory"); \
      _Pragma("unroll") for(int d_=0;d_<2;++d_) _Pragma("unroll") for(int r=0;r<16;++r)o[d_][r]*=wsf[crow(r,hi)]; } }while(0)
  f32x16 pA0,pA1,pB0,pB1;
  int sl_prev=0,sl_cur=0,sl_next=SLOTB;
  #define ROT() do{sl_prev=sl_cur;sl_cur=sl_next;sl_next=(sl_next==(NSLOT-1)*SLOTB)?0:sl_next+SLOTB;}while(0)
  DMA_K(2,2*SLOTB);
  WAIT_BAR(3);
  CINIT(pA0,pA1,0); qkt(pA0,pA1,Kbase,qr,r32,hi);asm volatile("s_nop 15\n\ts_nop 7":"+v"(pA0),"+v"(pA1));CMASK(pA0,pA1,0);
  START(pA0,pA1);
  _Pragma("unroll") for(int r=0;r<16;++r)pA1[r]=__builtin_amdgcn_exp2f(pA1[r]);
  WAIT_BAR(0);
  DMA_K(3,0);DMA_V(1,SLOTB);
  ROT();
  kload8(kf,kp0+sl_cur);
  WAIT_BAR(2);
  s16x4 vlo[8],vhi[8]; u32x4 pw0,pw1,pw2,pw3;
  #define PKW(P,B) cvtpk_s(P[B],P[B+1])
  #define PAF(k) __builtin_bit_cast(bf16x8,pw##k)
  #define VFR(i) (bf16x8){vlo[i][0],vlo[i][1],vlo[i][2],vlo[i][3],vhi[i][0],vhi[i][1],vhi[i][2],vhi[i][3]}
  #define PIN(x) asm volatile("":"+v"(x))
  #define MX3(a,b,c) __builtin_fmaxf(__builtin_fmaxf((a),(b)),(c))
  #define GAPA(MF,A0,A1,A2,A3,W0,W1,PW) do{ MF; sacc+=A0; sacc+=A1; sacc+=A2; sacc+=A3; PIN(sacc); W0; W1; PIN(PW); SBAR(); }while(0)
  #define EX(v) __builtin_amdgcn_exp2f(v)
  #define GAPB(MF,X,B) do{ MF; X[B]=EX(X[B]); X[B+1]=EX(X[B+1]); X[B+2]=EX(X[B+2]); X[B+3]=EX(X[B+3]); PIN(X); SBAR(); }while(0)
  #define VRD(i) do{ vlo[i]=vtr(vp_+(((i)>>2)*4096+((i)&3)*1024)); vhi[i]=vtr(vp_+(((i)>>2)*4096+((i)&3)*1024+512)); }while(0)
  #define KRD(G,j) do{ if(G){ kload2(kf,kp0+sl_next,j); SBAR(); } }while(0)
  #define STEP(C0,C1,P0,P1,t,GK,GV,GL) do{ SBAR(); CINIT(C0,C1,t); SBAR(); \
    const lds_cptr vp_=vp0+sl_prev; \
    float sacc=(P0[0]+P0[1]); \
    GAPA(C0=__builtin_amdgcn_mfma_f32_32x32x16_bf16(kf[0],qr[0],C0,0,0,0), P0[2],P0[3],P0[4],P0[5],     pw0[0]=PKW(P0,0), pw0[1]=PKW(P0,2), pw0); \
    GAPA(C1=__builtin_amdgcn_mfma_f32_32x32x16_bf16(kf[1],qr[0],C1,0,0,0), P0[6],P0[7],P0[8],P0[9],     pw0[2]=PKW(P0,4), pw0[3]=PKW(P0,6), pw0); \
    GAPA(C0=__builtin_amdgcn_mfma_f32_32x32x16_bf16(kf[2],qr[1],C0,0,0,0),   P0[10],P0[11],P0[12],P0[13], pw1[0]=PKW(P0,8), pw1[1]=PKW(P0,10), pw1); \
    GAPA(C1=__builtin_amdgcn_mfma_f32_32x32x16_bf16(kf[3],qr[1],C1,0,0,0),   P0[14],P0[15],P1[0],P1[1],   pw1[2]=PKW(P0,12),pw1[3]=PKW(P0,14), pw1); \
    GAPA(C0=__builtin_amdgcn_mfma_f32_32x32x16_bf16(kf[4],qr[2],C0,0,0,0),   P1[2],P1[3],P1[4],P1[5],     pw2[0]=PKW(P1,0), pw2[1]=PKW(P1,2), pw2); \
    GAPA(C1=__builtin_amdgcn_mfma_f32_32x32x16_bf16(kf[5],qr[2],C1,0,0,0),   P1[6],P1[7],P1[8],P1[9],     pw2[2]=PKW(P1,4), pw2[3]=PKW(P1,6), pw2); \
    GAPA(C0=__builtin_amdgcn_mfma_f32_32x32x16_bf16(kf[6],qr[3],C0,0,0,0),   P1[10],P1[11],P1[12],P1[13], pw3[0]=PKW(P1,8), pw3[1]=PKW(P1,10), pw3); \
    GAPA(C1=__builtin_amdgcn_mfma_f32_32x32x16_bf16(kf[7],qr[3],C1,0,0,0),   P1[14],P1[15],0.f,0.f,       pw3[2]=PKW(P1,12),pw3[3]=PKW(P1,14), pw3); \
    l_reg+=sacc; VRD(0); VRD(4); \
    if(GK){DMA_K((t)+3,sl_cur);} if(GV){DMA_V((t)+1,sl_next);} \
    CMASK(C0,C1,t); \
    { float a=MX3(C0[0],C0[1],C1[0]),b=MX3(C0[2],C0[3],C1[1]); a=MX3(a,C1[2],C1[3]); \
      _Pragma("unroll") for(int r=4;r<16;r+=4){a=MX3(a,C0[r],C0[r+1]);b=MX3(b,C0[r+2],C0[r+3]);a=MX3(a,C1[r],C1[r+1]);b=MX3(b,C1[r+2],C1[r+3]);} \
      float rm=__builtin_fmaxf(a,b); { auto rr=__builtin_amdgcn_permlane32_swap(__float_as_uint(rm),__float_as_uint(rm),false,false); rm=__builtin_fmaxf(__uint_as_float(rr[0]),__uint_as_float(rr[1])); } \
      resc=false; \
      if(__builtin_expect(__any(rm>(float)THRL),0)){ const float dl=__builtin_fmaxf(rm,0.f); mhat+=dl; \
        _Pragma("unroll") for(int r=0;r<16;++r){C0[r]-=dl;C1[r]-=dl;} \
        nmh=-mhat; \
        const float f=__builtin_amdgcn_exp2f(-dl); l_reg*=f; if(hi==0)wsf[r32]=f; resc=true; } } \
    SBAR(); \
    VRD(1); GAPB(o[0]=__builtin_amdgcn_mfma_f32_32x32x16_bf16(PAF(0),VFR(0),o[0],0,0,0), C0,0); \
    VRD(5); GAPB(o[1]=__builtin_amdgcn_mfma_f32_32x32x16_bf16(PAF(0),VFR(4),o[1],0,0,0), C0,4); \
    KRD(GL,0); VRD(2); GAPB(o[0]=__builtin_amdgcn_mfma_f32_32x32x16_bf16(PAF(1),VFR(1),o[0],0,0,0), C0,8); \
    KRD(GL,1); VRD(6); GAPB(o[1]=__builtin_amdgcn_mfma_f32_32x32x16_bf16(PAF(1),VFR(5),o[1],0,0,0), C0,12); \
    KRD(GL,2); VRD(3); GAPB(o[0]=__builtin_amdgcn_mfma_f32_32x32x16_bf16(PAF(2),VFR(2),o[0],0,0,0), C1,0); \
    KRD(GL,3); VRD(7); GAPB(o[1]=__builtin_amdgcn_mfma_f32_32x32x16_bf16(PAF(2),VFR(6),o[1],0,0,0), C1,4); \
    GAPB(o[0]=__builtin_amdgcn_mfma_f32_32x32x16_bf16(PAF(3),VFR(3),o[0],0,0,0), C1,8); \
    GAPB(o[1]=__builtin_amdgcn_mfma_f32_32x32x16_bf16(PAF(3),VFR(7),o[1],0,0,0), C1,12); \
    }while(0)
  int t=1;
  #define ENDW(tt) do{ if((tt)+3<NT){WAIT_BAR(2);} else if((tt)+2<NT){WAIT_BAR(1);} else {WAIT_BAR(0);} }while(0)
  for(;t+1<NT;t+=2){
    STEP(pB0,pB1,pA0,pA1,t,(t+3<NT),(t+1<NT),(t+1<NT));       ENDW(t);   RESC(); ROT();
    STEP(pA0,pA1,pB0,pB1,t+1,(t+4<NT),(t+2<NT),(t+2<NT));     ENDW(t+1); RESC(); ROT();
  }
  STEP(pB0,pB1,pA0,pA1,NT-1,false,false,false); RESC();
  { float sacc=pB0[0]+pB0[1]; _Pragma("unroll") for(int r=2;r<16;++r)sacc+=pB0[r]; _Pragma("unroll") for(int r=0;r<16;++r)sacc+=pB1[r]; l_reg+=sacc;
    pw0=(u32x4){PKW(pB0,0),PKW(pB0,2),PKW(pB0,4),PKW(pB0,6)};pw1=(u32x4){PKW(pB0,8),PKW(pB0,10),PKW(pB0,12),PKW(pB0,14)};pw2=(u32x4){PKW(pB1,0),PKW(pB1,2),PKW(pB1,4),PKW(pB1,6)};pw3=(u32x4){PKW(pB1,8),PKW(pB1,10),PKW(pB1,12),PKW(pB1,14)};
    SBAR(); pv(o,vb0+sl_cur,PAF(0),PAF(1),PAF(2),PAF(3)); }
  #undef PKW
  #undef PAF
  #undef VFR
  #undef PIN
  #undef MX3
  #undef GAPA
  #undef GAPB
  #undef EX
  #undef VRD
  #undef KRD
  #undef STEP
  #undef ENDW
  {auto rr=__builtin_amdgcn_permlane32_swap(__float_as_uint(l_reg),__float_as_uint(l_reg),false,false);l_reg=__uint_as_float(rr[0])+__uint_as_float(rr[1]);}
  if(hi==0)wsf[32+r32]=l_reg;asm volatile("s_waitcnt lgkmcnt(0)":::"memory");
  float rli[16];
  #pragma unroll
  for(int r=0;r<16;++r)rli[r]=__builtin_amdgcn_rcpf(wsf[32+crow(r,hi)]);
  bf16*Ow=O+(rowbase+q0+wid*QBLK)*ODM+h*D;
  { bf16*stg=(bf16*)(shm+LDS_OST)+wid*2048;
    #pragma unroll
    for(int r=0;r<16;++r){const int orow=crow(r,hi);
      #pragma unroll
      for(int d0=0;d0<2;++d0)stg[orow*64+d0*32+r32]=__float2bfloat16(o[d0][r]*rli[r]);}
    asm volatile("s_waitcnt lgkmcnt(0)":::"memory");
    #pragma unroll
    for(int i=0;i<4;++i){const int row=i*8+(lane>>3),ch=lane&7; const u32x4 v=*(const u32x4*)(stg+row*64+ch*8); ATTN_STORE16(Ow+(long)row*ODM+ch*8,v);} }
  asm volatile("s_waitcnt lgkmcnt(0)\n\ts_barrier":::"memory");
  #undef DMA_K
  #undef TA
  #undef CINIT
  #undef CINIT1
  #undef DMA_V
  #undef CMASK
  #undef START
  #undef RESC
  #undef ROT
}
constexpr int ATTN_LDS_BYTES=LDS_END;
#undef SBAR
#undef WAIT_BAR
}
constexpr int NWAVES = 8, NTHREADS = 512;
constexpr int BATCH = 2, T = 8192, D = 1024, FF = 4096, M = BATCH * T, DEPTH = 2;
constexpr int IN_COLS = 3592, NIN = 3840;
constexpr size_t MiB = 1u << 20;
constexpr size_t WS_CTL = 0, CTL_ZERO_BYTES = 1 * MiB;
constexpr size_t WS_SSQ = 64 * 1024;
constexpr size_t WS_LSIG = 512 * 1024;
constexpr size_t WS_WIN = 1 * MiB, WIN_BYTES = (size_t)NIN * D * 2;
constexpr size_t WS_WOUT = 16 * MiB, WS_WUP = 20 * MiB, WS_WDN = 36 * MiB;
constexpr size_t WS_XB = 52 * MiB;
constexpr size_t WS_ST = 84 * MiB;
constexpr size_t WS_HQ = 116 * MiB, WS_LF = 132 * MiB, WS_HV = 164 * MiB, WS_HG = 180 * MiB, WS_Q = 196 * MiB, WS_K = 212 * MiB, WS_V = 228 * MiB, WS_END = 244 * MiB;
constexpr size_t WS_H = 116 * MiB;
constexpr size_t WS_DL = 244 * MiB;
constexpr int LDS_BYTES = 147456;

#define GAS __attribute__((address_space(1)))
#define LAS __attribute__((address_space(3)))
typedef unsigned short bf16;
typedef unsigned v4u __attribute__((ext_vector_type(4)));
typedef float f32x4 __attribute__((ext_vector_type(4)));
typedef float f32x16 __attribute__((ext_vector_type(16)));
typedef short bf16x8 __attribute__((ext_vector_type(8)));
#define LDS_WAIT() asm volatile("s_waitcnt lgkmcnt(0)" ::: "memory")
__device__ __forceinline__ unsigned f2bf(float f) { unsigned u = __builtin_bit_cast(unsigned, f); return (u + 0x7fffu + ((u >> 16) & 1u)) >> 16; }
__device__ __forceinline__ unsigned pk2(float lo, float hi) { return f2bf(lo) | (f2bf(hi) << 16); }
__device__ __forceinline__ float bf2f(unsigned short b) { return __builtin_bit_cast(float, (unsigned)b << 16); }
__device__ __forceinline__ int crow16(int r, int hi) { return (r & 3) + 8 * (r >> 2) + 4 * hi; }

struct Frame {
    LAS unsigned char* lds; int tid, lane, wave, vcu, G;
};
__device__ __forceinline__ float wave_sum(float v) {
#pragma unroll
    for (int o = 1; o < 64; o <<= 1) v += __shfl_xor(v, o);
    return v;
}
__device__ __forceinline__ void p0_transpose_item(const float* W, int pitch, int K, const float* sc, bf16* WT, int dst_row0, int k0, int n0, LAS float* scr, int lane) {
#pragma unroll 8
    for (int i = 0; i < 32; ++i) { const int kk = 2 * i + (lane >> 5); float v = W[(size_t)(k0 + kk) * pitch + n0 + (lane & 31)]; if (sc) v *= sc[k0 + kk]; scr[kk * 33 + (lane & 31)] = v; }
    LDS_WAIT(); asm volatile("" ::: "memory");
    const int c = lane & 7;
#pragma unroll
    for (int j = 0; j < 4; ++j) { const int n = (lane >> 3) + 8 * j; const LAS float* s = scr + (8 * c) * 33 + n;
        v4u o; o.x = pk2(s[0 * 33], s[1 * 33]); o.y = pk2(s[2 * 33], s[3 * 33]); o.z = pk2(s[4 * 33], s[5 * 33]); o.w = pk2(s[6 * 33], s[7 * 33]);
        *(GAS v4u*)(WT + (size_t)(dst_row0 + n) * K + k0 + 8 * c) = o; }
    LDS_WAIT(); asm volatile("" ::: "memory");
}
__device__ __forceinline__ int map_in_row(int n) {
    if (n < 2048 || n >= 3072) return n;
    const int local = n - 2048, tile = local >> 8, o = local & 255, wc = o >> 6, w = o & 63, bj = w >> 5, x = w & 31;
    return 2048 + tile * 256 + bj * 128 + wc * 32 + x;
}
struct Ptrs {
    const float *x, *lower_bounds, *norm1_w, *w_in, *fox_f_bias, *q_norm_w, *k_norm_w, *hgrn_norm_w, *w_out, *norm2_w, *w_up, *w_down;
    float* out; unsigned char* ws;
};
__device__ __forceinline__ void p0_prologue(Frame& F, const Ptrs& P) {
    LAS float* scr = (LAS float*)(F.lds + F.wave * 16384);
    const int gw = F.vcu * NWAVES + F.wave, NGW = F.G * NWAVES;
    constexpr int I_IN = 16 * 112, I_OUT = 16 * 32, I_UP = 16 * 128, I_DN = 64 * 32, I_L = I_IN + I_OUT + I_UP + I_DN;
    for (int it = gw; it < DEPTH * I_L; it += NGW) {
        const int l = it / I_L; int r = it % I_L;
        if (r < I_IN) { const int kb = r / 112, nb = r % 112; p0_transpose_item(P.w_in + (size_t)l * D * IN_COLS, IN_COLS, D, P.norm1_w + l * D, (bf16*)(P.ws + WS_WIN + l * WIN_BYTES), map_in_row(32 * nb), 64 * kb, 32 * nb, scr, F.lane); continue; } r -= I_IN;
        if (r < I_OUT) { const int kb = r / 32, nb = r % 32; p0_transpose_item(P.w_out + (size_t)l * D * D, D, D, nullptr, (bf16*)(P.ws + WS_WOUT + l * 2 * MiB), 32 * nb, 64 * kb, 32 * nb, scr, F.lane); continue; } r -= I_OUT;
        if (r < I_UP) { const int kb = r / 128, nb = r % 128; p0_transpose_item(P.w_up + (size_t)l * D * FF, FF, D, P.norm2_w + l * D, (bf16*)(P.ws + WS_WUP + l * 8 * MiB), 32 * nb, 64 * kb, 32 * nb, scr, F.lane); continue; } r -= I_UP;
        { const int kb = r / 32, nb = r % 32; p0_transpose_item(P.w_down + (size_t)l * FF * D, D, FF, nullptr, (bf16*)(P.ws + WS_WDN + l * 8 * MiB), 32 * nb, 64 * kb, 32 * nb, scr, F.lane); }
    }
    { const int gt = F.vcu * NTHREADS + F.tid;
      for (int e = gt; e < DEPTH * 256 * 128; e += F.G * NTHREADS) { const int l = e >> 15, j = (e >> 7) & 255, kc = e & 127; float v[8];
#pragma unroll
          for (int i = 0; i < 8; ++i) v[i] = (j < 8) ? P.w_in[(size_t)l * D * IN_COLS + (size_t)(8 * kc + i) * IN_COLS + 3584 + j] * P.norm1_w[l * D + 8 * kc + i] : 0.f;
          v4u o; o.x = pk2(v[0], v[1]); o.y = pk2(v[2], v[3]); o.z = pk2(v[4], v[5]); o.w = pk2(v[6], v[7]);
          *(GAS v4u*)((bf16*)(P.ws + WS_WIN + l * WIN_BYTES) + (size_t)(3584 + j) * D + 8 * kc) = o; } }
    bf16* XB = (bf16*)(P.ws + WS_XB); float* ssq = (float*)(P.ws + WS_SSQ);
    for (int m = gw; m < M; m += NGW) { const GAS f32x4* xr = (const GAS f32x4*)(P.x + (size_t)m * D) + F.lane; f32x4 v[4]; float s = 0.f;
#pragma unroll
        for (int j = 0; j < 4; ++j) { v[j] = xr[64 * j]; s += (v[j].x * v[j].x + v[j].y * v[j].y) + (v[j].z * v[j].z + v[j].w * v[j].w); }
        s = wave_sum(s); if (F.lane == 0) ssq[m] = s;
        GAS unsigned long long* o8 = (GAS unsigned long long*)(XB + (size_t)m * D) + F.lane;
#pragma unroll
        for (int j = 0; j < 4; ++j) o8[64 * j] = (unsigned long long)pk2(v[j].x, v[j].y) | ((unsigned long long)pk2(v[j].z, v[j].w) << 32); }
}

constexpr int HC = 64, NCH = T / HC;
constexpr int H_KD = 0, H_QE = 0, H_QM = 17408, H_KM = 34816, H_VT = 52224, H_AM = 70656, H_OS = 79872, H_TOT = 113664, H_BM = 115712;
__device__ __forceinline__ f32x16 mfma32(bf16x8 a, bf16x8 b, f32x16 c) { return __builtin_amdgcn_mfma_f32_32x32x16_bf16(a, b, c, 0, 0, 0); }
#define HGRN_SCAN(lfv, bv, blast)  \
    float lfv[16], bv[16]; float blast; { const float* lfp = lf + (size_t)(m0 + part * 16) * 512 + h * 128 + k; \
      _Pragma("unroll") for (int i = 0; i < 16; ++i) lfv[i] = lfp[(size_t)i * 512]; \
      float run = 0.f; _Pragma("unroll") for (int i = 0; i < 16; ++i) { run += lfv[i]; bv[i] = run; } \
      LAS float* TOT = (LAS float*)(F.lds + H_TOT); TOT[part * 128 + k] = run; __syncthreads(); \
      const float t0 = TOT[k], t1 = TOT[128 + k], t2 = TOT[256 + k], t3 = TOT[384 + k]; \
      const float off = (part > 0 ? t0 : 0.f) + (part > 1 ? t1 : 0.f) + (part > 2 ? t2 : 0.f); blast = (t0 + t1) + (t2 + t3); \
      _Pragma("unroll") for (int i = 0; i < 16; ++i) bv[i] += off; }
#define HGRN_VT() { const bf16* vp = hv + (size_t)(m0 + part * 16) * 512 + h * 128 + k; unsigned w_[8]; \
      _Pragma("unroll") for (int i = 0; i < 8; ++i) w_[i] = (unsigned)vp[(size_t)(2 * i) * 512] | ((unsigned)vp[(size_t)(2 * i + 1) * 512] << 16); \
      LAS v4u* d_ = (LAS v4u*)(F.lds + H_VT + k * 144 + part * 32); d_[0] = (v4u){w_[0], w_[1], w_[2], w_[3]}; d_[1] = (v4u){w_[4], w_[5], w_[6], w_[7]}; }
__device__ __forceinline__ void hgrn_pass_a(Frame& F, const float* lf, const bf16* hv, bf16* ST, float* DL) {
    const int k = F.tid & 127, part = F.tid >> 7, l31 = F.lane & 31, hi = F.lane >> 5;
    for (int it = F.vcu; it < 8 * NCH; it += F.G) {
        const int bh = it >> 7, c = it & 127, b = bh >> 2, h = bh & 3; const int m0 = b * T + c * HC;
        HGRN_SCAN(lfv, bv, blast)
        { unsigned w_[8];
#pragma unroll
          for (int i = 0; i < 8; ++i) { const float a0 = (1.0f - __expf(lfv[2 * i])) * __expf(blast - bv[2 * i]), a1 = (1.0f - __expf(lfv[2 * i + 1])) * __expf(blast - bv[2 * i + 1]); w_[i] = pk2(a0, a1); }
          LAS v4u* d_ = (LAS v4u*)(F.lds + H_KD + k * 144 + part * 32); d_[0] = (v4u){w_[0], w_[1], w_[2], w_[3]}; d_[1] = (v4u){w_[4], w_[5], w_[6], w_[7]}; }
        if (part == 0) DL[(size_t)it * 128 + k] = __expf(blast);
        HGRN_VT()
        __syncthreads();
        const int mt = F.wave >> 1, nt0 = (F.wave & 1) * 2; f32x16 a0 = {}, a1 = {};
#pragma unroll
        for (int ks = 0; ks < 4; ++ks) { const bf16x8 av = *(const LAS bf16x8*)(F.lds + H_VT + (32 * mt + l31) * 144 + (16 * ks + 8 * hi) * 2);
            const bf16x8 b0 = *(const LAS bf16x8*)(F.lds + H_KD + (32 * nt0 + l31) * 144 + (16 * ks + 8 * hi) * 2), b1 = *(const LAS bf16x8*)(F.lds + H_KD + (32 * nt0 + 32 + l31) * 144 + (16 * ks + 8 * hi) * 2);
            a0 = mfma32(av, b0, a0); a1 = mfma32(av, b1, a1); }
        bf16* U = ST + (size_t)it * 16384;
#pragma unroll
        for (int r = 0; r < 16; ++r) { const int v = 32 * mt + crow16(r, hi); U[v * 128 + 32 * nt0 + l31] = (bf16)f2bf(a0[r]); U[v * 128 + 32 * nt0 + 32 + l31] = (bf16)f2bf(a1[r]); }
        __syncthreads();
    }
}
__device__ __forceinline__ void hgrn_pass_b(Frame& F, bf16* ST, const float* DL) {
    if (F.tid >= 256) return;
    for (int e = F.vcu * 256 + F.tid; e < 8 * 8192; e += F.G * 256) {
        const int bh = e >> 13, rem = e & 8191, k = (rem & 63) * 2;
        unsigned* up = (unsigned*)(ST + (size_t)bh * NCH * 16384) + rem; const float* dp = DL + (size_t)bh * NCH * 128 + k;
        float s0 = 0.f, s1 = 0.f;
        for (int c0 = 0; c0 < NCH; c0 += 8) { unsigned u[8]; float d0[8], d1[8];
#pragma unroll
            for (int j = 0; j < 8; ++j) { u[j] = up[(size_t)(c0 + j) * 8192]; d0[j] = dp[(c0 + j) * 128]; d1[j] = dp[(c0 + j) * 128 + 1]; }
#pragma unroll
            for (int j = 0; j < 8; ++j) { up[(size_t)(c0 + j) * 8192] = pk2(s0, s1); s0 = d0[j] * s0 + bf2f((unsigned short)(u[j] & 0xffffu)); s1 = d1[j] * s1 + bf2f((unsigned short)(u[j] >> 16)); } }
    }
}
__device__ __forceinline__ void hgrn_pass_c(Frame& F, const bf16* hq, const float* lf, const bf16* hv, const bf16* hg, const bf16* ST, const float* nw, bf16* mix) {
    const int k = F.tid & 127, part = F.tid >> 7, l31 = F.lane & 31, hi = F.lane >> 5;
    for (int it = F.vcu; it < 8 * NCH; it += F.G) {
        const int bh = it >> 7, c = it & 127, b = bh >> 2, h = bh & 3; const int m0 = b * T + c * HC;
        HGRN_SCAN(lfv, bv, blast)
        (void)blast;
        LAS float* BMID = (LAS float*)(F.lds + H_BM);
        if (part == 1) BMID[k] = bv[15];
        __syncthreads();
        const float bm = BMID[k];
        { const bf16* qp = hq + (size_t)(m0 + part * 16) * 512 + h * 128 + k;
#pragma unroll
          for (int i = 0; i < 16; ++i) { const int t = part * 16 + i; const float q = bf2f(qp[(size_t)i * 512]);
              *(LAS bf16*)(F.lds + H_QE + t * 272 + k * 2) = (bf16)f2bf(q * __expf(bv[i]));
              *(LAS bf16*)(F.lds + H_QM + t * 272 + k * 2) = (bf16)f2bf(q * __expf(fminf(bv[i] - bm, 80.f)));
              *(LAS bf16*)(F.lds + H_KM + t * 272 + k * 2) = (bf16)f2bf((1.0f - __expf(lfv[i])) * __expf(fminf(bm - bv[i], 80.f))); } }
        HGRN_VT()
        __syncthreads();
        const int mt = F.wave >> 2, nt = F.wave & 3; f32x16 acc = {};
        { const bf16* sp = ST + (size_t)it * 16384 + (size_t)(32 * nt + l31) * 128 + 8 * hi;
#pragma unroll
          for (int ks = 0; ks < 8; ++ks) { const bf16x8 av = *(const LAS bf16x8*)(F.lds + H_QE + (32 * mt + l31) * 272 + (16 * ks + 8 * hi) * 2); const bf16x8 bvv = *(const bf16x8*)(sp + 16 * ks); acc = mfma32(av, bvv, acc); } }
        if (F.wave < 4) { const int mt2 = F.wave >> 1, nt2 = F.wave & 1; f32x16 am = {};
#pragma unroll
            for (int ks = 0; ks < 8; ++ks) { const bf16x8 av = *(const LAS bf16x8*)(F.lds + H_QM + (32 * mt2 + l31) * 272 + (16 * ks + 8 * hi) * 2), bvv = *(const LAS bf16x8*)(F.lds + H_KM + (32 * nt2 + l31) * 272 + (16 * ks + 8 * hi) * 2); am = mfma32(av, bvv, am); }
#pragma unroll
            for (int r = 0; r < 16; ++r) { const int t = 32 * mt2 + crow16(r, hi), s = 32 * nt2 + l31; *(LAS bf16*)(F.lds + H_AM + t * 144 + s * 2) = (bf16)f2bf(s <= t ? am[r] : 0.f); } }
        __syncthreads();
#pragma unroll
        for (int ks = 0; ks < 4; ++ks) { const bf16x8 av = *(const LAS bf16x8*)(F.lds + H_AM + (32 * mt + l31) * 144 + (16 * ks + 8 * hi) * 2), bvv = *(const LAS bf16x8*)(F.lds + H_VT + (32 * nt + l31) * 144 + (16 * ks + 8 * hi) * 2); acc = mfma32(av, bvv, acc); }
#pragma unroll
        for (int r = 0; r < 16; ++r) *(LAS float*)(F.lds + H_OS + (32 * mt + crow16(r, hi)) * 528 + (32 * nt + l31) * 4) = acc[r];
        __syncthreads();
        { const int t = F.tid >> 3, seg = F.tid & 7; f32x4 o[4]; float ss = 0.f;
#pragma unroll
          for (int j = 0; j < 4; ++j) { o[j] = *(const LAS f32x4*)(F.lds + H_OS + t * 528 + (seg * 16 + 4 * j) * 4); ss += (o[j][0] * o[j][0] + o[j][1] * o[j][1]) + (o[j][2] * o[j][2] + o[j][3] * o[j][3]); }
          ss += __shfl_xor(ss, 1); ss += __shfl_xor(ss, 2); ss += __shfl_xor(ss, 4);
          const float rs = rsqrtf(ss * (1.0f / 128.0f) + 1e-6f);
          const v4u g0 = *(const v4u*)(hg + (size_t)(m0 + t) * 512 + h * 128 + seg * 16), g1 = *(const v4u*)(hg + (size_t)(m0 + t) * 512 + h * 128 + seg * 16 + 8);
          const unsigned gw_[8] = {g0.x, g0.y, g0.z, g0.w, g1.x, g1.y, g1.z, g1.w}; unsigned w_[8];
#pragma unroll
          for (int j = 0; j < 4; ++j) { const f32x4 wv = *(const f32x4*)(nw + seg * 16 + 4 * j);
              const float e0 = o[j][0] * rs * wv[0] * bf2f((unsigned short)(gw_[2 * j] & 0xffffu)), e1 = o[j][1] * rs * wv[1] * bf2f((unsigned short)(gw_[2 * j] >> 16));
              const float e2 = o[j][2] * rs * wv[2] * bf2f((unsigned short)(gw_[2 * j + 1] & 0xffffu)), e3 = o[j][3] * rs * wv[3] * bf2f((unsigned short)(gw_[2 * j + 1] >> 16));
              w_[2 * j] = pk2(e0, e1); w_[2 * j + 1] = pk2(e2, e3); }
          v4u* op = (v4u*)(mix + (size_t)(m0 + t) * 1024 + h * 128 + seg * 16); op[0] = (v4u){w_[0], w_[1], w_[2], w_[3]}; op[1] = (v4u){w_[4], w_[5], w_[6], w_[7]}; }
        __syncthreads();
    }
}
#ifndef FOX_SKIP
#define FOX_SKIP 1
#endif
__device__ __forceinline__ void fox_phase(Frame& F, unsigned char* lds_generic, const float* lsig, const bf16* Q, const bf16* Kb, const bf16* V, bf16* mix) {
    using attn_body::LDS_DK; using attn_body::LDS_WS; using attn_body::attn_unit;
    LAS float* dk = (LAS float*)(F.lds + LDS_DK);
    LAS double* wtot = (LAS double*)(F.lds + LDS_WS);
    for (int pr = F.vcu; pr < 256; pr += F.G) {
        const int bh = pr >> 4, s = pr & 15, b = bh >> 3, h = bh & 7;
        { int tid_ = F.tid; asm volatile("" : "+v"(tid_)); const int lane_ = tid_ & 63;
          const float* lp = lsig + ((size_t)b * T + tid_ * 16) * 8 + h; double v[16]; double run = 0.0;
#pragma unroll
          for (int i = 0; i < 16; ++i) { run -= (double)lp[i * 8]; v[i] = run; }
          double inc = run;
#pragma unroll
          for (int o = 1; o < 64; o <<= 1) { const double t = __shfl_up(inc, o); if (lane_ >= o) inc += t; }
          if (lane_ == 63) wtot[F.wave] = inc;
          __syncthreads();
          double off = inc - run;
          for (int w = 0; w < F.wave; ++w) off += wtot[w];
#pragma unroll
          for (int i = 0; i < 16; ++i) dk[tid_ * 16 + i] = (float)((v[i] + off) * 1.4426950408889634);
          __syncthreads(); }
#pragma unroll 1
        for (int i = 0; i < 2; ++i) {
            const int qb = (i == 0) ? 31 - s : s; const int NTA = 4 * qb + 4; int NT = NTA;
#if FOX_SKIP
            { const float ref = dk[qb * 256]; int lo = 0, hi_ = NTA - 4;
              while (lo < hi_) { const int mid = (lo + hi_) >> 1; if (dk[64 * mid + 63] - ref < -200.0f) lo = mid + 1; else hi_ = mid; }
              int nold = (NTA - 4) - lo; nold += (nold & 1); NT = 4 + nold; }
#endif
            attn_unit<8>(b, h, qb, NT, (const attn_body::bf16*)Q, (const attn_body::bf16*)Kb, (const attn_body::bf16*)V, (attn_body::bf16*)(mix + 512), (char*)lds_generic);
        }
        __syncthreads();
    }
}

struct Args { Ptrs p; int ph_lo, ph_hi; };
constexpr int N_PHASES = 1 + 7 * DEPTH;
__global__ void __launch_bounds__(NTHREADS, 2) hymba_fwd(Args args) {
    extern __shared__ __attribute__((aligned(16))) unsigned char lds[];
    Frame F; F.lds = (LAS unsigned char*)lds; F.tid = threadIdx.x; F.lane = F.tid & 63; F.wave = __builtin_amdgcn_readfirstlane(F.tid >> 6);
    F.G = gridDim.x; { const int bx = blockIdx.x; F.vcu = (F.G % 8 == 0) ? (bx % 8) * (F.G / 8) + bx / 8 : bx; }
    const Ptrs& P = args.p;
    const int lo = args.ph_lo, hi = args.ph_hi;
#define PHASE_ENV() int t__ = threadIdx.x; asm volatile("" : "+v"(t__)); F.tid = t__; F.lane = t__ & 63; unsigned char* ws = P.ws; asm volatile("" : "+s"(ws)); \
    float* ssq = (float*)(ws + WS_SSQ); float* lsig = (float*)(ws + WS_LSIG); \
    bf16* XB = (bf16*)(ws + WS_XB); bf16* ST = (bf16*)(ws + WS_ST); float* DL = (float*)(ws + WS_DL); \
    bf16* HQ = (bf16*)(ws + WS_HQ); float* LF = (float*)(ws + WS_LF); bf16* HV = (bf16*)(ws + WS_HV); bf16* HG = (bf16*)(ws + WS_HG); \
    bf16* Qb = (bf16*)(ws + WS_Q); bf16* Kb = (bf16*)(ws + WS_K); bf16* Vb = (bf16*)(ws + WS_V); bf16* HB = (bf16*)(ws + WS_H); \
    (void)ssq; (void)lsig; (void)XB; (void)ST; (void)DL; (void)HQ; (void)LF; (void)HV; (void)HG; (void)Qb; (void)Kb; (void)Vb; (void)HB;
#define IN(k) (lo <= (k) && (k) < hi)
#define SEAM(k) do { if (IN(k) && IN((k) + 1)) cg::this_grid().sync(); } while (0)
    if (IN(0)) { PHASE_ENV() p0_prologue(F, P); }
    SEAM(0);
#pragma unroll 1
    for (int l = 0; l < DEPTH; ++l) {
        const int pb = 1 + 7 * l;
        if (IN(pb)) { PHASE_ENV()
            pg8::Gemm g{XB, (const bf16*)(ws + WS_WIN + l * WIN_BYTES), M, NIN, D}; pg8::StaticOrder S; S.init(M, NIN, F.G, (int)blockIdx.x);
            pg8::EpiIn E{ssq + (size_t)(2 * l) * M, HQ, HV, HG, Qb, Kb, Vb, LF, lsig, P.lower_bounds, P.lower_bounds + 512, l, P.q_norm_w + l * 64, P.k_norm_w + l * 64, P.fox_f_bias + l * 8};
            pg8::gemm_phase<pg8::EpiIn, pg8::StaticOrder, true, true>(F.lds, g, S, E);
        }
        SEAM(pb);
        if (IN(pb + 1)) { PHASE_ENV()
            fox_phase(F, lds, lsig, Qb, Kb, Vb, XB);
            hgrn_pass_a(F, LF, HV, ST, DL);
        }
        SEAM(pb + 1);
        if (IN(pb + 2)) { PHASE_ENV() hgrn_pass_b(F, ST, DL); }
        SEAM(pb + 2);
        if (IN(pb + 3)) { PHASE_ENV() hgrn_pass_c(F, HQ, LF, HV, HG, ST, P.hgrn_norm_w + l * 128, XB); }
        SEAM(pb + 3);
        if (IN(pb + 4)) { PHASE_ENV()
            pg8::Gemm g{XB, (const bf16*)(ws + WS_WOUT + l * 2 * MiB), M, D, D}; pg8::StaticOrder S; S.init(M, D, F.G, (int)blockIdx.x);
            pg8::EpiRes E{l == 0 ? P.x : P.out, P.out, ST, ssq + (size_t)(2 * l + 1) * M};
            pg8::gemm_phase<pg8::EpiRes, pg8::StaticOrder, true, true>(F.lds, g, S, E);
        }
        SEAM(pb + 4);
        if (IN(pb + 5)) { PHASE_ENV()
            pg8::Gemm g{ST, (const bf16*)(ws + WS_WUP + l * 8 * MiB), M, FF, D}; pg8::StaticOrder S; S.init(M, FF, F.G, (int)blockIdx.x);
            pg8::EpiUp E{ssq + (size_t)(2 * l + 1) * M, HB};
            pg8::gemm_phase<pg8::EpiUp, pg8::StaticOrder, true, true>(F.lds, g, S, E);
        }
        SEAM(pb + 5);
        if (IN(pb + 6)) { PHASE_ENV()
            pg8::Gemm g{HB, (const bf16*)(ws + WS_WDN + l * 8 * MiB), M, D, FF}; pg8::StaticOrder S; S.init(M, D, F.G, (int)blockIdx.x);
            const bool last = (l == DEPTH - 1);
            pg8::EpiRes E{P.out, P.out, last ? nullptr : XB, last ? nullptr : ssq + (size_t)(2 * l + 2) * M};
            pg8::gemm_phase<pg8::EpiRes, pg8::StaticOrder, true, true>(F.lds, g, S, E);
        }
        SEAM(pb + 6);
    }
#undef IN
#undef SEAM
}

#ifndef MK_PER_PHASE
#define MK_PER_PHASE 0
#endif
extern "C" void kernel_launch(void* const* d_in, const int* in_sizes, int n_in, void* d_out, int out_size, void* d_ws, size_t ws_size, hipStream_t stream) {
    static int grid = 0;
    if (grid == 0) {
        if (n_in != 12 || out_size != M * D || ws_size < WS_DL + MiB) { fprintf(stderr, "kernel_launch: unexpected sizes (n_in %d out %d ws %zu)\n", n_in, out_size, ws_size); grid = -1; return; }
        int dev = 0, cus = 0, per_cu = 0;
        (void)hipGetDevice(&dev); (void)hipDeviceGetAttribute(&cus, hipDeviceAttributeMultiprocessorCount, dev);
        if (hipFuncSetAttribute((const void*)hymba_fwd, hipFuncAttributeMaxDynamicSharedMemorySize, LDS_BYTES) != hipSuccess) { fprintf(stderr, "kernel_launch: hipFuncSetAttribute failed\n"); grid = -1; return; }
        if (hipOccupancyMaxActiveBlocksPerMultiprocessor(&per_cu, (const void*)hymba_fwd, NTHREADS, LDS_BYTES) != hipSuccess || per_cu < 1) { fprintf(stderr, "kernel_launch: occupancy query gave %d\n", per_cu); per_cu = 1; }
        (void)hipGetLastError();
        grid = cus * 1;
        fprintf(stderr, "kernel_launch: cus %d per_cu %d grid %d\n", cus, per_cu, grid);
    }
    if (grid < 0) return;
    (void)hipMemsetAsync((char*)d_ws + WS_CTL, 0, CTL_ZERO_BYTES, stream);
    Args a{};
    a.p.x = (const float*)d_in[0]; a.p.lower_bounds = (const float*)d_in[1]; a.p.norm1_w = (const float*)d_in[2]; a.p.w_in = (const float*)d_in[3];
    a.p.fox_f_bias = (const float*)d_in[4]; a.p.q_norm_w = (const float*)d_in[5]; a.p.k_norm_w = (const float*)d_in[6]; a.p.hgrn_norm_w = (const float*)d_in[7];
    a.p.w_out = (const float*)d_in[8]; a.p.norm2_w = (const float*)d_in[9]; a.p.w_up = (const float*)d_in[10]; a.p.w_down = (const float*)d_in[11];
    a.p.out = (float*)d_out; a.p.ws = (unsigned char*)d_ws;
#if MK_PER_PHASE
    for (int ph = 0; ph < N_PHASES; ++ph) { a.ph_lo = ph; a.ph_hi = ph + 1; hipLaunchKernelGGL(hymba_fwd, dim3(grid), dim3(NTHREADS), LDS_BYTES, stream, a); }
#else
    a.ph_lo = 0; a.ph_hi = N_PHASES;
    void* kargs[] = {&a};
    const hipError_t e = hipLaunchCooperativeKernel((const void*)hymba_fwd, dim3(grid), dim3(NTHREADS), kargs, LDS_BYTES, stream);
    if (e != hipSuccess) fprintf(stderr, "kernel_launch: cooperative launch failed: %s (grid %d)\n", hipGetErrorString(e), grid);
#endif
}
```

```cpp
#include <hip/hip_runtime.h>
#include <hip/hip_cooperative_groups.h>
#include <cstdio>
#include <cstdint>
namespace cg = cooperative_groups;
namespace pg8 {
#define PG8_LAS __attribute__((address_space(3)))
typedef unsigned short bf16_t;
typedef short bf16x8 __attribute__((ext_vector_type(8)));
typedef float f32x4 __attribute__((ext_vector_type(4)));
typedef unsigned u32x4 __attribute__((ext_vector_type(4)));
constexpr int BM = 256, BK = 64, HALF = 128, HTB = HALF * BK * 2  , STAGE_BYTES = 8 * HTB, NXCD = 8, WGM = 8;

__host__ __device__ __forceinline__ int lds_byte(int r, int c) { const int st = (r >> 4) * 2 + (c >> 5), rr = r & 15, cc = c & 31, ob = rr * 64 + cc * 2; return st * 1024 + (ob ^ (((ob >> 9) & 1) << 5)); }
__host__ __device__ __forceinline__ void stage_rc(int b, int& R, int& C) { const int st = b / 1024, sb = b % 1024, swz = sb ^ (((sb >> 9) & 1) << 5); R = (st >> 1) * 16 + swz / 64; C = (st & 1) * 32 + (swz % 64) / 2; }
__host__ __device__ __forceinline__ int perm32(int rho) { const int n = rho >> 4, i = rho & 15; return 8 * (i >> 2) + 4 * n + (i & 3); }

struct Unit { int pm, pn; };
struct Gemm { const bf16_t* A; const bf16_t* Bt; int M, N, K; };

struct StaticOrder {
    int nM, nN, nwg, G, c;
    __host__ __device__ void init(int M, int N, int G_, int c_) { nM = M / BM; nN = N / BM; nwg = nM * nN; G = G_; c = c_; }
    __host__ __device__ bool next(int i, Unit& u) const {
        const long L = (long)i * G + c; if (L >= nwg) return false;
        int wgid = (int)L; { const int q = nwg / NXCD, r = nwg % NXCD, xcd = wgid % NXCD, off = wgid / NXCD; wgid = (xcd < r ? xcd * (q + 1) : r * (q + 1) + (xcd - r) * q) + off; }
        const int nig = WGM * nN, gid = wgid / nig, fm = gid * WGM, gsz = (nM - fm) < WGM ? (nM - fm) : WGM;
        u.pm = fm + ((wgid % nig) % gsz); u.pn = (wgid % nig) / gsz; return true;
    }
    __device__ __forceinline__ void a_ready(const Unit&) const {}
    __device__ __forceinline__ void done(const Unit&) const {}
};

__device__ __forceinline__ unsigned cvt_pk_bf16(float lo, float hi) { unsigned r; asm volatile("v_cvt_pk_bf16_f32 %0, %1, %2" : "=v"(r) : "v"(lo), "v"(hi)); return r; }
typedef float f32x2 __attribute__((ext_vector_type(2)));
template <class Epi, class Sched, bool ALIGN_EPI = false, bool SP2 = false>
__device__ __forceinline__ void gemm_phase(PG8_LAS unsigned char* lds, const Gemm g, const Sched& S, const Epi& E) {
    int tid_o = threadIdx.x; asm volatile("" : "+v"(tid_o));
    const int tid = tid_o, wid = __builtin_amdgcn_readfirstlane(tid >> 6), lane = tid & 63, wr = wid >> 2, wc = wid & 3, fr = lane & 15, fq = lane >> 4;
    const int K = g.K, nt = K / BK;
    unsigned voffA[2], voffB[2];
#pragma unroll
    for (int i = 0; i < 2; ++i) { int R, C; stage_rc(tid * 16 + i * 8192, R, C); const int Rb = Epi::PERM ? ((R & ~31) + perm32(R & 31)) : R;
        voffA[i] = (unsigned)(R * K + C) * 2u; voffB[i] = (unsigned)(Rb * K + C) * 2u; }
    const size_t kstep = (size_t)(BK * 2);
    const size_t hstep = (size_t)HALF * K * 2;
    const size_t tstep = 2 * hstep;
    const unsigned ldsw = (unsigned)wid * 1024u;
    const int aoff = lds_byte(wr * 64 + fr, fq * 8), boff = lds_byte(wc * 32 + fr, fq * 8);
#define PG8_SA(b, h) (((b) * 2 + (h)) * HTB)
#define PG8_SB(b, h) ((4 + (b) * 2 + (h)) * HTB)
#define PG8_STAGE(bufoff, gbase, voff) do { _Pragma("unroll") for (int _i = 0; _i < 2; ++_i) \
        __builtin_amdgcn_global_load_lds((const unsigned*)((const char*)(gbase) + (voff)[_i]), (PG8_LAS unsigned*)(lds + (bufoff) + ldsw + _i * 8192), 16, 0, 0); } while (0)
#define PG8_LDA(dst, b, h) do { _Pragma("unroll") for (int m = 0; m < 4; ++m) _Pragma("unroll") for (int k = 0; k < 2; ++k) dst[m][k] = *(const PG8_LAS bf16x8*)(lds + PG8_SA(b, h) + aoff + m * 2048 + k * 1024); } while (0)
#define PG8_LDB(dst, b, h) do { _Pragma("unroll") for (int n = 0; n < 2; ++n) _Pragma("unroll") for (int k = 0; k < 2; ++k) dst[n][k] = *(const PG8_LAS bf16x8*)(lds + PG8_SB(b, h) + boff + n * 2048 + k * 1024); } while (0)
#define PG8_MMA(ai, bj, At, Bt) do { __builtin_amdgcn_s_setprio(1); _Pragma("unroll") for (int m = 0; m < 4; ++m) _Pragma("unroll") for (int n = 0; n < 2; ++n) _Pragma("unroll") for (int k = 0; k < 2; ++k) \
        acc[ai][bj][m][n] = __builtin_amdgcn_mfma_f32_16x16x32_bf16(Bt[n][k], At[m][k], acc[ai][bj][m][n], 0, 0, 0); __builtin_amdgcn_s_setprio(0); } while (0)
#define PG8_WAIT_V(n) asm volatile("s_waitcnt vmcnt(" #n ")" ::: "memory")
#define PG8_WAIT_L(n) asm volatile("s_waitcnt lgkmcnt(" #n ")" ::: "memory")
#define PG8_BAR __builtin_amdgcn_s_barrier()
#define PG8_SCHED __builtin_amdgcn_sched_barrier(0)
    Unit cur, nxt; int ui = 0;
    if (!S.next(0, cur)) return;
    f32x4 acc[2][2][4][2];
#pragma unroll
    for (int a = 0; a < 2; ++a)
#pragma unroll
        for (int b = 0; b < 2; ++b)
#pragma unroll
            for (int m = 0; m < 4; ++m)
#pragma unroll
                for (int n = 0; n < 2; ++n) acc[a][b][m][n] = (f32x4){0.f, 0.f, 0.f, 0.f};
    bf16x8 At[4][2], B0[2][2], B1[2][2];
    const char* cA = (const char*)g.A + (size_t)cur.pm * tstep; const char* cB = (const char*)g.Bt + (size_t)cur.pn * tstep;
    S.a_ready(cur);
    if constexpr (SP2) {
        PG8_STAGE(PG8_SB(0, 0), cB, voffB); PG8_STAGE(PG8_SB(0, 1), cB + hstep, voffB); PG8_STAGE(PG8_SA(0, 0), cA, voffA); PG8_STAGE(PG8_SA(0, 1), cA + hstep, voffA);
        if (wr == 1) PG8_BAR;
        PG8_WAIT_V(2); PG8_BAR;
        PG8_STAGE(PG8_SB(1, 0), cB + kstep, voffB); PG8_STAGE(PG8_SA(1, 0), cA + kstep, voffA); PG8_STAGE(PG8_SB(1, 1), cB + hstep + kstep, voffB);
        PG8_WAIT_V(6); PG8_BAR;
    } else {
        PG8_STAGE(PG8_SB(0, 0), cB, voffB); PG8_STAGE(PG8_SA(0, 0), cA, voffA); PG8_STAGE(PG8_SB(0, 1), cB + hstep, voffB); PG8_STAGE(PG8_SA(0, 1), cA + hstep, voffA);
        if (wr == 1) PG8_BAR;
        PG8_WAIT_V(4); PG8_BAR;
        PG8_STAGE(PG8_SB(1, 0), cB + kstep, voffB); PG8_STAGE(PG8_SA(1, 0), cA + kstep, voffA); PG8_STAGE(PG8_SB(1, 1), cB + hstep + kstep, voffB);
        PG8_WAIT_V(6); PG8_BAR;
    }
    for (;;) {
        const bool has_next = S.next(ui + 1, nxt);
        const char* nA = has_next ? (const char*)g.A + (size_t)nxt.pm * tstep : cA; const char* nB = has_next ? (const char*)g.Bt + (size_t)nxt.pn * tstep : cB;
        for (int t = 0; t < nt; t += 2) {
            const bool last = (t == nt - 2);
            const char* a1 = cA + (size_t)(t + 1) * kstep;
            const char* a2 = last ? nA : cA + (size_t)(t + 2) * kstep; const char* b2 = last ? nB : cB + (size_t)(t + 2) * kstep;
            const char* a3 = a2 + kstep; const char* b3 = b2 + kstep;
            if (last && has_next) S.a_ready(nxt);
            if constexpr (SP2) {
            PG8_LDB(B0, 0, 0); PG8_LDB(B1, 0, 1); PG8_SCHED; PG8_LDA(At, 0, 0); PG8_STAGE(PG8_SA(1, 1), a1 + hstep, voffA);
            PG8_WAIT_V(8); PG8_WAIT_L(0); PG8_BAR; PG8_MMA(0, 0, At, B0); PG8_MMA(0, 1, At, B1); PG8_BAR; PG8_SCHED;
            PG8_LDA(At, 0, 1); PG8_STAGE(PG8_SB(0, 0), b2, voffB); PG8_STAGE(PG8_SB(0, 1), b2 + hstep, voffB); PG8_STAGE(PG8_SA(0, 0), a2, voffA);
            PG8_WAIT_V(8); PG8_WAIT_L(0); PG8_BAR; PG8_MMA(1, 0, At, B0); PG8_MMA(1, 1, At, B1); PG8_BAR; PG8_SCHED;
            PG8_LDB(B0, 1, 0); PG8_LDB(B1, 1, 1); PG8_SCHED; PG8_LDA(At, 1, 0); PG8_STAGE(PG8_SA(0, 1), a2 + hstep, voffA);
            PG8_WAIT_V(8); PG8_WAIT_L(0); PG8_BAR; PG8_MMA(0, 0, At, B0); PG8_MMA(0, 1, At, B1); PG8_BAR; PG8_SCHED;
            PG8_LDA(At, 1, 1); PG8_STAGE(PG8_SB(1, 0), b3, voffB); PG8_STAGE(PG8_SB(1, 1), b3 + hstep, voffB); PG8_STAGE(PG8_SA(1, 0), a3, voffA);
            PG8_WAIT_V(8); PG8_WAIT_L(0); PG8_BAR; PG8_MMA(1, 0, At, B0); PG8_MMA(1, 1, At, B1); PG8_BAR; PG8_SCHED;
            } else {
            PG8_LDB(B0, 0, 0); PG8_SCHED; PG8_LDA(At, 0, 0); PG8_STAGE(PG8_SA(1, 1), a1 + hstep, voffA);
            PG8_WAIT_L(8); PG8_BAR; PG8_WAIT_L(0); PG8_MMA(0, 0, At, B0); PG8_BAR; PG8_SCHED;
            PG8_LDB(B1, 0, 1); PG8_STAGE(PG8_SB(0, 0), b2, voffB);
            PG8_BAR; PG8_WAIT_L(0); PG8_MMA(0, 1, At, B1); PG8_BAR;
            PG8_LDA(At, 0, 1); PG8_STAGE(PG8_SA(0, 0), a2, voffA);
            PG8_BAR; PG8_WAIT_L(0); PG8_MMA(1, 0, At, B0); PG8_BAR; PG8_SCHED;
            PG8_STAGE(PG8_SB(0, 1), b2 + hstep, voffB);
            PG8_WAIT_V(6); PG8_BAR; PG8_MMA(1, 1, At, B1); PG8_BAR;
            PG8_LDB(B0, 1, 0); PG8_SCHED; PG8_LDA(At, 1, 0); PG8_STAGE(PG8_SA(0, 1), a2 + hstep, voffA);
            PG8_WAIT_L(8); PG8_BAR; PG8_WAIT_L(0); PG8_MMA(0, 0, At, B0); PG8_BAR; PG8_SCHED;
            PG8_LDB(B1, 1, 1); PG8_STAGE(PG8_SB(1, 0), b3, voffB);
            PG8_BAR; PG8_WAIT_L(0); PG8_MMA(0, 1, At, B1); PG8_BAR;
            PG8_LDA(At, 1, 1); PG8_STAGE(PG8_SA(1, 0), a3, voffA);
            PG8_BAR; PG8_WAIT_L(0); PG8_MMA(1, 0, At, B0); PG8_BAR; PG8_SCHED;
            PG8_STAGE(PG8_SB(1, 1), b3 + hstep, voffB);
            PG8_WAIT_V(6); PG8_BAR; PG8_MMA(1, 1, At, B1); PG8_BAR;
            }
        }
        if constexpr (ALIGN_EPI) { if (wr == 0) PG8_BAR; }
        if constexpr (!Epi::AFTER_DRAIN) { E(acc, cur, wr, wc, fr, fq); S.done(cur); }
        if (!has_next) break;
#pragma unroll
        for (int a = 0; a < 2; ++a)
#pragma unroll
            for (int b = 0; b < 2; ++b)
#pragma unroll
                for (int m = 0; m < 4; ++m)
#pragma unroll
                    for (int n = 0; n < 2; ++n) acc[a][b][m][n] = (f32x4){0.f, 0.f, 0.f, 0.f};
        cur = nxt; cA = nA; cB = nB; ++ui;
        if constexpr (ALIGN_EPI) { if (wr == 1) PG8_BAR; }
    }
    PG8_WAIT_V(0);
    if constexpr (!ALIGN_EPI) { if (wr == 0) PG8_BAR; }
    PG8_BAR;
    if constexpr (Epi::AFTER_DRAIN) { E.fused(acc, cur, wr, wc, fr, fq, lds, wid, lane); S.done(cur); }
#undef PG8_SA
#undef PG8_SB
#undef PG8_STAGE
#undef PG8_LDA
#undef PG8_LDB
#undef PG8_MMA
#undef PG8_WAIT_V
#undef PG8_WAIT_L
#undef PG8_BAR
#undef PG8_SCHED
}
}
namespace pg8 {
typedef unsigned u32x2 __attribute__((ext_vector_type(2)));
__device__ __forceinline__ float fsigmoid(float v) { return 1.0f / (1.0f + __expf(-v)); }
struct EpiIn {
    static constexpr bool PERM = true, AFTER_DRAIN = false;
    const float* ssq;
    bf16_t *hq, *hv, *hg, *Q, *Kb, *V; float* lf; float* lsig;
    const float* lba; const float* lbb;
    int layer; const float* qw; const float* kw; const float* fbias;
    __device__ __forceinline__ void operator()(const f32x4 (&acc)[2][2][4][2], const Unit& u, int wr, int wc, int fr, int fq) const {
        const int pn = u.pn, g = pn >> 1, half = pn & 1;
        const int row0 = u.pm * BM + wr * 64 + fr;
        if (pn == 14) {
            if (wc == 0 && fq == 0) {
                const f32x4 b0 = *(const f32x4*)(fbias), b1 = *(const f32x4*)(fbias + 4);
#pragma unroll
                for (int ai = 0; ai < 2; ++ai)
#pragma unroll
                    for (int m = 0; m < 4; ++m) { const int row = row0 + ai * HALF + m * 16; const float rs = rsqrtf(ssq[row] * (1.0f / 1024.0f) + 1e-6f);
                        f32x4 v0 = acc[ai][0][m][0] * rs + b0, v1 = acc[ai][0][m][1] * rs + b1;
#pragma unroll
                        for (int j = 0; j < 4; ++j) { v0[j] = fminf(v0[j], 0.f) - log1pf(__expf(-fabsf(v0[j]))); v1[j] = fminf(v1[j], 0.f) - log1pf(__expf(-fabsf(v1[j]))); }
                        *(f32x4*)(lsig + (size_t)row * 8) = v0; *(f32x4*)(lsig + (size_t)row * 8 + 4) = v1; }
            }
            return;
        }
        if (g == 4 || g == 5) {
            bf16_t* dst = (g == 4) ? Q : Kb; const float* nw = (g == 4) ? qw : kw; const float osc = (g == 4) ? 0.125f * 1.4426950408889634f : 1.0f;
            f32x4 w[2][2];
#pragma unroll
            for (int bj = 0; bj < 2; ++bj)
#pragma unroll
                for (int n = 0; n < 2; ++n) w[bj][n] = *(const f32x4*)(nw + 32 * bj + 8 * fq + 4 * n) * osc;
            const int col0 = (half * 4 + wc) * 64 + 8 * fq;
#pragma unroll
            for (int ai = 0; ai < 2; ++ai)
#pragma unroll
                for (int m = 0; m < 4; ++m) { const int row = row0 + ai * HALF + m * 16; const float rs = rsqrtf(ssq[row] * (1.0f / 1024.0f) + 1e-6f);
                    f32x4 v[2][2]; float ss = 0.f;
#pragma unroll
                    for (int bj = 0; bj < 2; ++bj)
#pragma unroll
                        for (int n = 0; n < 2; ++n) { v[bj][n] = acc[ai][bj][m][n] * rs; ss += (v[bj][n][0] * v[bj][n][0] + v[bj][n][1] * v[bj][n][1]) + (v[bj][n][2] * v[bj][n][2] + v[bj][n][3] * v[bj][n][3]); }
                    ss += __shfl_xor(ss, 16); ss += __shfl_xor(ss, 32);
                    const float hr = rsqrtf(ss * (1.0f / 64.0f) + 1e-6f);
#pragma unroll
                    for (int bj = 0; bj < 2; ++bj) { const f32x4 a = v[bj][0] * hr * w[bj][0], b = v[bj][1] * hr * w[bj][1];
                        u32x4 o; o.x = cvt_pk_bf16(a[0], a[1]); o.y = cvt_pk_bf16(a[2], a[3]); o.z = cvt_pk_bf16(b[0], b[1]); o.w = cvt_pk_bf16(b[2], b[3]);
                        *(u32x4*)(dst + (size_t)row * 512 + col0 + 32 * bj) = o; } }
            return;
        }
        const int col0 = half * 256 + wc * 32 + 8 * fq;
        if (g == 1) {
            f32x4 lbv[2][2];
#pragma unroll
            for (int bj = 0; bj < 2; ++bj)
#pragma unroll
                for (int n = 0; n < 2; ++n) { f32x4 t = (f32x4){0.f, 0.f, 0.f, 0.f};
                    if (layer == 1) { const f32x4 a0 = *(const f32x4*)(lba + col0 + 128 * bj + 4 * n), a1 = *(const f32x4*)(lbb + col0 + 128 * bj + 4 * n);
#pragma unroll
                        for (int j = 0; j < 4; ++j) t[j] = fsigmoid(a1[j] - a0[j]); }
                    lbv[bj][n] = t; }
#pragma unroll
            for (int ai = 0; ai < 2; ++ai)
#pragma unroll
                for (int m = 0; m < 4; ++m) { const int row = row0 + ai * HALF + m * 16; const float rs = rsqrtf(ssq[row] * (1.0f / 1024.0f) + 1e-6f);
#pragma unroll
                    for (int bj = 0; bj < 2; ++bj)
#pragma unroll
                        for (int n = 0; n < 2; ++n) { f32x4 v = acc[ai][bj][m][n] * rs;
#pragma unroll
                            for (int j = 0; j < 4; ++j) v[j] = __logf(lbv[bj][n][j] + (1.0f - lbv[bj][n][j]) * fsigmoid(v[j]));
                            *(f32x4*)(lf + (size_t)row * 512 + col0 + 128 * bj + 4 * n) = v; } }
            return;
        }
        bf16_t* dst = (g == 0) ? hq : (g == 2) ? hv : (g == 3) ? hg : V;
        const float sc = (g == 0) ? 0.08838834764831845f : 1.0f;
#pragma unroll
        for (int ai = 0; ai < 2; ++ai)
#pragma unroll
            for (int m = 0; m < 4; ++m) { const int row = row0 + ai * HALF + m * 16; const float rs = rsqrtf(ssq[row] * (1.0f / 1024.0f) + 1e-6f) * sc;
#pragma unroll
                for (int bj = 0; bj < 2; ++bj) { f32x4 a = acc[ai][bj][m][0] * rs, b = acc[ai][bj][m][1] * rs;
                    if (g == 3) {
#pragma unroll
                        for (int j = 0; j < 4; ++j) { a[j] = a[j] * fsigmoid(a[j]); b[j] = b[j] * fsigmoid(b[j]); } }
                    u32x4 o; o.x = cvt_pk_bf16(a[0], a[1]); o.y = cvt_pk_bf16(a[2], a[3]); o.z = cvt_pk_bf16(b[0], b[1]); o.w = cvt_pk_bf16(b[2], b[3]);
                    *(u32x4*)(dst + (size_t)row * 512 + col0 + 128 * bj) = o; } }
    }
};
struct EpiRes {
    static constexpr bool PERM = false, AFTER_DRAIN = false;
    const float* base; float* out; bf16_t* xb; float* ssq;
    __device__ __forceinline__ void operator()(const f32x4 (&acc)[2][2][4][2], const Unit& u, int wr, int wc, int fr, int fq) const {
        const int col0 = u.pn * BM + wc * 32 + 4 * fq;
#pragma unroll
        for (int ai = 0; ai < 2; ++ai)
#pragma unroll
            for (int m = 0; m < 4; ++m) { const int row = u.pm * BM + ai * HALF + wr * 64 + m * 16 + fr; const size_t off = (size_t)row * 1024 + col0; float ss = 0.f;
#pragma unroll
                for (int bj = 0; bj < 2; ++bj)
#pragma unroll
                    for (int n = 0; n < 2; ++n) { const f32x4 o = *(const f32x4*)(base + off + bj * HALF + n * 16) + acc[ai][bj][m][n];
                        *(f32x4*)(out + off + bj * HALF + n * 16) = o; ss += (o[0] * o[0] + o[1] * o[1]) + (o[2] * o[2] + o[3] * o[3]);
                        if (xb) { u32x2 w; w.x = cvt_pk_bf16(o[0], o[1]); w.y = cvt_pk_bf16(o[2], o[3]); *(u32x2*)(xb + off + bj * HALF + n * 16) = w; } }
                if (ssq) { ss += __shfl_xor(ss, 16); ss += __shfl_xor(ss, 32); if (fq == 0) unsafeAtomicAdd(ssq + row, ss); } }
    }
};
struct EpiUp {
    static constexpr bool PERM = true, AFTER_DRAIN = false;
    const float* ssq; bf16_t* H;
    __device__ __forceinline__ void operator()(const f32x4 (&acc)[2][2][4][2], const Unit& u, int wr, int wc, int fr, int fq) const {
        const int row0 = u.pm * BM + wr * 64 + fr, col0 = u.pn * BM + wc * 32 + 8 * fq;
#pragma unroll
        for (int ai = 0; ai < 2; ++ai)
#pragma unroll
            for (int m = 0; m < 4; ++m) { const int row = row0 + ai * HALF + m * 16; const float rs = rsqrtf(ssq[row] * (1.0f / 1024.0f) + 1e-6f);
#pragma unroll
                for (int bj = 0; bj < 2; ++bj) { f32x4 a = acc[ai][bj][m][0] * rs, b = acc[ai][bj][m][1] * rs;
#pragma unroll
                    for (int j = 0; j < 4; ++j) { a[j] = fmaxf(a[j], 0.f); a[j] *= a[j]; b[j] = fmaxf(b[j], 0.f); b[j] *= b[j]; }
                    u32x4 o; o.x = cvt_pk_bf16(a[0], a[1]); o.y = cvt_pk_bf16(a[2], a[3]); o.z = cvt_pk_bf16(b[0], b[1]); o.w = cvt_pk_bf16(b[2], b[3]);
                    *(u32x4*)(H + (size_t)row * 4096 + col0 + 128 * bj) = o; } }
    }
};
}
#include <hip/hip_bf16.h>
#include <cmath>
namespace attn_body {
using bf16=__hip_bfloat16;
using bf16x8=__attribute__((ext_vector_type(8)))short;
using s16x4=__attribute__((ext_vector_type(4)))short;
using f32x16=__attribute__((ext_vector_type(16)))float;
using u32x4=__attribute__((ext_vector_type(4)))unsigned;
using f32x4v=__attribute__((ext_vector_type(4)))float;
constexpr int BATCH=2,NHEAD=8,SEQ=8192,D=64,DM=NHEAD*D,ODM=1024;
constexpr int NW=8,QBLK=32,QB=QBLK*NW,KVBLK=64,NQB=SEQ/QB;
constexpr int ATTN_PITCH=DM, ATTN_UNIT_ROWS=QB;
__device__ __forceinline__ int crow(int r,int hi){return (r&3)+8*(r>>2)+4*hi;}
#define SBAR() __builtin_amdgcn_sched_barrier(0)
__device__ __forceinline__ void cmask(f32x16&p0,f32x16&p1,int jb,int qrel,int hi){
  const float NEG=-INFINITY; int kb=64*jb+4*hi;
  #pragma unroll
  for(int r=0;r<16;++r){int kv=kb+(r&3)+8*(r>>2); if(kv>qrel)p0[r]=NEG; if(kv+32>qrel)p1[r]=NEG;}
}

constexpr int NSLOT=3, SLOTB=8192;
constexpr int LDS_K=0, LDS_V=NSLOT*SLOTB, LDS_WS=2*NSLOT*SLOTB, LDS_OST=LDS_WS+NW*64*4, LDS_BYTES=LDS_OST+NW*4096, LDS_DK=86016, LDS_END=LDS_DK+SEQ*4;
constexpr float C2=0.125f*1.4426950408889634f;
__device__ __forceinline__ void glds16(const void*gsrc,unsigned lds_dst){unsigned keep;
  asm volatile("s_mov_b32 %0, m0\n\ts_mov_b32 m0, %2\n\ts_nop 0\n\tglobal_load_lds_dwordx4 %1, off\n\ts_mov_b32 m0, %0":"=&s"(keep):"v"(gsrc),"s"(lds_dst):"memory");}
__device__ __forceinline__ float max3f(float a,float b,float c){float r;asm("v_max3_f32 %0, %1, %2, %3":"=v"(r):"v"(a),"v"(b),"v"(c));return r;}
__device__ __forceinline__ float max2f(float a,float b){float r;asm("v_max_f32_e32 %0, %1, %2":"=v"(r):"v"(a),"v"(b));return r;}
__device__ __forceinline__ float fadd_s(float a,float b){float r;asm("v_add_f32_e32 %0, %1, %2":"=v"(r):"v"(a),"v"(b));return r;}
__device__ __forceinline__ float fsub_s(float a,float b){float r;asm("v_sub_f32_e32 %0, %1, %2":"=v"(r):"v"(a),"v"(b));return r;}
typedef float f32x2_t __attribute__((ext_vector_type(2))); typedef __bf16 bf16x2_t __attribute__((ext_vector_type(2)));
__device__ __forceinline__ unsigned cvtpk_s(float lo,float hi){f32x2_t v={lo,hi};bf16x2_t b=__builtin_convertvector(v,bf16x2_t);return __builtin_bit_cast(unsigned,b);}
#define WAIT_BAR(N) asm volatile("s_waitcnt vmcnt(" #N ") lgkmcnt(0)\n\ts_barrier":::"memory")

__device__ __forceinline__ void qkt(f32x16&p0,f32x16&p1,const char*Kslot,const bf16x8*qr,int r32,int hi){
  const char*kb=Kslot+hi*1024+r32*16;
  #pragma unroll
  for(int d0=0;d0<4;++d0){
    const bf16x8 b0=*reinterpret_cast<const bf16x8*>(kb+d0*2048);
    const bf16x8 b1=*reinterpret_cast<const bf16x8*>(kb+d0*2048+512);
    {p0=__builtin_amdgcn_mfma_f32_32x32x16_bf16(b0,qr[d0],p0,0,0,0);p1=__builtin_amdgcn_mfma_f32_32x32x16_bf16(b1,qr[d0],p1,0,0,0);}}
}
typedef __attribute__((address_space(3))) const char* lds_cptr;
typedef short v4i16_t __attribute__((ext_vector_type(4)));
__device__ __forceinline__ void kload8(bf16x8*kf,lds_cptr kp){
  kf[0]=*(const __attribute__((address_space(3))) bf16x8*)(kp);      kf[1]=*(const __attribute__((address_space(3))) bf16x8*)(kp+512);
  kf[2]=*(const __attribute__((address_space(3))) bf16x8*)(kp+2048); kf[3]=*(const __attribute__((address_space(3))) bf16x8*)(kp+2560);
  kf[4]=*(const __attribute__((address_space(3))) bf16x8*)(kp+4096); kf[5]=*(const __attribute__((address_space(3))) bf16x8*)(kp+4608);
  kf[6]=*(const __attribute__((address_space(3))) bf16x8*)(kp+6144); kf[7]=*(const __attribute__((address_space(3))) bf16x8*)(kp+6656);
}
__device__ __forceinline__ void kload2(bf16x8*kf,lds_cptr kp,int j){ kf[2*j]=*(const __attribute__((address_space(3))) bf16x8*)(kp+j*2048); kf[2*j+1]=*(const __attribute__((address_space(3))) bf16x8*)(kp+j*2048+512); }
__device__ __forceinline__ s16x4 vtr(lds_cptr p){ return __builtin_bit_cast(s16x4,__builtin_amdgcn_ds_read_tr16_b64_v4i16((__attribute__((address_space(3))) v4i16_t*)p)); }
__device__ __forceinline__ float rowmax(const f32x16&p0,const f32x16&p1){
  float a=max3f(p0[0],p0[1],p1[0]),b=max3f(p0[2],p0[3],p1[1]);a=max3f(a,p1[2],p1[3]);
  #pragma unroll
  for(int r=4;r<16;r+=4){a=max3f(a,p0[r],p0[r+1]);b=max3f(b,p0[r+2],p0[r+3]);a=max3f(a,p1[r],p1[r+1]);b=max3f(b,p1[r+2],p1[r+3]);}
  const float m=max2f(a,b);
  auto rr=__builtin_amdgcn_permlane32_swap(__float_as_uint(m),__float_as_uint(m),false,false);
  return max2f(__uint_as_float(rr[0]),__uint_as_float(rr[1]));
}
__device__ __forceinline__ void pv(f32x16*o,int vb,bf16x8 pa0,bf16x8 pa1,bf16x8 pa2,bf16x8 pa3){
  #pragma unroll
  for(int d0=0;d0<2;++d0){s16x4 lo[4],hi[4];
    #pragma unroll
    for(int ks=0;ks<4;++ks){
      asm volatile("ds_read_b64_tr_b16 %0,%1 offset:%c2":"=&v"(lo[ks]):"v"(vb),"i"(d0*4096+ks*1024):"memory");
      asm volatile("ds_read_b64_tr_b16 %0,%1 offset:%c2":"=&v"(hi[ks]):"v"(vb),"i"(d0*4096+ks*1024+512):"memory");}
    asm volatile("s_waitcnt lgkmcnt(0)":::"memory");SBAR();
    #define PK(k) (bf16x8){lo[k][0],lo[k][1],lo[k][2],lo[k][3],hi[k][0],hi[k][1],hi[k][2],hi[k][3]}
    o[d0]=__builtin_amdgcn_mfma_f32_32x32x16_bf16(pa0,PK(0),o[d0],0,0,0);
    o[d0]=__builtin_amdgcn_mfma_f32_32x32x16_bf16(pa1,PK(1),o[d0],0,0,0);
    o[d0]=__builtin_amdgcn_mfma_f32_32x32x16_bf16(pa2,PK(2),o[d0],0,0,0);
    o[d0]=__builtin_amdgcn_mfma_f32_32x32x16_bf16(pa3,PK(3),o[d0],0,0,0);
    #undef PK
  }
}

#ifndef ATTN_STORE16
#define ATTN_STORE16(p,v) (*(u32x4*)(p)=(v))
#endif
template<int THRL> __device__ __forceinline__ void attn_unit(int b,int h,int qb,int NT,const bf16*Q,const bf16*__restrict__ K,const bf16*__restrict__ V,bf16*O,char*shm){
  int tid_o=threadIdx.x; asm volatile("":"+v"(tid_o));
  const int tid=tid_o,lane=tid&63,r32=lane&31,hi=lane>>5; const int wid=__builtin_amdgcn_readfirstlane(tid>>6);
  const long rowbase=(long)b*SEQ; const int q0=qb*QB;
  const bf16*Qw=Q+(rowbase+q0+wid*QBLK)*DM+h*D;
  const bf16*Kh=K+rowbase*DM+h*D,*Vh=V+rowbase*DM+h*D;
  const unsigned lds0=(unsigned)(uintptr_t)shm;
  float*wsf=(float*)(shm+LDS_WS)+wid*64;
  const bf16*ksrc=Kh+(long)lane*DM+wid*8;
  const bf16*vsrc=Vh+(long)(16*(wid&3)+(lane>>2))*DM+(wid>>2)*32+(lane&3)*8;
  const unsigned kdst=lds0+LDS_K+wid*1024, vdst=lds0+LDS_V+wid*1024;
  #define TA(t) (((t)<4)?(NTA-4+(t)):(NTA-1-(t)))
  #define DMA_K(t,slot) glds16(ksrc+(long)TA(t)*KVBLK*DM,(unsigned)__builtin_amdgcn_readfirstlane(kdst+(slot)))
  #define DMA_V(t,slot) glds16(vsrc+(long)TA(t)*KVBLK*DM,(unsigned)__builtin_amdgcn_readfirstlane(vdst+(slot)))
  const int vb0=(int)(lds0+LDS_V)+((lane>>4)&1)*32+(lane&3)*8+(4*hi+((lane&15)>>2))*64;
  const char*Kbase=shm+LDS_K; bf16x8 kf[8];
  const lds_cptr shm3=(lds_cptr)shm; const lds_cptr kp0=shm3+LDS_K+hi*1024+r32*16; const lds_cptr vp0=shm3+LDS_V+((lane>>4)&1)*32+(lane&3)*8+(4*hi+((lane&15)>>2))*64;
  const int NTA=(q0+QB)/KVBLK;
  typedef __attribute__((address_space(3))) const f32x4v* dk_cptr; const dk_cptr dkp=(dk_cptr)(shm3+LDS_DK+hi*16);
  #define CINIT1(C0,t,o8) do{ const dk_cptr dp_=dkp+TA(t)*16+(o8); _Pragma("unroll") for(int j_=0;j_<4;++j_){ const f32x4v a_=dp_[2*j_]; \
      C0[4*j_]=a_[0]+nmh;C0[4*j_+1]=a_[1]+nmh;C0[4*j_+2]=a_[2]+nmh;C0[4*j_+3]=a_[3]+nmh; } }while(0)
  #define CINIT(C0,C1,t) do{ CINIT1(C0,t,0); SBAR(); CINIT1(C1,t,8); }while(0)
  DMA_K(0,0);DMA_V(0,0);DMA_K(1,SLOTB);
  bf16x8 qr[4];
  #pragma unroll
  for(int d0=0;d0<4;++d0)qr[d0]=*reinterpret_cast<const bf16x8*>(&Qw[(long)r32*DM+d0*16+hi*8]);
  float mhat=0.f,l_reg=0.f,nmh=0.f;f32x16 o[2];o[0]=f32x16{};o[1]=f32x16{};
  const int qrel=wid*QBLK+r32;
  #define CMASK(P0,P1,t) do{int jb_=(t); if(jb_<4)cmask(P0,P1,jb_,qrel,hi);}while(0)
  bool resc=false;
  #define START(P0,P1) do{ const float rm=rowmax(P0,P1); resc=false; \
    { const float dl=rm; mhat=fadd_s(mhat,dl); \
      _Pragma("unroll") for(int r=0;r<16;++r){P0[r]=fsub_s(P0[r],dl);P1[r]=fsub_s(P1[r],dl);} \
      nmh=-mhat; } \
    _Pragma("unroll") for(int r=0;r<16;++r)P0[r]=__builtin_amdgcn_exp2f(P0[r]); }while(0)
  #define RESC() do{ if(resc){ asm volatile("s_waitcnt lgkmcnt(0)":::"memory"); \
      _Pragma("unroll") for(int d_=0;d_<2;++d_) _Pragma("unroll") for(int r=0;r<16;++r)o[d_][r]*=wsf[crow(r,hi)]; } }while(0)
  f32x16 pA0,pA1,pB0,pB1;
  int sl_prev=0,sl_cur=0,sl_next=SLOTB;
  #define ROT() do{sl_prev=sl_cur;sl_cur=sl_next;sl_next=(sl_next==(NSLOT-1)*SLOTB)?0:sl_next+SLOTB;}while(0)
  DMA_K(2,2*SLOTB);
  WAIT_BAR(3);
  CINIT(pA0,pA1,0); qkt(pA0,pA1,Kbase,qr,r32,hi);asm volatile("s_nop 15\n\ts_nop 7":"+v"(pA0),"+v"(pA1));CMASK(pA0,pA1,0);
  START(pA0,pA1);
  _Pragma("unroll") for(int r=0;r<16;++r)pA1[r]=__builtin_amdgcn_exp2f(pA1[r]);
  WAIT_BAR(0);
  DMA_K(3,0);DMA_V(1,SLOTB);
  ROT();
  kload8(kf,kp0+sl_cur);
  WAIT_BAR(2);
  s16x4 vlo[8],vhi[8]; u32x4 pw0,pw1,pw2,pw3;
  #define PKW(P,B) cvtpk_s(P[B],P[B+1])
  #define PAF(k) __builtin_bit_cast(bf16x8,pw##k)
  #define VFR(i) (bf16x8){vlo[i][0],vlo[i][1],vlo[i][2],vlo[i][3],vhi[i][0],vhi[i][1],vhi[i][2],vhi[i][3]}
  #define PIN(x) asm volatile("":"+v"(x))
  #define MX3(a,b,c) __builtin_fmaxf(__builtin_fmaxf((a),(b)),(c))
  #define GAPA(MF,A0,A1,A2,A3,W0,W1,PW) do{ MF; sacc+=A0; sacc+=A1; sacc+=A2; sacc+=A3; PIN(sacc); W0; W1; PIN(PW); SBAR(); }while(0)
  #define EX(v) __builtin_amdgcn_exp2f(v)
  #define GAPB(MF,X,B) do{ MF; X[B]=EX(X[B]); X[B+1]=EX(X[B+1]); X[B+2]=EX(X[B+2]); X[B+3]=EX(X[B+3]); PIN(X); SBAR(); }while(0)
  #define VRD(i) do{ vlo[i]=vtr(vp_+(((i)>>2)*4096+((i)&3)*1024)); vhi[i]=vtr(vp_+(((i)>>2)*4096+((i)&3)*1024+512)); }while(0)
  #define KRD(G,j) do{ if(G){ kload2(kf,kp0+sl_next,j); SBAR(); } }while(0)
  #define STEP(C0,C1,P0,P1,t,GK,GV,GL) do{ SBAR(); CINIT(C0,C1,t); SBAR(); \
    const lds_cptr vp_=vp0+sl_prev; \
    float sacc=(P0[0]+P0[1]); \
    GAPA(C0=__builtin_amdgcn_mfma_f32_32x32x16_bf16(kf[0],qr[0],C0,0,0,0), P0[2],P0[3],P0[4],P0[5],     pw0[0]=PKW(P0,0), pw0[1]=PKW(P0,2), pw0); \
    GAPA(C1=__builtin_amdgcn_mfma_f32_32x32x16_bf16(kf[1],qr[0],C1,0,0,0), P0[6],P0[7],P0[8],P0[9],     pw0[2]=PKW(P0,4), pw0[3]=PKW(P0,6), pw0); \
    GAPA(C0=__builtin_amdgcn_mfma_f32_32x32x16_bf16(kf[2],qr[1],C0,0,0,0),   P0[10],P0[11],P0[12],P0[13], pw1[0]=PKW(P0,8), pw1[1]=PKW(P0,10), pw1); \
    GAPA(C1=__builtin_amdgcn_mfma_f32_32x32x16_bf16(kf[3],qr[1],C1,0,0,0),   P0[14],P0[15],P1[0],P1[1],   pw1[2]=PKW(P0,12),pw1[3]=PKW(P0,14), pw1); \
    GAPA(C0=__builtin_amdgcn_mfma_f32_32x32x16_bf16(kf[4],qr[2],C0,0,0,0),   P1[2],P1[3],P1[4],P1[5],     pw2[0]=PKW(P1,0), pw2[1]=PKW(P1,2), pw2); \
    GAPA(C1=__builtin_amdgcn_mfma_f32_32x32x16_bf16(kf[5],qr[2],C1,0,0,0),   P1[6],P1[7],P1[8],P1[9],     pw2[2]=PKW(P1,4), pw2[3]=PKW(P1,6), pw2); \
    GAPA(C0=__builtin_amdgcn_mfma_f32_32x32x16_bf16(kf[6],qr[3],C0,0,0,0),   P1[10],P1[11],P1[12],P1[13], pw3[0]=PKW(P1,8), pw3[1]=PKW(P1,10), pw3); \
    GAPA(C1=__builtin_amdgcn_mfma_f32_32x32x16_bf16(kf[7],qr[3],C1,0,0,0),   P1[14],P1[15],0.f,0.f,       pw3[2]=PKW(P1,12),pw3[3]=PKW(P1,14), pw3); \
    l_reg+=sacc; VRD(0); VRD(4); \
    if(GK){DMA_K((t)+3,sl_cur);} if(GV){DMA_V((t)+1,sl_next);} \
    CMASK(C0,C1,t); \
    { float a=MX3(C0[0],C0[1],C1[0]),b=MX3(C0[2],C0[3],C1[1]); a=MX3(a,C1[2],C1[3]); \
      _Pragma("unroll") for(int r=4;r<16;r+=4){a=MX3(a,C0[r],C0[r+1]);b=MX3(b,C0[r+2],C0[r+3]);a=MX3(a,C1[r],C1[r+1]);b=MX3(b,C1[r+2],C1[r+3]);} \
      float rm=__builtin_fmaxf(a,b); { auto rr=__builtin_amdgcn_permlane32_swap(__float_as_uint(rm),__float_as_uint(rm),false,false); rm=__builtin_fmaxf(__uint_as_float(rr[0]),__uint_as_float(rr[1])); } \
      resc=false; \
      if(__builtin_expect(__any(rm>(float)THRL),0)){ const float dl=__builtin_fmaxf(rm,0.f); mhat+=dl; \
        _Pragma("unroll") for(int r=0;r<16;++r){C0[r]-=dl;C1[r]-=dl;} \
        nmh=-mhat; \
        const float f=__builtin_amdgcn_exp2f(-dl); l_reg*=f; if(hi==0)wsf[r32]=f; resc=true; } } \
    SBAR(); \
    VRD(1); GAPB(o[0]=__builtin_amdgcn_mfma_f32_32x32x16_bf16(PAF(0),VFR(0),o[0],0,0,0), C0,0); \
    VRD(5); GAPB(o[1]=__builtin_amdgcn_mfma_f32_32x32x16_bf16(PAF(0),VFR(4),o[1],0,0,0), C0,4); \
    KRD(GL,0); VRD(2); GAPB(o[0]=__builtin_amdgcn_mfma_f32_32x32x16_bf16(PAF(1),VFR(1),o[0],0,0,0), C0,8); \
    KRD(GL,1); VRD(6); GAPB(o[1]=__builtin_amdgcn_mfma_f32_32x32x16_bf16(PAF(1),VFR(5),o[1],0,0,0), C0,12); \
    KRD(GL,2); VRD(3); GAPB(o[0]=__builtin_amdgcn_mfma_f32_32x32x16_bf16(PAF(2),VFR(2),o[0],0,0,0), C1,0); \
    KRD(GL,3); VRD(7); GAPB(o[1]=__builtin_amdgcn_mfma_f32_32x32x16_bf16(PAF(2),VFR(6),o[1],0,0,0), C1,4); \
    GAPB(o[0]=__builtin_amdgcn_mfma_f32_32x32x16_bf16(PAF(3),VFR(3),o[0],0,0,0), C1,8); \
    GAPB(o[1]=__builtin_amdgcn_mfma_f32_32x32x16_bf16(PAF(3),VFR(7),o[1],0,0,0), C1,12); \
    }while(0)
  int t=1;
  #define ENDW(tt) do{ if((tt)+3<NT){WAIT_BAR(2);} else if((tt)+2<NT){WAIT_BAR(1);} else {WAIT_BAR(0);} }while(0)
  for(;t+1<NT;t+=2){
    STEP(pB0,pB1,pA0,pA1,t,(t+3<NT),(t+1<NT),(t+1<NT));       ENDW(t);   RESC(); ROT();
    STEP(pA0,pA1,pB0,pB1,t+1,(t+4<NT),(t+2<NT),(t+2<NT));     ENDW(t+1); RESC(); ROT();
  }
  STEP(pB0,pB1,pA0,pA1,NT-1,false,false,false); RESC();
  { float sacc=pB0[0]+pB0[1]; _Pragma("unroll") for(int r=2;r<16;++r)sacc+=pB0[r]; _Pragma("unroll") for(int r=0;r<16;++r)sacc+=pB1[r]; l_reg+=sacc;
    pw0=(u32x4){PKW(pB0,0),PKW(pB0,2),PKW(pB0,4),PKW(pB0,6)};pw1=(u32x4){PKW(pB0,8),PKW(pB0,10),PKW(pB0,12),PKW(pB0,14)};pw2=(u32x4){PKW(pB1,0),PKW(pB1,2),PKW(pB1,4),PKW(pB1,6)};pw3=(u32x4){PKW(pB1,8),PKW(pB1,10),PKW(pB1,12),PKW(pB1,14)};
    SBAR(); pv(o,vb0+sl_cur,PAF(0),PAF(1),PAF(2),PAF(3)); }
  #undef PKW
  #undef PAF
  #undef VFR
  #undef PIN
  #undef MX3
  #undef GAPA
  #undef GAPB
  #undef EX
  #undef VRD
  #undef KRD
  #undef STEP
  #undef ENDW
  {auto rr=__builtin_amdgcn_permlane32_swap(__float_as_uint(l_reg),__float_as_uint(l_reg),false,false);l_reg=__uint_as_float(rr[0])+__uint_as_float(rr[1]);}
  if(hi==0)wsf[32+r32]=l_reg;asm volatile("s_waitcnt lgkmcnt(0)":::"memory");
  float rli[16];
  #pragma unroll
  for(int r=0;r<16;++r)rli[r]=__builtin_amdgcn_rcpf(wsf[32+crow(r,hi)]);
  bf16*Ow=O+(rowbase+q0+wid*QBLK)*ODM+h*D;
  { bf16*stg=(bf16*)(shm+LDS_OST)+wid*2048;
    #pragma unroll
    for(int r=0;r<16;++r){const int orow=crow(r,hi);
      #pragma unroll
      for(int d0=0;d0<2;++d0)stg[orow*64+d0*32+r32]=__float2bfloat16(o[d0][r]*rli[r]);}
    asm volatile("s_waitcnt lgkmcnt(0)":::"memory");
    #pragma unroll
    for(int i=0;i<4;++i){const int row=i*8+(lane>>3),ch=lane&7; const u32x4 v=*(const u32x4*)(stg+row*64+ch*8); ATTN_STORE16(Ow+(long)row*ODM+ch*8,v);} }
  asm volatile("s_waitcnt lgkmcnt(0)\n\ts_barrier":::"memory");
  #undef DMA_K
  #undef TA
  #undef CINIT
  #undef CINIT1
  #undef DMA_V
  #undef CMASK
  #undef START
  #undef RESC
  #undef ROT
}
constexpr int ATTN_LDS_BYTES=LDS_END;
#undef SBAR
#undef WAIT_BAR
}
constexpr int NWAVES = 8, NTHREADS = 512;
constexpr int BATCH = 2, T = 8192, D = 1024, FF = 4096, M = BATCH * T, DEPTH = 2;
constexpr int IN_COLS = 3592, NIN = 3840;
constexpr size_t MiB = 1u << 20;
constexpr size_t WS_CTL = 0, CTL_ZERO_BYTES = 1 * MiB;
constexpr size_t WS_SSQ = 64 * 1024;
constexpr size_t WS_LSIG = 512 * 1024;
constexpr size_t WS_WIN = 1 * MiB, WIN_BYTES = (size_t)NIN * D * 2;
constexpr size_t WS_WOUT = 16 * MiB, WS_WUP = 20 * MiB, WS_WDN = 36 * MiB;
constexpr size_t WS_XB = 52 * MiB;
constexpr size_t WS_ST = 84 * MiB;
constexpr size_t WS_HQ = 116 * MiB, WS_LF = 132 * MiB, WS_HV = 164 * MiB, WS_HG = 180 * MiB, WS_Q = 196 * MiB, WS_K = 212 * MiB, WS_V = 228 * MiB, WS_END = 244 * MiB;
constexpr size_t WS_H = 116 * MiB;
constexpr size_t WS_DL = 244 * MiB;
constexpr int LDS_BYTES = 147456;

#define GAS __attribute__((address_space(1)))
#define LAS __attribute__((address_space(3)))
typedef unsigned short bf16;
typedef unsigned v4u __attribute__((ext_vector_type(4)));
typedef float f32x4 __attribute__((ext_vector_type(4)));
typedef float f32x16 __attribute__((ext_vector_type(16)));
typedef short bf16x8 __attribute__((ext_vector_type(8)));
#define LDS_WAIT() asm volatile("s_waitcnt lgkmcnt(0)" ::: "memory")
__device__ __forceinline__ unsigned f2bf(float f) { unsigned u = __builtin_bit_cast(unsigned, f); return (u + 0x7fffu + ((u >> 16) & 1u)) >> 16; }
__device__ __forceinline__ unsigned pk2(float lo, float hi) { return f2bf(lo) | (f2bf(hi) << 16); }
__device__ __forceinline__ float bf2f(unsigned short b) { return __builtin_bit_cast(float, (unsigned)b << 16); }
__device__ __forceinline__ int crow16(int r, int hi) { return (r & 3) + 8 * (r >> 2) + 4 * hi; }

struct Frame {
    LAS unsigned char* lds; int tid, lane, wave, vcu, G;
};
__device__ __forceinline__ float wave_sum(float v) {
#pragma unroll
    for (int o = 1; o < 64; o <<= 1) v += __shfl_xor(v, o);
    return v;
}
__device__ __forceinline__ void p0_transpose_item(const float* W, int pitch, int K, const float* sc, bf16* WT, int dst_row0, int k0, int n0, LAS float* scr, int lane) {
#pragma unroll 8
    for (int i = 0; i < 32; ++i) { const int kk = 2 * i + (lane >> 5); float v = W[(size_t)(k0 + kk) * pitch + n0 + (lane & 31)]; if (sc) v *= sc[k0 + kk]; scr[kk * 33 + (lane & 31)] = v; }
    LDS_WAIT(); asm volatile("" ::: "memory");
    const int c = lane & 7;
#pragma unroll
    for (int j = 0; j < 4; ++j) { const int n = (lane >> 3) + 8 * j; const LAS float* s = scr + (8 * c) * 33 + n;
        v4u o; o.x = pk2(s[0 * 33], s[1 * 33]); o.y = pk2(s[2 * 33], s[3 * 33]); o.z = pk2(s[4 * 33], s[5 * 33]); o.w = pk2(s[6 * 33], s[7 * 33]);
        *(GAS v4u*)(WT + (size_t)(dst_row0 + n) * K + k0 + 8 * c) = o; }
    LDS_WAIT(); asm volatile("" ::: "memory");
}
__device__ __forceinline__ int map_in_row(int n) {
    if (n < 2048 || n >= 3072) return n;
    const int local = n - 2048, tile = local >> 8, o = local & 255, wc = o >> 6, w = o & 63, bj = w >> 5, x = w & 31;
    return 2048 + tile * 256 + bj * 128 + wc * 32 + x;
}
struct Ptrs {
    const float *x, *lower_bounds, *norm1_w, *w_in, *fox_f_bias, *q_norm_w, *k_norm_w, *hgrn_norm_w, *w_out, *norm2_w, *w_up, *w_down;
    float* out; unsigned char* ws;
};
__device__ __forceinline__ void p0_prologue(Frame& F, const Ptrs& P) {
    LAS float* scr = (LAS float*)(F.lds + F.wave * 16384);
    const int gw = F.vcu * NWAVES + F.wave, NGW = F.G * NWAVES;
    constexpr int I_IN = 16 * 112, I_OUT = 16 * 32, I_UP = 16 * 128, I_DN = 64 * 32, I_L = I_IN + I_OUT + I_UP + I_DN;
    for (int it = gw; it < DEPTH * I_L; it += NGW) {
        const int l = it / I_L; int r = it % I_L;
        if (r < I_IN) { const int kb = r / 112, nb = r % 112; p0_transpose_item(P.w_in + (size_t)l * D * IN_COLS, IN_COLS, D, P.norm1_w + l * D, (bf16*)(P.ws + WS_WIN + l * WIN_BYTES), map_in_row(32 * nb), 64 * kb, 32 * nb, scr, F.lane); continue; } r -= I_IN;
        if (r < I_OUT) { const int kb = r / 32, nb = r % 32; p0_transpose_item(P.w_out + (size_t)l * D * D, D, D, nullptr, (bf16*)(P.ws + WS_WOUT + l * 2 * MiB), 32 * nb, 64 * kb, 32 * nb, scr, F.lane); continue; } r -= I_OUT;
        if (r < I_UP) { const int kb = r / 128, nb = r % 128; p0_transpose_item(P.w_up + (size_t)l * D * FF, FF, D, P.norm2_w + l * D, (bf16*)(P.ws + WS_WUP + l * 8 * MiB), 32 * nb, 64 * kb, 32 * nb, scr, F.lane); continue; } r -= I_UP;
        { const int kb = r / 32, nb = r % 32; p0_transpose_item(P.w_down + (size_t)l * FF * D, D, FF, nullptr, (bf16*)(P.ws + WS_WDN + l * 8 * MiB), 32 * nb, 64 * kb, 32 * nb, scr, F.lane); }
    }
    { const int gt = F.vcu * NTHREADS + F.tid;
      for (int e = gt; e < DEPTH * 256 * 128; e += F.G * NTHREADS) { const int l = e >> 15, j = (e >> 7) & 255, kc = e & 127; float v[8];
#pragma unroll
          for (int i = 0; i < 8; ++i) v[i] = (j < 8) ? P.w_in[(size_t)l * D * IN_COLS + (size_t)(8 * kc + i) * IN_COLS + 3584 + j] * P.norm1_w[l * D + 8 * kc + i] : 0.f;
          v4u o; o.x = pk2(v[0], v[1]); o.y = pk2(v[2], v[3]); o.z = pk2(v[4], v[5]); o.w = pk2(v[6], v[7]);
          *(GAS v4u*)((bf16*)(P.ws + WS_WIN + l * WIN_BYTES) + (size_t)(3584 + j) * D + 8 * kc) = o; } }
    bf16* XB = (bf16*)(P.ws + WS_XB); float* ssq = (float*)(P.ws + WS_SSQ);
    for (int m = gw; m < M; m += NGW) { const GAS f32x4* xr = (const GAS f32x4*)(P.x + (size_t)m * D) + F.lane; f32x4 v[4]; float s = 0.f;
#pragma unroll
        for (int j = 0; j < 4; ++j) { v[j] = xr[64 * j]; s += (v[j].x * v[j].x + v[j].y * v[j].y) + (v[j].z * v[j].z + v[j].w * v[j].w); }
        s = wave_sum(s); if (F.lane == 0) ssq[m] = s;
        GAS unsigned long long* o8 = (GAS unsigned long long*)(XB + (size_t)m * D) + F.lane;
#pragma unroll
        for (int j = 0; j < 4; ++j) o8[64 * j] = (unsigned long long)pk2(v[j].x, v[j].y) | ((unsigned long long)pk2(v[j].z, v[j].w) << 32); }
}

constexpr int HC = 64, NCH = T / HC;
constexpr int H_KD = 0, H_QE = 0, H_QM = 17408, H_KM = 34816, H_VT = 52224, H_AM = 70656, H_OS = 79872, H_TOT = 113664, H_BM = 115712;
__device__ __forceinline__ f32x16 mfma32(bf16x8 a, bf16x8 b, f32x16 c) { return __builtin_amdgcn_mfma_f32_32x32x16_bf16(a, b, c, 0, 0, 0); }
#define HGRN_SCAN(lfv, bv, blast)  \
    float lfv[16], bv[16]; float blast; { const float* lfp = lf + (size_t)(m0 + part * 16) * 512 + h * 128 + k; \
      _Pragma("unroll") for (int i = 0; i < 16; ++i) lfv[i] = lfp[(size_t)i * 512]; \
      float run = 0.f; _Pragma("unroll") for (int i = 0; i < 16; ++i) { run += lfv[i]; bv[i] = run; } \
      LAS float* TOT = (LAS float*)(F.lds + H_TOT); TOT[part * 128 + k] = run; __syncthreads(); \
      const float t0 = TOT[k], t1 = TOT[128 + k], t2 = TOT[256 + k], t3 = TOT[384 + k]; \
      const float off = (part > 0 ? t0 : 0.f) + (part > 1 ? t1 : 0.f) + (part > 2 ? t2 : 0.f); blast = (t0 + t1) + (t2 + t3); \
      _Pragma("unroll") for (int i = 0; i < 16; ++i) bv[i] += off; }
#define HGRN_VT() { const bf16* vp = hv + (size_t)(m0 + part * 16) * 512 + h * 128 + k; unsigned w_[8]; \
      _Pragma("unroll") for (int i = 0; i < 8; ++i) w_[i] = (unsigned)vp[(size_t)(2 * i) * 512] | ((unsigned)vp[(size_t)(2 * i + 1) * 512] << 16); \
      LAS v4u* d_ = (LAS v4u*)(F.lds + H_VT + k * 144 + part * 32); d_[0] = (v4u){w_[0], w_[1], w_[2], w_[3]}; d_[1] = (v4u){w_[4], w_[5], w_[6], w_[7]}; }
__device__ __forceinline__ void hgrn_pass_a(Frame& F, const float* lf, const bf16* hv, bf16* ST, float* DL) {
    const int k = F.tid & 127, part = F.tid >> 7, l31 = F.lane & 31, hi = F.lane >> 5;
    for (int it = F.vcu; it < 8 * NCH; it += F.G) {
        const int bh = it >> 7, c = it & 127, b = bh >> 2, h = bh & 3; const int m0 = b * T + c * HC;
        HGRN_SCAN(lfv, bv, blast)
        { unsigned w_[8];
#pragma unroll
          for (int i = 0; i < 8; ++i) { const float a0 = (1.0f - __expf(lfv[2 * i])) * __expf(blast - bv[2 * i]), a1 = (1.0f - __expf(lfv[2 * i + 1])) * __expf(blast - bv[2 * i + 1]); w_[i] = pk2(a0, a1); }
          LAS v4u* d_ = (LAS v4u*)(F.lds + H_KD + k * 144 + part * 32); d_[0] = (v4u){w_[0], w_[1], w_[2], w_[3]}; d_[1] = (v4u){w_[4], w_[5], w_[6], w_[7]}; }
        if (part == 0) DL[(size_t)it * 128 + k] = __expf(blast);
        HGRN_VT()
        __syncthreads();
        const int mt = F.wave >> 1, nt0 = (F.wave & 1) * 2; f32x16 a0 = {}, a1 = {};
#pragma unroll
        for (int ks = 0; ks < 4; ++ks) { const bf16x8 av = *(const LAS bf16x8*)(F.lds + H_VT + (32 * mt + l31) * 144 + (16 * ks + 8 * hi) * 2);
            const bf16x8 b0 = *(const LAS bf16x8*)(F.lds + H_KD + (32 * nt0 + l31) * 144 + (16 * ks + 8 * hi) * 2), b1 = *(const LAS bf16x8*)(F.lds + H_KD + (32 * nt0 + 32 + l31) * 144 + (16 * ks + 8 * hi) * 2);
            a0 = mfma32(av, b0, a0); a1 = mfma32(av, b1, a1); }
        bf16* U = ST + (size_t)it * 16384;
#pragma unroll
        for (int r = 0; r < 16; ++r) { const int v = 32 * mt + crow16(r, hi); U[v * 128 + 32 * nt0 + l31] = (bf16)f2bf(a0[r]); U[v * 128 + 32 * nt0 + 32 + l31] = (bf16)f2bf(a1[r]); }
        __syncthreads();
    }
}
__device__ __forceinline__ void hgrn_pass_b(Frame& F, bf16* ST, const float* DL) {
    if (F.tid >= 256) return;
    for (int e = F.vcu * 256 + F.tid; e < 8 * 8192; e += F.G * 256) {
        const int bh = e >> 13, rem = e & 8191, k = (rem & 63) * 2;
        unsigned* up = (unsigned*)(ST + (size_t)bh * NCH * 16384) + rem; const float* dp = DL + (size_t)bh * NCH * 128 + k;
        float s0 = 0.f, s1 = 0.f;
        for (int c0 = 0; c0 < NCH; c0 += 8) { unsigned u[8]; float d0[8], d1[8];
#pragma unroll
            for (int j = 0; j < 8; ++j) { u[j] = up[(size_t)(c0 + j) * 8192]; d0[j] = dp[(c0 + j) * 128]; d1[j] = dp[(c0 + j) * 128 + 1]; }
#pragma unroll
            for (int j = 0; j < 8; ++j) { up[(size_t)(c0 + j) * 8192] = pk2(s0, s1); s0 = d0[j] * s0 + bf2f((unsigned short)(u[j] & 0xffffu)); s1 = d1[j] * s1 + bf2f((unsigned short)(u[j] >> 16)); } }
    }
}
__device__ __forceinline__ void hgrn_pass_c(Frame& F, const bf16* hq, const float* lf, const bf16* hv, const bf16* hg, const bf16* ST, const float* nw, bf16* mix) {
    const int k = F.tid & 127, part = F.tid >> 7, l31 = F.lane & 31, hi = F.lane >> 5;
    for (int it = F.vcu; it < 8 * NCH; it += F.G) {
        const int bh = it >> 7, c = it & 127, b = bh >> 2, h = bh & 3; const int m0 = b * T + c * HC;
        HGRN_SCAN(lfv, bv, blast)
        (void)blast;
        LAS float* BMID = (LAS float*)(F.lds + H_BM);
        if (part == 1) BMID[k] = bv[15];
        __syncthreads();
        const float bm = BMID[k];
        { const bf16* qp = hq + (size_t)(m0 + part * 16) * 512 + h * 128 + k;
#pragma unroll
          for (int i = 0; i < 16; ++i) { const int t = part * 16 + i; const float q = bf2f(qp[(size_t)i * 512]);
              *(LAS bf16*)(F.lds + H_QE + t * 272 + k * 2) = (bf16)f2bf(q * __expf(bv[i]));
              *(LAS bf16*)(F.lds + H_QM + t * 272 + k * 2) = (bf16)f2bf(q * __expf(fminf(bv[i] - bm, 80.f)));
              *(LAS bf16*)(F.lds + H_KM + t * 272 + k * 2) = (bf16)f2bf((1.0f - __expf(lfv[i])) * __expf(fminf(bm - bv[i], 80.f))); } }
        HGRN_VT()
        __syncthreads();
        const int mt = F.wave >> 2, nt = F.wave & 3; f32x16 acc = {};
        { const bf16* sp = ST + (size_t)it * 16384 + (size_t)(32 * nt + l31) * 128 + 8 * hi;
#pragma unroll
          for (int ks = 0; ks < 8; ++ks) { const bf16x8 av = *(const LAS bf16x8*)(F.lds + H_QE + (32 * mt + l31) * 272 + (16 * ks + 8 * hi) * 2); const bf16x8 bvv = *(const bf16x8*)(sp + 16 * ks); acc = mfma32(av, bvv, acc); } }
        if (F.wave < 4) { const int mt2 = F.wave >> 1, nt2 = F.wave & 1; f32x16 am = {};
#pragma unroll
            for (int ks = 0; ks < 8; ++ks) { const bf16x8 av = *(const LAS bf16x8*)(F.lds + H_QM + (32 * mt2 + l31) * 272 + (16 * ks + 8 * hi) * 2), bvv = *(const LAS bf16x8*)(F.lds + H_KM + (32 * nt2 + l31) * 272 + (16 * ks + 8 * hi) * 2); am = mfma32(av, bvv, am); }
#pragma unroll
            for (int r = 0; r < 16; ++r) { const int t = 32 * mt2 + crow16(r, hi), s = 32 * nt2 + l31; *(LAS bf16*)(F.lds + H_AM + t * 144 + s * 2) = (bf16)f2bf(s <= t ? am[r] : 0.f); } }
        __syncthreads();
#pragma unroll
        for (int ks = 0; ks < 4; ++ks) { const bf16x8 av = *(const LAS bf16x8*)(F.lds + H_AM + (32 * mt + l31) * 144 + (16 * ks + 8 * hi) * 2), bvv = *(const LAS bf16x8*)(F.lds + H_VT + (32 * nt + l31) * 144 + (16 * ks + 8 * hi) * 2); acc = mfma32(av, bvv, acc); }
#pragma unroll
        for (int r = 0; r < 16; ++r) *(LAS float*)(F.lds + H_OS + (32 * mt + crow16(r, hi)) * 528 + (32 * nt + l31) * 4) = acc[r];
        __syncthreads();
        { const int t = F.tid >> 3, seg = F.tid & 7; f32x4 o[4]; float ss = 0.f;
#pragma unroll
          for (int j = 0; j < 4; ++j) { o[j] = *(const LAS f32x4*)(F.lds + H_OS + t * 528 + (seg * 16 + 4 * j) * 4); ss += (o[j][0] * o[j][0] + o[j][1] * o[j][1]) + (o[j][2] * o[j][2] + o[j][3] * o[j][3]); }
          ss += __shfl_xor(ss, 1); ss += __shfl_xor(ss, 2); ss += __shfl_xor(ss, 4);
          const float rs = rsqrtf(ss * (1.0f / 128.0f) + 1e-6f);
          const v4u g0 = *(const v4u*)(hg + (size_t)(m0 + t) * 512 + h * 128 + seg * 16), g1 = *(const v4u*)(hg + (size_t)(m0 + t) * 512 + h * 128 + seg * 16 + 8);
          const unsigned gw_[8] = {g0.x, g0.y, g0.z, g0.w, g1.x, g1.y, g1.z, g1.w}; unsigned w_[8];
#pragma unroll
          for (int j = 0; j < 4; ++j) { const f32x4 wv = *(const f32x4*)(nw + seg * 16 + 4 * j);
              const float e0 = o[j][0] * rs * wv[0] * bf2f((unsigned short)(gw_[2 * j] & 0xffffu)), e1 = o[j][1] * rs * wv[1] * bf2f((unsigned short)(gw_[2 * j] >> 16));
              const float e2 = o[j][2] * rs * wv[2] * bf2f((unsigned short)(gw_[2 * j + 1] & 0xffffu)), e3 = o[j][3] * rs * wv[3] * bf2f((unsigned short)(gw_[2 * j + 1] >> 16));
              w_[2 * j] = pk2(e0, e1); w_[2 * j + 1] = pk2(e2, e3); }
          v4u* op = (v4u*)(mix + (size_t)(m0 + t) * 1024 + h * 128 + seg * 16); op[0] = (v4u){w_[0], w_[1], w_[2], w_[3]}; op[1] = (v4u){w_[4], w_[5], w_[6], w_[7]}; }
        __syncthreads();
    }
}
#define RLX_AGENT __ATOMIC_RELAXED, __HIP_MEMORY_SCOPE_AGENT
#define XB_TMO      128
#define XB_XCNT(j)  (256  + 64 * (j))
#define XB_XSUB(j)  (1280 + 64 * (j))
#define XB_XGEN(j)  (2304 + 64 * (j))
#define XB_TOP      3328
#define XB_TOPGEN   3392
#define XCD_BAR_WORDS 3456
#define XB_SPIN_CAP (1u << 18)

__device__ __forceinline__ unsigned xb_ld(unsigned* p)              { return __hip_atomic_load(p, __ATOMIC_RELAXED, __HIP_MEMORY_SCOPE_AGENT); }
__device__ __forceinline__ unsigned xb_add(unsigned* p, unsigned v) { return __hip_atomic_fetch_add(p, v, __ATOMIC_RELAXED, __HIP_MEMORY_SCOPE_AGENT); }
__device__ __forceinline__ unsigned xb_xcc_id() { return (unsigned)__builtin_amdgcn_s_getreg((3 << 11) | 20) & 0xFu; }
#define XB_SPIN(cond, bar) do { unsigned _sp = 0; while (cond) { __builtin_amdgcn_s_sleep(1); \
    if ((++_sp & 255u) == 0u) { if (xb_ld(&(bar)[XB_TMO])) break; if (_sp > XB_SPIN_CAP) { atomicAdd(&(bar)[XB_TMO], 1u); break; } } } } while (0)

struct XcdBarrier {
    unsigned* bar; unsigned x;
    volatile LAS unsigned* st;
};

__device__ __forceinline__ XcdBarrier xcd_barrier_post(unsigned* bar, volatile LAS unsigned* st) {
    XcdBarrier b; b.bar = bar; b.x = xb_xcc_id(); b.st = st;
    if (threadIdx.x == 0) (void)xb_add(&bar[XB_XCNT(b.x)], 1u);
    return b;
}
__device__ __forceinline__ void xcd_barrier_complete(unsigned* bar, unsigned x, unsigned& nloc, unsigned& nx) {
    const unsigned G = gridDim.x * gridDim.y * gridDim.z;
    unsigned sum, cnt, mine, sp = 0u;
    for (;;) {
        sum = 0u; cnt = 0u; mine = 0u;
#pragma unroll
        for (unsigned j = 0; j < 16; ++j) { const unsigned c = xb_ld(&bar[XB_XCNT(j)]); sum += c; cnt += (c > 0u) ? 1u : 0u; mine = (j == x) ? c : mine; }
        if (sum == G) break;
        __builtin_amdgcn_s_sleep(1);
        if ((++sp & 255u) == 0u) { if (xb_ld(&bar[XB_TMO])) break; if (sp > XB_SPIN_CAP) { atomicAdd(&bar[XB_TMO], 1u); break; } }
    }
    nloc = mine > 0u ? mine : 1u; nx = cnt > 0u ? cnt : 1u;
}

__device__ __forceinline__ void xcd_barrier(const XcdBarrier& b) {
    asm volatile("s_waitcnt vmcnt(0)" ::: "memory");
    __syncthreads();
    if (threadIdx.x == 0) {
        unsigned* bar = b.bar;
        __builtin_amdgcn_s_waitcnt(0);
        unsigned nloc = b.st[0], nx = b.st[1];
        if (nloc == 0u) { xcd_barrier_complete(bar, b.x, nloc, nx); b.st[0] = nloc; b.st[1] = nx; }
        const unsigned old = xb_add(&bar[XB_XSUB(b.x)], 1u);
        const unsigned gen = old / nloc;
        if (old + 1u == (gen + 1u) * nloc) {
            __builtin_amdgcn_fence(__ATOMIC_RELEASE, "agent");
            asm volatile("s_waitcnt vmcnt(0)" ::: "memory");
            const unsigned og = xb_add(&bar[XB_TOP], 1u);
            const unsigned tg = og / nx;
            if (og + 1u == (tg + 1u) * nx) xb_add(&bar[XB_TOPGEN], 1u);
            else XB_SPIN(xb_ld(&bar[XB_TOPGEN]) == tg, bar);
            __builtin_amdgcn_fence(__ATOMIC_ACQUIRE, "agent");
            xb_add(&bar[XB_XGEN(b.x)], 1u);
            asm volatile("s_waitcnt vmcnt(0)" ::: "memory");
        } else {
            XB_SPIN(xb_ld(&bar[XB_XGEN(b.x)]) == gen, bar);
            __builtin_amdgcn_fence(__ATOMIC_ACQUIRE, "agent");
            asm volatile("s_waitcnt vmcnt(0)" ::: "memory");
        }
    }
    __syncthreads();
}

#ifndef FOX_SKIP
#define FOX_SKIP 1
#endif
__device__ __forceinline__ void fox_phase(Frame& F, unsigned char* lds_generic, const float* lsig, const bf16* Q, const bf16* Kb, const bf16* V, bf16* mix) {
    using attn_body::LDS_DK; using attn_body::LDS_WS; using attn_body::attn_unit;
    LAS float* dk = (LAS float*)(F.lds + LDS_DK);
    LAS double* wtot = (LAS double*)(F.lds + LDS_WS);
    for (int pr = F.vcu; pr < 256; pr += F.G) {
        const int bh = pr >> 4, s = pr & 15, b = bh >> 3, h = bh & 7;
        { int tid_ = F.tid; asm volatile("" : "+v"(tid_)); const int lane_ = tid_ & 63;
          const float* lp = lsig + ((size_t)b * T + tid_ * 16) * 8 + h; double v[16]; double run = 0.0;
#pragma unroll
          for (int i = 0; i < 16; ++i) { run -= (double)lp[i * 8]; v[i] = run; }
          double inc = run;
#pragma unroll
          for (int o = 1; o < 64; o <<= 1) { const double t = __shfl_up(inc, o); if (lane_ >= o) inc += t; }
          if (lane_ == 63) wtot[F.wave] = inc;
          __syncthreads();
          double off = inc - run;
          for (int w = 0; w < F.wave; ++w) off += wtot[w];
#pragma unroll
          for (int i = 0; i < 16; ++i) dk[tid_ * 16 + i] = (float)((v[i] + off) * 1.4426950408889634);
          __syncthreads(); }
#pragma unroll 1
        for (int i = 0; i < 2; ++i) {
            const int qb = (i == 0) ? 31 - s : s; const int NTA = 4 * qb + 4; int NT = NTA;
#if FOX_SKIP
            { const float ref = dk[qb * 256]; int lo = 0, hi_ = NTA - 4;
              while (lo < hi_) { const int mid = (lo + hi_) >> 1; if (dk[64 * mid + 63] - ref < -200.0f) lo = mid + 1; else hi_ = mid; }
              int nold = (NTA - 4) - lo; nold += (nold & 1); NT = 4 + nold; }
#endif
            attn_unit<8>(b, h, qb, NT, (const attn_body::bf16*)Q, (const attn_body::bf16*)Kb, (const attn_body::bf16*)V, (attn_body::bf16*)(mix + 512), (char*)lds_generic);
        }
        __syncthreads();
    }
}

struct Args { Ptrs p; int ph_lo, ph_hi; };
constexpr int N_PHASES = 1 + 7 * DEPTH;
__global__ void __launch_bounds__(NTHREADS, 2) hymba_fwd(Args args) {
    extern __shared__ __attribute__((aligned(16))) unsigned char lds[];
    Frame F; F.lds = (LAS unsigned char*)lds; F.tid = threadIdx.x; F.lane = F.tid & 63; F.wave = __builtin_amdgcn_readfirstlane(F.tid >> 6);
    F.G = gridDim.x; { const int bx = blockIdx.x; F.vcu = (F.G % 8 == 0) ? (bx % 8) * (F.G / 8) + bx / 8 : bx; }
    const Ptrs& P = args.p;
    const int lo = args.ph_lo, hi = args.ph_hi;
    volatile LAS unsigned* bst = (volatile LAS unsigned*)(F.lds + 131072 + 64);
    if (F.tid < 2) bst[F.tid] = 0u;
    __syncthreads();
    XcdBarrier bar; bar.bar = (unsigned*)(P.ws + WS_CTL + 16384); bar.x = 0; bar.st = bst;
    if (hi - lo > 1) bar = xcd_barrier_post((unsigned*)(P.ws + WS_CTL + 16384), bst);
#define PHASE_ENV() int t__ = threadIdx.x; asm volatile("" : "+v"(t__)); F.tid = t__; F.lane = t__ & 63; unsigned char* ws = P.ws; asm volatile("" : "+s"(ws)); \
    float* ssq = (float*)(ws + WS_SSQ); float* lsig = (float*)(ws + WS_LSIG); \
    bf16* XB = (bf16*)(ws + WS_XB); bf16* ST = (bf16*)(ws + WS_ST); float* DL = (float*)(ws + WS_DL); \
    bf16* HQ = (bf16*)(ws + WS_HQ); float* LF = (float*)(ws + WS_LF); bf16* HV = (bf16*)(ws + WS_HV); bf16* HG = (bf16*)(ws + WS_HG); \
    bf16* Qb = (bf16*)(ws + WS_Q); bf16* Kb = (bf16*)(ws + WS_K); bf16* Vb = (bf16*)(ws + WS_V); bf16* HB = (bf16*)(ws + WS_H); \
    (void)ssq; (void)lsig; (void)XB; (void)ST; (void)DL; (void)HQ; (void)LF; (void)HV; (void)HG; (void)Qb; (void)Kb; (void)Vb; (void)HB;
#define IN(k) (lo <= (k) && (k) < hi)
#define SEAM(k) do { if (IN(k) && IN((k) + 1)) { if ((k) == 0) cg::this_grid().sync(); else xcd_barrier(bar); } } while (0)
    if (IN(0)) { PHASE_ENV() p0_prologue(F, P); }
    SEAM(0);
#pragma unroll 1
    for (int l = 0; l < DEPTH; ++l) {
        const int pb = 1 + 7 * l;
        if (IN(pb)) { PHASE_ENV()
            pg8::Gemm g{XB, (const bf16*)(ws + WS_WIN + l * WIN_BYTES), M, NIN, D}; pg8::StaticOrder S; S.init(M, NIN, F.G, (int)blockIdx.x);
            pg8::EpiIn E{ssq + (size_t)(2 * l) * M, HQ, HV, HG, Qb, Kb, Vb, LF, lsig, P.lower_bounds, P.lower_bounds + 512, l, P.q_norm_w + l * 64, P.k_norm_w + l * 64, P.fox_f_bias + l * 8};
            pg8::gemm_phase<pg8::EpiIn, pg8::StaticOrder, true, true>(F.lds, g, S, E);
        }
        SEAM(pb);
        if (IN(pb + 1)) { PHASE_ENV()
            fox_phase(F, lds, lsig, Qb, Kb, Vb, XB);
            hgrn_pass_a(F, LF, HV, ST, DL);
        }
        SEAM(pb + 1);
        if (IN(pb + 2)) { PHASE_ENV() hgrn_pass_b(F, ST, DL); }
        SEAM(pb + 2);
        if (IN(pb + 3)) { PHASE_ENV() hgrn_pass_c(F, HQ, LF, HV, HG, ST, P.hgrn_norm_w + l * 128, XB); }
        SEAM(pb + 3);
        if (IN(pb + 4)) { PHASE_ENV()
            pg8::Gemm g{XB, (const bf16*)(ws + WS_WOUT + l * 2 * MiB), M, D, D}; pg8::StaticOrder S; S.init(M, D, F.G, (int)blockIdx.x);
            pg8::EpiRes E{l == 0 ? P.x : P.out, P.out, ST, ssq + (size_t)(2 * l + 1) * M};
            pg8::gemm_phase<pg8::EpiRes, pg8::StaticOrder, true, true>(F.lds, g, S, E);
        }
        SEAM(pb + 4);
        if (IN(pb + 5)) { PHASE_ENV()
            pg8::Gemm g{ST, (const bf16*)(ws + WS_WUP + l * 8 * MiB), M, FF, D}; pg8::StaticOrder S; S.init(M, FF, F.G, (int)blockIdx.x);
            pg8::EpiUp E{ssq + (size_t)(2 * l + 1) * M, HB};
            pg8::gemm_phase<pg8::EpiUp, pg8::StaticOrder, true, true>(F.lds, g, S, E);
        }
        SEAM(pb + 5);
        if (IN(pb + 6)) { PHASE_ENV()
            pg8::Gemm g{HB, (const bf16*)(ws + WS_WDN + l * 8 * MiB), M, D, FF}; pg8::StaticOrder S; S.init(M, D, F.G, (int)blockIdx.x);
            const bool last = (l == DEPTH - 1);
            pg8::EpiRes E{P.out, P.out, last ? nullptr : XB, last ? nullptr : ssq + (size_t)(2 * l + 2) * M};
            pg8::gemm_phase<pg8::EpiRes, pg8::StaticOrder, true, true>(F.lds, g, S, E);
        }
        SEAM(pb + 6);
    }
#undef IN
#undef SEAM
}

#ifndef MK_PER_PHASE
#define MK_PER_PHASE 0
#endif
extern "C" void kernel_launch(void* const* d_in, const int* in_sizes, int n_in, void* d_out, int out_size, void* d_ws, size_t ws_size, hipStream_t stream) {
    static int grid = 0;
    if (grid == 0) {
        if (n_in != 12 || out_size != M * D || ws_size < WS_DL + MiB) { fprintf(stderr, "kernel_launch: unexpected sizes (n_in %d out %d ws %zu)\n", n_in, out_size, ws_size); grid = -1; return; }
        int dev = 0, cus = 0, per_cu = 0;
        (void)hipGetDevice(&dev); (void)hipDeviceGetAttribute(&cus, hipDeviceAttributeMultiprocessorCount, dev);
        if (hipFuncSetAttribute((const void*)hymba_fwd, hipFuncAttributeMaxDynamicSharedMemorySize, LDS_BYTES) != hipSuccess) { fprintf(stderr, "kernel_launch: hipFuncSetAttribute failed\n"); grid = -1; return; }
        if (hipOccupancyMaxActiveBlocksPerMultiprocessor(&per_cu, (const void*)hymba_fwd, NTHREADS, LDS_BYTES) != hipSuccess || per_cu < 1) { fprintf(stderr, "kernel_launch: occupancy query gave %d\n", per_cu); per_cu = 1; }
        (void)hipGetLastError();
        grid = cus * 1;
        fprintf(stderr, "kernel_launch: cus %d per_cu %d grid %d\n", cus, per_cu, grid);
    }
    if (grid < 0) return;
    (void)hipMemsetAsync((char*)d_ws + WS_CTL, 0, CTL_ZERO_BYTES, stream);
    Args a{};
    a.p.x = (const float*)d_in[0]; a.p.lower_bounds = (const float*)d_in[1]; a.p.norm1_w = (const float*)d_in[2]; a.p.w_in = (const float*)d_in[3];
    a.p.fox_f_bias = (const float*)d_in[4]; a.p.q_norm_w = (const float*)d_in[5]; a.p.k_norm_w = (const float*)d_in[6]; a.p.hgrn_norm_w = (const float*)d_in[7];
    a.p.w_out = (const float*)d_in[8]; a.p.norm2_w = (const float*)d_in[9]; a.p.w_up = (const float*)d_in[10]; a.p.w_down = (const float*)d_in[11];
    a.p.out = (float*)d_out; a.p.ws = (unsigned char*)d_ws;
#if MK_PER_PHASE
    for (int ph = 0; ph < N_PHASES; ++ph) { a.ph_lo = ph; a.ph_hi = ph + 1; hipLaunchKernelGGL(hymba_fwd, dim3(grid), dim3(NTHREADS), LDS_BYTES, stream, a); }
#else
    a.ph_lo = 0; a.ph_hi = N_PHASES;
    void* kargs[] = {&a};
    const hipError_t e = hipLaunchCooperativeKernel((const void*)hymba_fwd, dim3(grid), dim3(NTHREADS), kargs, LDS_BYTES, stream);
    if (e != hipSuccess) fprintf(stderr, "kernel_launch: cooperative launch failed: %s (grid %d)\n", hipGetErrorString(e), grid);
#endif
}
```

```cpp
#include <hip/hip_runtime.h>
#include <hip/hip_cooperative_groups.h>
#include <cstdio>
#include <cstdint>
namespace cg = cooperative_groups;
namespace pg8 {
#define PG8_LAS __attribute__((address_space(3)))
typedef unsigned short bf16_t;
typedef short bf16x8 __attribute__((ext_vector_type(8)));
typedef float f32x4 __attribute__((ext_vector_type(4)));
typedef unsigned u32x4 __attribute__((ext_vector_type(4)));
constexpr int BM = 256, BK = 64, HALF = 128, HTB = HALF * BK * 2  , STAGE_BYTES = 8 * HTB, NXCD = 8, WGM = 8;

__host__ __device__ __forceinline__ int lds_byte(int r, int c) { const int st = (r >> 4) * 2 + (c >> 5), rr = r & 15, cc = c & 31, ob = rr * 64 + cc * 2; return st * 1024 + (ob ^ (((ob >> 9) & 1) << 5)); }
__host__ __device__ __forceinline__ void stage_rc(int b, int& R, int& C) { const int st = b / 1024, sb = b % 1024, swz = sb ^ (((sb >> 9) & 1) << 5); R = (st >> 1) * 16 + swz / 64; C = (st & 1) * 32 + (swz % 64) / 2; }
__host__ __device__ __forceinline__ int perm32(int rho) { const int n = rho >> 4, i = rho & 15; return 8 * (i >> 2) + 4 * n + (i & 3); }

struct Unit { int pm, pn; };
struct Gemm { const bf16_t* A; const bf16_t* Bt; int M, N, K; };

struct StaticOrder {
    int nM, nN, nwg, G, c;
    __host__ __device__ void init(int M, int N, int G_, int c_) { nM = M / BM; nN = N / BM; nwg = nM * nN; G = G_; c = c_; }
    __host__ __device__ bool next(int i, Unit& u) const {
        const long L = (long)i * G + c; if (L >= nwg) return false;
        int wgid = (int)L; { const int q = nwg / NXCD, r = nwg % NXCD, xcd = wgid % NXCD, off = wgid / NXCD; wgid = (xcd < r ? xcd * (q + 1) : r * (q + 1) + (xcd - r) * q) + off; }
        const int nig = WGM * nN, gid = wgid / nig, fm = gid * WGM, gsz = (nM - fm) < WGM ? (nM - fm) : WGM;
        u.pm = fm + ((wgid % nig) % gsz); u.pn = (wgid % nig) / gsz; return true;
    }
    __device__ __forceinline__ void a_ready(const Unit&) const {}
    __device__ __forceinline__ void done(const Unit&) const {}
};

__device__ __forceinline__ unsigned cvt_pk_bf16(float lo, float hi) { unsigned r; asm volatile("v_cvt_pk_bf16_f32 %0, %1, %2" : "=v"(r) : "v"(lo), "v"(hi)); return r; }
typedef float f32x2 __attribute__((ext_vector_type(2)));
template <class Epi, class Sched, bool ALIGN_EPI = false, bool SP2 = false>
__device__ __forceinline__ void gemm_phase(PG8_LAS unsigned char* lds, const Gemm g, const Sched& S, const Epi& E) {
    int tid_o = threadIdx.x; asm volatile("" : "+v"(tid_o));
    const int tid = tid_o, wid = __builtin_amdgcn_readfirstlane(tid >> 6), lane = tid & 63, wr = wid >> 2, wc = wid & 3, fr = lane & 15, fq = lane >> 4;
    const int K = g.K, nt = K / BK;
    unsigned voffA[2], voffB[2];
#pragma unroll
    for (int i = 0; i < 2; ++i) { int R, C; stage_rc(tid * 16 + i * 8192, R, C); const int Rb = Epi::PERM ? ((R & ~31) + perm32(R & 31)) : R;
        voffA[i] = (unsigned)(R * K + C) * 2u; voffB[i] = (unsigned)(Rb * K + C) * 2u; }
    const size_t kstep = (size_t)(BK * 2);
    const size_t hstep = (size_t)HALF * K * 2;
    const size_t tstep = 2 * hstep;
    const unsigned ldsw = (unsigned)wid * 1024u;
    const int aoff = lds_byte(wr * 64 + fr, fq * 8), boff = lds_byte(wc * 32 + fr, fq * 8);
#define PG8_SA(b, h) (((b) * 2 + (h)) * HTB)
#define PG8_SB(b, h) ((4 + (b) * 2 + (h)) * HTB)
#define PG8_STAGE(bufoff, gbase, voff) do { _Pragma("unroll") for (int _i = 0; _i < 2; ++_i) \
        __builtin_amdgcn_global_load_lds((const unsigned*)((const char*)(gbase) + (voff)[_i]), (PG8_LAS unsigned*)(lds + (bufoff) + ldsw + _i * 8192), 16, 0, 0); } while (0)
#define PG8_LDA(dst, b, h) do { _Pragma("unroll") for (int m = 0; m < 4; ++m) _Pragma("unroll") for (int k = 0; k < 2; ++k) dst[m][k] = *(const PG8_LAS bf16x8*)(lds + PG8_SA(b, h) + aoff + m * 2048 + k * 1024); } while (0)
#define PG8_LDB(dst, b, h) do { _Pragma("unroll") for (int n = 0; n < 2; ++n) _Pragma("unroll") for (int k = 0; k < 2; ++k) dst[n][k] = *(const PG8_LAS bf16x8*)(lds + PG8_SB(b, h) + boff + n * 2048 + k * 1024); } while (0)
#define PG8_MMA(ai, bj, At, Bt) do { __builtin_amdgcn_s_setprio(1); _Pragma("unroll") for (int m = 0; m < 4; ++m) _Pragma("unroll") for (int n = 0; n < 2; ++n) _Pragma("unroll") for (int k = 0; k < 2; ++k) \
        acc[ai][bj][m][n] = __builtin_amdgcn_mfma_f32_16x16x32_bf16(Bt[n][k], At[m][k], acc[ai][bj][m][n], 0, 0, 0); __builtin_amdgcn_s_setprio(0); } while (0)
#define PG8_WAIT_V(n) asm volatile("s_waitcnt vmcnt(" #n ")" ::: "memory")
#define PG8_WAIT_L(n) asm volatile("s_waitcnt lgkmcnt(" #n ")" ::: "memory")
#define PG8_BAR __builtin_amdgcn_s_barrier()
#define PG8_SCHED __builtin_amdgcn_sched_barrier(0)
    Unit cur, nxt; int ui = 0;
    if (!S.next(0, cur)) return;
    f32x4 acc[2][2][4][2];
#pragma unroll
    for (int a = 0; a < 2; ++a)
#pragma unroll
        for (int b = 0; b < 2; ++b)
#pragma unroll
            for (int m = 0; m < 4; ++m)
#pragma unroll
                for (int n = 0; n < 2; ++n) acc[a][b][m][n] = (f32x4){0.f, 0.f, 0.f, 0.f};
    bf16x8 At[4][2], B0[2][2], B1[2][2];
    const char* cA = (const char*)g.A + (size_t)cur.pm * tstep; const char* cB = (const char*)g.Bt + (size_t)cur.pn * tstep;
    S.a_ready(cur);
    if constexpr (SP2) {
        PG8_STAGE(PG8_SB(0, 0), cB, voffB); PG8_STAGE(PG8_SB(0, 1), cB + hstep, voffB); PG8_STAGE(PG8_SA(0, 0), cA, voffA); PG8_STAGE(PG8_SA(0, 1), cA + hstep, voffA);
        if (wr == 1) PG8_BAR;
        PG8_WAIT_V(2); PG8_BAR;
        PG8_STAGE(PG8_SB(1, 0), cB + kstep, voffB); PG8_STAGE(PG8_SA(1, 0), cA + kstep, voffA); PG8_STAGE(PG8_SB(1, 1), cB + hstep + kstep, voffB);
        PG8_WAIT_V(6); PG8_BAR;
    } else {
        PG8_STAGE(PG8_SB(0, 0), cB, voffB); PG8_STAGE(PG8_SA(0, 0), cA, voffA); PG8_STAGE(PG8_SB(0, 1), cB + hstep, voffB); PG8_STAGE(PG8_SA(0, 1), cA + hstep, voffA);
        if (wr == 1) PG8_BAR;
        PG8_WAIT_V(4); PG8_BAR;
        PG8_STAGE(PG8_SB(1, 0), cB + kstep, voffB); PG8_STAGE(PG8_SA(1, 0), cA + kstep, voffA); PG8_STAGE(PG8_SB(1, 1), cB + hstep + kstep, voffB);
        PG8_WAIT_V(6); PG8_BAR;
    }
    for (;;) {
        const bool has_next = S.next(ui + 1, nxt);
        const char* nA = has_next ? (const char*)g.A + (size_t)nxt.pm * tstep : cA; const char* nB = has_next ? (const char*)g.Bt + (size_t)nxt.pn * tstep : cB;
        for (int t = 0; t < nt; t += 2) {
            const bool last = (t == nt - 2);
            const char* a1 = cA + (size_t)(t + 1) * kstep;
            const char* a2 = last ? nA : cA + (size_t)(t + 2) * kstep; const char* b2 = last ? nB : cB + (size_t)(t + 2) * kstep;
            const char* a3 = a2 + kstep; const char* b3 = b2 + kstep;
            if (last && has_next) S.a_ready(nxt);
            if constexpr (SP2) {
            PG8_LDB(B0, 0, 0); PG8_LDB(B1, 0, 1); PG8_SCHED; PG8_LDA(At, 0, 0); PG8_STAGE(PG8_SA(1, 1), a1 + hstep, voffA);
            PG8_WAIT_V(8); PG8_WAIT_L(0); PG8_BAR; PG8_MMA(0, 0, At, B0); PG8_MMA(0, 1, At, B1); PG8_BAR; PG8_SCHED;
            PG8_LDA(At, 0, 1); PG8_STAGE(PG8_SB(0, 0), b2, voffB); PG8_STAGE(PG8_SB(0, 1), b2 + hstep, voffB); PG8_STAGE(PG8_SA(0, 0), a2, voffA);
            PG8_WAIT_V(8); PG8_WAIT_L(0); PG8_BAR; PG8_MMA(1, 0, At, B0); PG8_MMA(1, 1, At, B1); PG8_BAR; PG8_SCHED;
            PG8_LDB(B0, 1, 0); PG8_LDB(B1, 1, 1); PG8_SCHED; PG8_LDA(At, 1, 0); PG8_STAGE(PG8_SA(0, 1), a2 + hstep, voffA);
            PG8_WAIT_V(8); PG8_WAIT_L(0); PG8_BAR; PG8_MMA(0, 0, At, B0); PG8_MMA(0, 1, At, B1); PG8_BAR; PG8_SCHED;
            PG8_LDA(At, 1, 1); PG8_STAGE(PG8_SB(1, 0), b3, voffB); PG8_STAGE(PG8_SB(1, 1), b3 + hstep, voffB); PG8_STAGE(PG8_SA(1, 0), a3, voffA);
            PG8_WAIT_V(8); PG8_WAIT_L(0); PG8_BAR; PG8_MMA(1, 0, At, B0); PG8_MMA(1, 1, At, B1); PG8_BAR; PG8_SCHED;
            } else {
            PG8_LDB(B0, 0, 0); PG8_SCHED; PG8_LDA(At, 0, 0); PG8_STAGE(PG8_SA(1, 1), a1 + hstep, voffA);
            PG8_WAIT_L(8); PG8_BAR; PG8_WAIT_L(0); PG8_MMA(0, 0, At, B0); PG8_BAR; PG8_SCHED;
            PG8_LDB(B1, 0, 1); PG8_STAGE(PG8_SB(0, 0), b2, voffB);
            PG8_BAR; PG8_WAIT_L(0); PG8_MMA(0, 1, At, B1); PG8_BAR;
            PG8_LDA(At, 0, 1); PG8_STAGE(PG8_SA(0, 0), a2, voffA);
            PG8_BAR; PG8_WAIT_L(0); PG8_MMA(1, 0, At, B0); PG8_BAR; PG8_SCHED;
            PG8_STAGE(PG8_SB(0, 1), b2 + hstep, voffB);
            PG8_WAIT_V(6); PG8_BAR; PG8_MMA(1, 1, At, B1); PG8_BAR;
            PG8_LDB(B0, 1, 0); PG8_SCHED; PG8_LDA(At, 1, 0); PG8_STAGE(PG8_SA(0, 1), a2 + hstep, voffA);
            PG8_WAIT_L(8); PG8_BAR; PG8_WAIT_L(0); PG8_MMA(0, 0, At, B0); PG8_BAR; PG8_SCHED;
            PG8_LDB(B1, 1, 1); PG8_STAGE(PG8_SB(1, 0), b3, voffB);
            PG8_BAR; PG8_WAIT_L(0); PG8_MMA(0, 1, At, B1); PG8_BAR;
            PG8_LDA(At, 1, 1); PG8_STAGE(PG8_SA(1, 0), a3, voffA);
            PG8_BAR; PG8_WAIT_L(0); PG8_MMA(1, 0, At, B0); PG8_BAR; PG8_SCHED;
            PG8_STAGE(PG8_SB(1, 1), b3 + hstep, voffB);
            PG8_WAIT_V(6); PG8_BAR; PG8_MMA(1, 1, At, B1); PG8_BAR;
            }
        }
        if constexpr (ALIGN_EPI) { if (wr == 0) PG8_BAR; }
        if constexpr (!Epi::AFTER_DRAIN) { E(acc, cur, wr, wc, fr, fq); S.done(cur); }
        if (!has_next) break;
#pragma unroll
        for (int a = 0; a < 2; ++a)
#pragma unroll
            for (int b = 0; b < 2; ++b)
#pragma unroll
                for (int m = 0; m < 4; ++m)
#pragma unroll
                    for (int n = 0; n < 2; ++n) acc[a][b][m][n] = (f32x4){0.f, 0.f, 0.f, 0.f};
        cur = nxt; cA = nA; cB = nB; ++ui;
        if constexpr (ALIGN_EPI) { if (wr == 1) PG8_BAR; }
    }
    PG8_WAIT_V(0);
    if constexpr (!ALIGN_EPI) { if (wr == 0) PG8_BAR; }
    PG8_BAR;
    if constexpr (Epi::AFTER_DRAIN) { E.fused(acc, cur, wr, wc, fr, fq, lds, wid, lane); S.done(cur); }
#undef PG8_SA
#undef PG8_SB
#undef PG8_STAGE
#undef PG8_LDA
#undef PG8_LDB
#undef PG8_MMA
#undef PG8_WAIT_V
#undef PG8_WAIT_L
#undef PG8_BAR
#undef PG8_SCHED
}
}
namespace pg8 {
typedef unsigned u32x2 __attribute__((ext_vector_type(2)));
__device__ __forceinline__ float fsigmoid(float v) { return 1.0f / (1.0f + __expf(-v)); }
struct EpiIn {
    static constexpr bool PERM = true, AFTER_DRAIN = false;
    const float* ssq;
    bf16_t *hq, *hv, *hg, *Q, *Kb, *V; float* lf; float* lsig;
    const float* lba; const float* lbb;
    int layer; const float* qw; const float* kw; const float* fbias;
    __device__ __forceinline__ void operator()(const f32x4 (&acc)[2][2][4][2], const Unit& u, int wr, int wc, int fr, int fq) const {
        const int pn = u.pn, g = pn >> 1, half = pn & 1;
        const int row0 = u.pm * BM + wr * 64 + fr;
        if (pn == 14) {
            if (wc == 0 && fq == 0) {
                const f32x4 b0 = *(const f32x4*)(fbias), b1 = *(const f32x4*)(fbias + 4);
#pragma unroll
                for (int ai = 0; ai < 2; ++ai)
#pragma unroll
                    for (int m = 0; m < 4; ++m) { const int row = row0 + ai * HALF + m * 16; const float rs = rsqrtf(ssq[row] * (1.0f / 1024.0f) + 1e-6f);
                        f32x4 v0 = acc[ai][0][m][0] * rs + b0, v1 = acc[ai][0][m][1] * rs + b1;
#pragma unroll
                        for (int j = 0; j < 4; ++j) { v0[j] = fminf(v0[j], 0.f) - log1pf(__expf(-fabsf(v0[j]))); v1[j] = fminf(v1[j], 0.f) - log1pf(__expf(-fabsf(v1[j]))); }
                        *(f32x4*)(lsig + (size_t)row * 8) = v0; *(f32x4*)(lsig + (size_t)row * 8 + 4) = v1; }
            }
            return;
        }
        if (g == 4 || g == 5) {
            bf16_t* dst = (g == 4) ? Q : Kb; const float* nw = (g == 4) ? qw : kw; const float osc = (g == 4) ? 0.125f * 1.4426950408889634f : 1.0f;
            f32x4 w[2][2];
#pragma unroll
            for (int bj = 0; bj < 2; ++bj)
#pragma unroll
                for (int n = 0; n < 2; ++n) w[bj][n] = *(const f32x4*)(nw + 32 * bj + 8 * fq + 4 * n) * osc;
            const int col0 = (half * 4 + wc) * 64 + 8 * fq;
#pragma unroll
            for (int ai = 0; ai < 2; ++ai)
#pragma unroll
                for (int m = 0; m < 4; ++m) { const int row = row0 + ai * HALF + m * 16; const float rs = rsqrtf(ssq[row] * (1.0f / 1024.0f) + 1e-6f);
                    f32x4 v[2][2]; float ss = 0.f;
#pragma unroll
                    for (int bj = 0; bj < 2; ++bj)
#pragma unroll
                        for (int n = 0; n < 2; ++n) { v[bj][n] = acc[ai][bj][m][n] * rs; ss += (v[bj][n][0] * v[bj][n][0] + v[bj][n][1] * v[bj][n][1]) + (v[bj][n][2] * v[bj][n][2] + v[bj][n][3] * v[bj][n][3]); }
                    ss += __shfl_xor(ss, 16); ss += __shfl_xor(ss, 32);
                    const float hr = rsqrtf(ss * (1.0f / 64.0f) + 1e-6f);
#pragma unroll
                    for (int bj = 0; bj < 2; ++bj) { const f32x4 a = v[bj][0] * hr * w[bj][0], b = v[bj][1] * hr * w[bj][1];
                        u32x4 o; o.x = cvt_pk_bf16(a[0], a[1]); o.y = cvt_pk_bf16(a[2], a[3]); o.z = cvt_pk_bf16(b[0], b[1]); o.w = cvt_pk_bf16(b[2], b[3]);
                        *(u32x4*)(dst + (size_t)row * 512 + col0 + 32 * bj) = o; } }
            return;
        }
        const int col0 = half * 256 + wc * 32 + 8 * fq;
        if (g == 1) {
            f32x4 lbv[2][2];
#pragma unroll
            for (int bj = 0; bj < 2; ++bj)
#pragma unroll
                for (int n = 0; n < 2; ++n) { f32x4 t = (f32x4){0.f, 0.f, 0.f, 0.f};
                    if (layer == 1) { const f32x4 a0 = *(const f32x4*)(lba + col0 + 128 * bj + 4 * n), a1 = *(const f32x4*)(lbb + col0 + 128 * bj + 4 * n);
#pragma unroll
                        for (int j = 0; j < 4; ++j) t[j] = fsigmoid(a1[j] - a0[j]); }
                    lbv[bj][n] = t; }
#pragma unroll
            for (int ai = 0; ai < 2; ++ai)
#pragma unroll
                for (int m = 0; m < 4; ++m) { const int row = row0 + ai * HALF + m * 16; const float rs = rsqrtf(ssq[row] * (1.0f / 1024.0f) + 1e-6f);
#pragma unroll
                    for (int bj = 0; bj < 2; ++bj)
#pragma unroll
                        for (int n = 0; n < 2; ++n) { f32x4 v = acc[ai][bj][m][n] * rs;
#pragma unroll
                            for (int j = 0; j < 4; ++j) v[j] = __logf(lbv[bj][n][j] + (1.0f - lbv[bj][n][j]) * fsigmoid(v[j]));
                            *(f32x4*)(lf + (size_t)row * 512 + col0 + 128 * bj + 4 * n) = v; } }
            return;
        }
        bf16_t* dst = (g == 0) ? hq : (g == 2) ? hv : (g == 3) ? hg : V;
        const float sc = (g == 0) ? 0.08838834764831845f : 1.0f;
#pragma unroll
        for (int ai = 0; ai < 2; ++ai)
#pragma unroll
            for (int m = 0; m < 4; ++m) { const int row = row0 + ai * HALF + m * 16; const float rs = rsqrtf(ssq[row] * (1.0f / 1024.0f) + 1e-6f) * sc;
#pragma unroll
                for (int bj = 0; bj < 2; ++bj) { f32x4 a = acc[ai][bj][m][0] * rs, b = acc[ai][bj][m][1] * rs;
                    if (g == 3) {
#pragma unroll
                        for (int j = 0; j < 4; ++j) { a[j] = a[j] * fsigmoid(a[j]); b[j] = b[j] * fsigmoid(b[j]); } }
                    u32x4 o; o.x = cvt_pk_bf16(a[0], a[1]); o.y = cvt_pk_bf16(a[2], a[3]); o.z = cvt_pk_bf16(b[0], b[1]); o.w = cvt_pk_bf16(b[2], b[3]);
                    *(u32x4*)(dst + (size_t)row * 512 + col0 + 128 * bj) = o; } }
    }
};
struct EpiRes {
    static constexpr bool PERM = false, AFTER_DRAIN = false;
    const float* base32; const bf16_t* base16; float* out32; bf16_t* out16; float* ssq;
    __device__ __forceinline__ void operator()(const f32x4 (&acc)[2][2][4][2], const Unit& u, int wr, int wc, int fr, int fq) const {
        const int col0 = u.pn * BM + wc * 32 + 4 * fq;
#pragma unroll
        for (int ai = 0; ai < 2; ++ai)
#pragma unroll
            for (int m = 0; m < 4; ++m) { const int row = u.pm * BM + ai * HALF + wr * 64 + m * 16 + fr; const size_t off = (size_t)row * 1024 + col0; float ss = 0.f;
#pragma unroll
                for (int bj = 0; bj < 2; ++bj)
#pragma unroll
                    for (int n = 0; n < 2; ++n) { const size_t o_ = off + bj * HALF + n * 16; f32x4 b;
                        if (base32) b = *(const f32x4*)(base32 + o_);
                        else { const u32x2 w = *(const u32x2*)(base16 + o_); b = (f32x4){__builtin_bit_cast(float, w.x << 16), __builtin_bit_cast(float, w.x & 0xffff0000u), __builtin_bit_cast(float, w.y << 16), __builtin_bit_cast(float, w.y & 0xffff0000u)}; }
                        const f32x4 o = b + acc[ai][bj][m][n];
                        ss += (o[0] * o[0] + o[1] * o[1]) + (o[2] * o[2] + o[3] * o[3]);
                        if (out32) *(f32x4*)(out32 + o_) = o;
                        else { u32x2 w; w.x = cvt_pk_bf16(o[0], o[1]); w.y = cvt_pk_bf16(o[2], o[3]); *(u32x2*)(out16 + o_) = w; } }
                if (ssq) { ss += __shfl_xor(ss, 16); ss += __shfl_xor(ss, 32); if (fq == 0) unsafeAtomicAdd(ssq + row, ss); } }
    }
};
struct EpiUp {
    static constexpr bool PERM = true, AFTER_DRAIN = false;
    const float* ssq; bf16_t* H;
    __device__ __forceinline__ void operator()(const f32x4 (&acc)[2][2][4][2], const Unit& u, int wr, int wc, int fr, int fq) const {
        const int row0 = u.pm * BM + wr * 64 + fr, col0 = u.pn * BM + wc * 32 + 8 * fq;
#pragma unroll
        for (int ai = 0; ai < 2; ++ai)
#pragma unroll
            for (int m = 0; m < 4; ++m) { const int row = row0 + ai * HALF + m * 16; const float rs = rsqrtf(ssq[row] * (1.0f / 1024.0f) + 1e-6f);
#pragma unroll
                for (int bj = 0; bj < 2; ++bj) { f32x4 a = acc[ai][bj][m][0] * rs, b = acc[ai][bj][m][1] * rs;
#pragma unroll
                    for (int j = 0; j < 4; ++j) { a[j] = fmaxf(a[j], 0.f); a[j] *= a[j]; b[j] = fmaxf(b[j], 0.f); b[j] *= b[j]; }
                    u32x4 o; o.x = cvt_pk_bf16(a[0], a[1]); o.y = cvt_pk_bf16(a[2], a[3]); o.z = cvt_pk_bf16(b[0], b[1]); o.w = cvt_pk_bf16(b[2], b[3]);
                    *(u32x4*)(H + (size_t)row * 4096 + col0 + 128 * bj) = o; } }
    }
};
}
#include <hip/hip_bf16.h>
#include <cmath>
namespace attn_body {
using bf16=__hip_bfloat16;
using bf16x8=__attribute__((ext_vector_type(8)))short;
using s16x4=__attribute__((ext_vector_type(4)))short;
using f32x16=__attribute__((ext_vector_type(16)))float;
using u32x4=__attribute__((ext_vector_type(4)))unsigned;
using f32x4v=__attribute__((ext_vector_type(4)))float;
constexpr int BATCH=2,NHEAD=8,SEQ=8192,D=64,DM=NHEAD*D,ODM=1024;
constexpr int NW=8,QBLK=32,QB=QBLK*NW,KVBLK=64,NQB=SEQ/QB;
constexpr int ATTN_PITCH=DM, ATTN_UNIT_ROWS=QB;
__device__ __forceinline__ int crow(int r,int hi){return (r&3)+8*(r>>2)+4*hi;}
#define SBAR() __builtin_amdgcn_sched_barrier(0)
__device__ __forceinline__ void cmask(f32x16&p0,f32x16&p1,int jb,int qrel,int hi){
  const float NEG=-INFINITY; int kb=64*jb+4*hi;
  #pragma unroll
  for(int r=0;r<16;++r){int kv=kb+(r&3)+8*(r>>2); if(kv>qrel)p0[r]=NEG; if(kv+32>qrel)p1[r]=NEG;}
}

constexpr int NSLOT=3, SLOTB=8192;
constexpr int LDS_K=0, LDS_V=NSLOT*SLOTB, LDS_WS=2*NSLOT*SLOTB, LDS_OST=LDS_WS+NW*64*4, LDS_BYTES=LDS_OST+NW*4096, LDS_DK=86016, LDS_END=LDS_DK+SEQ*4;
constexpr float C2=0.125f*1.4426950408889634f;
__device__ __forceinline__ void glds16(const void*gsrc,unsigned lds_dst){unsigned keep;
  asm volatile("s_mov_b32 %0, m0\n\ts_mov_b32 m0, %2\n\ts_nop 0\n\tglobal_load_lds_dwordx4 %1, off\n\ts_mov_b32 m0, %0":"=&s"(keep):"v"(gsrc),"s"(lds_dst):"memory");}
__device__ __forceinline__ float max3f(float a,float b,float c){float r;asm("v_max3_f32 %0, %1, %2, %3":"=v"(r):"v"(a),"v"(b),"v"(c));return r;}
__device__ __forceinline__ float max2f(float a,float b){float r;asm("v_max_f32_e32 %0, %1, %2":"=v"(r):"v"(a),"v"(b));return r;}
__device__ __forceinline__ float fadd_s(float a,float b){float r;asm("v_add_f32_e32 %0, %1, %2":"=v"(r):"v"(a),"v"(b));return r;}
__device__ __forceinline__ float fsub_s(float a,float b){float r;asm("v_sub_f32_e32 %0, %1, %2":"=v"(r):"v"(a),"v"(b));return r;}
typedef float f32x2_t __attribute__((ext_vector_type(2))); typedef __bf16 bf16x2_t __attribute__((ext_vector_type(2)));
__device__ __forceinline__ unsigned cvtpk_s(float lo,float hi){f32x2_t v={lo,hi};bf16x2_t b=__builtin_convertvector(v,bf16x2_t);return __builtin_bit_cast(unsigned,b);}
#define WAIT_BAR(N) asm volatile("s_waitcnt vmcnt(" #N ") lgkmcnt(0)\n\ts_barrier":::"memory")

__device__ __forceinline__ void qkt(f32x16&p0,f32x16&p1,const char*Kslot,const bf16x8*qr,int r32,int hi){
  const char*kb=Kslot+hi*1024+r32*16;
  #pragma unroll
  for(int d0=0;d0<4;++d0){
    const bf16x8 b0=*reinterpret_cast<const bf16x8*>(kb+d0*2048);
    const bf16x8 b1=*reinterpret_cast<const bf16x8*>(kb+d0*2048+512);
    {p0=__builtin_amdgcn_mfma_f32_32x32x16_bf16(b0,qr[d0],p0,0,0,0);p1=__builtin_amdgcn_mfma_f32_32x32x16_bf16(b1,qr[d0],p1,0,0,0);}}
}
typedef __attribute__((address_space(3))) const char* lds_cptr;
typedef short v4i16_t __attribute__((ext_vector_type(4)));
__device__ __forceinline__ void kload8(bf16x8*kf,lds_cptr kp){
  kf[0]=*(const __attribute__((address_space(3))) bf16x8*)(kp);      kf[1]=*(const __attribute__((address_space(3))) bf16x8*)(kp+512);
  kf[2]=*(const __attribute__((address_space(3))) bf16x8*)(kp+2048); kf[3]=*(const __attribute__((address_space(3))) bf16x8*)(kp+2560);
  kf[4]=*(const __attribute__((address_space(3))) bf16x8*)(kp+4096); kf[5]=*(const __attribute__((address_space(3))) bf16x8*)(kp+4608);
  kf[6]=*(const __attribute__((address_space(3))) bf16x8*)(kp+6144); kf[7]=*(const __attribute__((address_space(3))) bf16x8*)(kp+6656);
}
__device__ __forceinline__ void kload2(bf16x8*kf,lds_cptr kp,int j){ kf[2*j]=*(const __attribute__((address_space(3))) bf16x8*)(kp+j*2048); kf[2*j+1]=*(const __attribute__((address_space(3))) bf16x8*)(kp+j*2048+512); }
__device__ __forceinline__ s16x4 vtr(lds_cptr p){ return __builtin_bit_cast(s16x4,__builtin_amdgcn_ds_read_tr16_b64_v4i16((__attribute__((address_space(3))) v4i16_t*)p)); }
__device__ __forceinline__ float rowmax(const f32x16&p0,const f32x16&p1){
  float a=max3f(p0[0],p0[1],p1[0]),b=max3f(p0[2],p0[3],p1[1]);a=max3f(a,p1[2],p1[3]);
  #pragma unroll
  for(int r=4;r<16;r+=4){a=max3f(a,p0[r],p0[r+1]);b=max3f(b,p0[r+2],p0[r+3]);a=max3f(a,p1[r],p1[r+1]);b=max3f(b,p1[r+2],p1[r+3]);}
  const float m=max2f(a,b);
  auto rr=__builtin_amdgcn_permlane32_swap(__float_as_uint(m),__float_as_uint(m),false,false);
  return max2f(__uint_as_float(rr[0]),__uint_as_float(rr[1]));
}
__device__ __forceinline__ void pv(f32x16*o,int vb,bf16x8 pa0,bf16x8 pa1,bf16x8 pa2,bf16x8 pa3){
  #pragma unroll
  for(int d0=0;d0<2;++d0){s16x4 lo[4],hi[4];
    #pragma unroll
    for(int ks=0;ks<4;++ks){
      asm volatile("ds_read_b64_tr_b16 %0,%1 offset:%c2":"=&v"(lo[ks]):"v"(vb),"i"(d0*4096+ks*1024):"memory");
      asm volatile("ds_read_b64_tr_b16 %0,%1 offset:%c2":"=&v"(hi[ks]):"v"(vb),"i"(d0*4096+ks*1024+512):"memory");}
    asm volatile("s_waitcnt lgkmcnt(0)":::"memory");SBAR();
    #define PK(k) (bf16x8){lo[k][0],lo[k][1],lo[k][2],lo[k][3],hi[k][0],hi[k][1],hi[k][2],hi[k][3]}
    o[d0]=__builtin_amdgcn_mfma_f32_32x32x16_bf16(pa0,PK(0),o[d0],0,0,0);
    o[d0]=__builtin_amdgcn_mfma_f32_32x32x16_bf16(pa1,PK(1),o[d0],0,0,0);
    o[d0]=__builtin_amdgcn_mfma_f32_32x32x16_bf16(pa2,PK(2),o[d0],0,0,0);
    o[d0]=__builtin_amdgcn_mfma_f32_32x32x16_bf16(pa3,PK(3),o[d0],0,0,0);
    #undef PK
  }
}

#ifndef ATTN_STORE16
#define ATTN_STORE16(p,v) (*(u32x4*)(p)=(v))
#endif
template<int THRL> __device__ __forceinline__ void attn_unit(int b,int h,int qb,int NT,const bf16*Q,const bf16*__restrict__ K,const bf16*__restrict__ V,bf16*O,char*shm){
  int tid_o=threadIdx.x; asm volatile("":"+v"(tid_o));
  const int tid=tid_o,lane=tid&63,r32=lane&31,hi=lane>>5; const int wid=__builtin_amdgcn_readfirstlane(tid>>6);
  const long rowbase=(long)b*SEQ; const int q0=qb*QB;
  const bf16*Qw=Q+(rowbase+q0+wid*QBLK)*DM+h*D;
  const bf16*Kh=K+rowbase*DM+h*D,*Vh=V+rowbase*DM+h*D;
  const unsigned lds0=(unsigned)(uintptr_t)shm;
  float*wsf=(float*)(shm+LDS_WS)+wid*64;
  const bf16*ksrc=Kh+(long)lane*DM+wid*8;
  const bf16*vsrc=Vh+(long)(16*(wid&3)+(lane>>2))*DM+(wid>>2)*32+(lane&3)*8;
  const unsigned kdst=lds0+LDS_K+wid*1024, vdst=lds0+LDS_V+wid*1024;
  #define TA(t) (((t)<4)?(NTA-4+(t)):(NTA-1-(t)))
  #define DMA_K(t,slot) glds16(ksrc+(long)TA(t)*KVBLK*DM,(unsigned)__builtin_amdgcn_readfirstlane(kdst+(slot)))
  #define DMA_V(t,slot) glds16(vsrc+(long)TA(t)*KVBLK*DM,(unsigned)__builtin_amdgcn_readfirstlane(vdst+(slot)))
  const int vb0=(int)(lds0+LDS_V)+((lane>>4)&1)*32+(lane&3)*8+(4*hi+((lane&15)>>2))*64;
  const char*Kbase=shm+LDS_K; bf16x8 kf[8];
  const lds_cptr shm3=(lds_cptr)shm; const lds_cptr kp0=shm3+LDS_K+hi*1024+r32*16; const lds_cptr vp0=shm3+LDS_V+((lane>>4)&1)*32+(lane&3)*8+(4*hi+((lane&15)>>2))*64;
  const int NTA=(q0+QB)/KVBLK;
  typedef __attribute__((address_space(3))) const f32x4v* dk_cptr; const dk_cptr dkp=(dk_cptr)(shm3+LDS_DK+hi*16);
  #define CINIT1(C0,t,o8) do{ const dk_cptr dp_=dkp+TA(t)*16+(o8); _Pragma("unroll") for(int j_=0;j_<4;++j_){ const f32x4v a_=dp_[2*j_]; \
      C0[4*j_]=a_[0]+nmh;C0[4*j_+1]=a_[1]+nmh;C0[4*j_+2]=a_[2]+nmh;C0[4*j_+3]=a_[3]+nmh; } }while(0)
  #define CINIT(C0,C1,t) do{ CINIT1(C0,t,0); SBAR(); CINIT1(C1,t,8); }while(0)
  DMA_K(0,0);DMA_V(0,0);DMA_K(1,SLOTB);
  bf16x8 qr[4];
  #pragma unroll
  for(int d0=0;d0<4;++d0)qr[d0]=*reinterpret_cast<const bf16x8*>(&Qw[(long)r32*DM+d0*16+hi*8]);
  float mhat=0.f,l_reg=0.f,nmh=0.f;f32x16 o[2];o[0]=f32x16{};o[1]=f32x16{};
  const int qrel=wid*QBLK+r32;
  #define CMASK(P0,P1,t) do{int jb_=(t); if(jb_<4)cmask(P0,P1,jb_,qrel,hi);}while(0)
  bool resc=false;
  #define START(P0,P1) do{ const float rm=rowmax(P0,P1); resc=false; \
    { const float dl=rm; mhat=fadd_s(mhat,dl); \
      _Pragma("unroll") for(int r=0;r<16;++r){P0[r]=fsub_s(P0[r],dl);P1[r]=fsub_s(P1[r],dl);} \
      nmh=-mhat; } \
    _Pragma("unroll") for(int r=0;r<16;++r)P0[r]=__builtin_amdgcn_exp2f(P0[r]); }while(0)
  #define RESC() do{ if(resc){ asm volatile("s_waitcnt lgkmcnt(0)":::"memory"); \
      _Pragma("unroll") for(int d_=0;d_<2;++d_) _Pragma("unroll") for(int r=0;r<16;++r)o[d_][r]*=wsf[crow(r,hi)]; } }while(0)
  f32x16 pA0,pA1,pB0,pB1;
  int sl_prev=0,sl_cur=0,sl_next=SLOTB;
  #define ROT() do{sl_prev=sl_cur;sl_cur=sl_next;sl_next=(sl_next==(NSLOT-1)*SLOTB)?0:sl_next+SLOTB;}while(0)
  DMA_K(2,2*SLOTB);
  WAIT_BAR(3);
  CINIT(pA0,pA1,0); qkt(pA0,pA1,Kbase,qr,r32,hi);asm volatile("s_nop 15\n\ts_nop 7":"+v"(pA0),"+v"(pA1));CMASK(pA0,pA1,0);
  START(pA0,pA1);
  _Pragma("unroll") for(int r=0;r<16;++r)pA1[r]=__builtin_amdgcn_exp2f(pA1[r]);
  WAIT_BAR(0);
  DMA_K(3,0);DMA_V(1,SLOTB);
  ROT();
  kload8(kf,kp0+sl_cur);
  WAIT_BAR(2);
  s16x4 vlo[8],vhi[8]; u32x4 pw0,pw1,pw2,pw3;
  #define PKW(P,B) cvtpk_s(P[B],P[B+1])
  #define PAF(k) __builtin_bit_cast(bf16x8,pw##k)
  #define VFR(i) (bf16x8){vlo[i][0],vlo[i][1],vlo[i][2],vlo[i][3],vhi[i][0],vhi[i][1],vhi[i][2],vhi[i][3]}
  #define PIN(x) asm volatile("":"+v"(x))
  #define MX3(a,b,c) __builtin_fmaxf(__builtin_fmaxf((a),(b)),(c))
  #define GAPA(MF,A0,A1,A2,A3,W0,W1,PW) do{ MF; sacc+=A0; sacc+=A1; sacc+=A2; sacc+=A3; PIN(sacc); W0; W1; PIN(PW); SBAR(); }while(0)
  #define EX(v) __builtin_amdgcn_exp2f(v)
  #define GAPB(MF,X,B) do{ MF; X[B]=EX(X[B]); X[B+1]=EX(X[B+1]); X[B+2]=EX(X[B+2]); X[B+3]=EX(X[B+3]); PIN(X); SBAR(); }while(0)
  #define VRD(i) do{ vlo[i]=vtr(vp_+(((i)>>2)*4096+((i)&3)*1024)); vhi[i]=vtr(vp_+(((i)>>2)*4096+((i)&3)*1024+512)); }while(0)
  #define KRD(G,j) do{ if(G){ kload2(kf,kp0+sl_next,j); SBAR(); } }while(0)
  #define STEP(C0,C1,P0,P1,t,GK,GV,GL) do{ SBAR(); CINIT(C0,C1,t); SBAR(); \
    const lds_cptr vp_=vp0+sl_prev; \
    float sacc=(P0[0]+P0[1]); \
    GAPA(C0=__builtin_amdgcn_mfma_f32_32x32x16_bf16(kf[0],qr[0],C0,0,0,0), P0[2],P0[3],P0[4],P0[5],     pw0[0]=PKW(P0,0), pw0[1]=PKW(P0,2), pw0); \
    GAPA(C1=__builtin_amdgcn_mfma_f32_32x32x16_bf16(kf[1],qr[0],C1,0,0,0), P0[6],P0[7],P0[8],P0[9],     pw0[2]=PKW(P0,4), pw0[3]=PKW(P0,6), pw0); \
    GAPA(C0=__builtin_amdgcn_mfma_f32_32x32x16_bf16(kf[2],qr[1],C0,0,0,0),   P0[10],P0[11],P0[12],P0[13], pw1[0]=PKW(P0,8), pw1[1]=PKW(P0,10), pw1); \
    GAPA(C1=__builtin_amdgcn_mfma_f32_32x32x16_bf16(kf[3],qr[1],C1,0,0,0),   P0[14],P0[15],P1[0],P1[1],   pw1[2]=PKW(P0,12),pw1[3]=PKW(P0,14), pw1); \
    GAPA(C0=__builtin_amdgcn_mfma_f32_32x32x16_bf16(kf[4],qr[2],C0,0,0,0),   P1[2],P1[3],P1[4],P1[5],     pw2[0]=PKW(P1,0), pw2[1]=PKW(P1,2), pw2); \
    GAPA(C1=__builtin_amdgcn_mfma_f32_32x32x16_bf16(kf[5],qr[2],C1,0,0,0),   P1[6],P1[7],P1[8],P1[9],     pw2[2]=PKW(P1,4), pw2[3]=PKW(P1,6), pw2); \
    GAPA(C0=__builtin_amdgcn_mfma_f32_32x32x16_bf16(kf[6],qr[3],C0,0,0,0),   P1[10],P1[11],P1[12],P1[13], pw3[0]=PKW(P1,8), pw3[1]=PKW(P1,10), pw3); \
    GAPA(C1=__builtin_amdgcn_mfma_f32_32x32x16_bf16(kf[7],qr[3],C1,0,0,0),   P1[14],P1[15],0.f,0.f,       pw3[2]=PKW(P1,12),pw3[3]=PKW(P1,14), pw3); \
    l_reg+=sacc; VRD(0); VRD(4); \
    if(GK){DMA_K((t)+3,sl_cur);} if(GV){DMA_V((t)+1,sl_next);} \
    CMASK(C0,C1,t); \
    { float a=MX3(C0[0],C0[1],C1[0]),b=MX3(C0[2],C0[3],C1[1]); a=MX3(a,C1[2],C1[3]); \
      _Pragma("unroll") for(int r=4;r<16;r+=4){a=MX3(a,C0[r],C0[r+1]);b=MX3(b,C0[r+2],C0[r+3]);a=MX3(a,C1[r],C1[r+1]);b=MX3(b,C1[r+2],C1[r+3]);} \
      float rm=__builtin_fmaxf(a,b); { auto rr=__builtin_amdgcn_permlane32_swap(__float_as_uint(rm),__float_as_uint(rm),false,false); rm=__builtin_fmaxf(__uint_as_float(rr[0]),__uint_as_float(rr[1])); } \
      resc=false; \
      if(__builtin_expect(__any(rm>(float)THRL),0)){ const float dl=__builtin_fmaxf(rm,0.f); mhat+=dl; \
        _Pragma("unroll") for(int r=0;r<16;++r){C0[r]-=dl;C1[r]-=dl;} \
        nmh=-mhat; \
        const float f=__builtin_amdgcn_exp2f(-dl); l_reg*=f; if(hi==0)wsf[r32]=f; resc=true; } } \
    SBAR(); \
    VRD(1); GAPB(o[0]=__builtin_amdgcn_mfma_f32_32x32x16_bf16(PAF(0),VFR(0),o[0],0,0,0), C0,0); \
    VRD(5); GAPB(o[1]=__builtin_amdgcn_mfma_f32_32x32x16_bf16(PAF(0),VFR(4),o[1],0,0,0), C0,4); \
    KRD(GL,0); VRD(2); GAPB(o[0]=__builtin_amdgcn_mfma_f32_32x32x16_bf16(PAF(1),VFR(1),o[0],0,0,0), C0,8); \
    KRD(GL,1); VRD(6); GAPB(o[1]=__builtin_amdgcn_mfma_f32_32x32x16_bf16(PAF(1),VFR(5),o[1],0,0,0), C0,12); \
    KRD(GL,2); VRD(3); GAPB(o[0]=__builtin_amdgcn_mfma_f32_32x32x16_bf16(PAF(2),VFR(2),o[0],0,0,0), C1,0); \
    KRD(GL,3); VRD(7); GAPB(o[1]=__builtin_amdgcn_mfma_f32_32x32x16_bf16(PAF(2),VFR(6),o[1],0,0,0), C1,4); \
    GAPB(o[0]=__builtin_amdgcn_mfma_f32_32x32x16_bf16(PAF(3),VFR(3),o[0],0,0,0), C1,8); \
    GAPB(o[1]=__builtin_amdgcn_mfma_f32_32x32x16_bf16(PAF(3),VFR(7),o[1],0,0,0), C1,12); \
    }while(0)
  int t=1;
  #define ENDW(tt) do{ if((tt)+3<NT){WAIT_BAR(2);} else if((tt)+2<NT){WAIT_BAR(1);} else {WAIT_BAR(0);} }while(0)
  for(;t+1<NT;t+=2){
    STEP(pB0,pB1,pA0,pA1,t,(t+3<NT),(t+1<NT),(t+1<NT));       ENDW(t);   RESC(); ROT();
    STEP(pA0,pA1,pB0,pB1,t+1,(t+4<NT),(t+2<NT),(t+2<NT));     ENDW(t+1); RESC(); ROT();
  }
  STEP(pB0,pB1,pA0,pA1,NT-1,false,false,false); RESC();
  { float sacc=pB0[0]+pB0[1]; _Pragma("unroll") for(int r=2;r<16;++r)sacc+=pB0[r]; _Pragma("unroll") for(int r=0;r<16;++r)sacc+=pB1[r]; l_reg+=sacc;
    pw0=(u32x4){PKW(pB0,0),PKW(pB0,2),PKW(pB0,4),PKW(pB0,6)};pw1=(u32x4){PKW(pB0,8),PKW(pB0,10),PKW(pB0,12),PKW(pB0,14)};pw2=(u32x4){PKW(pB1,0),PKW(pB1,2),PKW(pB1,4),PKW(pB1,6)};pw3=(u32x4){PKW(pB1,8),PKW(pB1,10),PKW(pB1,12),PKW(pB1,14)};
    SBAR(); pv(o,vb0+sl_cur,PAF(0),PAF(1),PAF(2),PAF(3)); }
  #undef PKW
  #undef PAF
  #undef VFR
  #undef PIN
  #undef MX3
  #undef GAPA
  #undef GAPB
  #undef EX
  #undef VRD
  #undef KRD
  #undef STEP
  #undef ENDW
  {auto rr=__builtin_amdgcn_permlane32_swap(__float_as_uint(l_reg),__float_as_uint(l_reg),false,false);l_reg=__uint_as_float(rr[0])+__uint_as_float(rr[1]);}
  if(hi==0)wsf[32+r32]=l_reg;asm volatile("s_waitcnt lgkmcnt(0)":::"memory");
  float rli[16];
  #pragma unroll
  for(int r=0;r<16;++r)rli[r]=__builtin_amdgcn_rcpf(wsf[32+crow(r,hi)]);
  bf16*Ow=O+(rowbase+q0+wid*QBLK)*ODM+h*D;
  { bf16*stg=(bf16*)(shm+LDS_OST)+wid*2048;
    #pragma unroll
    for(int r=0;r<16;++r){const int orow=crow(r,hi);
      #pragma unroll
      for(int d0=0;d0<2;++d0)stg[orow*64+d0*32+r32]=__float2bfloat16(o[d0][r]*rli[r]);}
    asm volatile("s_waitcnt lgkmcnt(0)":::"memory");
    #pragma unroll
    for(int i=0;i<4;++i){const int row=i*8+(lane>>3),ch=lane&7; const u32x4 v=*(const u32x4*)(stg+row*64+ch*8); ATTN_STORE16(Ow+(long)row*ODM+ch*8,v);} }
  asm volatile("s_waitcnt lgkmcnt(0)\n\ts_barrier":::"memory");
  #undef DMA_K
  #undef TA
  #undef CINIT
  #undef CINIT1
  #undef DMA_V
  #undef CMASK
  #undef START
  #undef RESC
  #undef ROT
}
constexpr int ATTN_LDS_BYTES=LDS_END;
#undef SBAR
#undef WAIT_BAR
}
constexpr int NWAVES = 8, NTHREADS = 512;
constexpr int BATCH = 2, T = 8192, D = 1024, FF = 4096, M = BATCH * T, DEPTH = 2;
constexpr int IN_COLS = 3592, NIN = 3840;
constexpr size_t MiB = 1u << 20;
constexpr size_t WS_CTL = 0, CTL_ZERO_BYTES = 1 * MiB;
constexpr size_t WS_SSQ = 64 * 1024;
constexpr size_t WS_LSIG = 512 * 1024;
constexpr size_t WS_WIN = 1 * MiB, WIN_BYTES = (size_t)NIN * D * 2;
constexpr size_t WS_WOUT = 16 * MiB, WS_WUP = 20 * MiB, WS_WDN = 36 * MiB;
constexpr size_t WS_XB = 52 * MiB;
constexpr size_t WS_ST = 84 * MiB;
constexpr size_t WS_HQ = 116 * MiB, WS_LF = 132 * MiB, WS_HV = 164 * MiB, WS_HG = 180 * MiB, WS_Q = 196 * MiB, WS_K = 212 * MiB, WS_V = 228 * MiB, WS_END = 244 * MiB;
constexpr size_t WS_H = 116 * MiB;
constexpr size_t WS_DL = 244 * MiB;
constexpr int LDS_BYTES = 147456;

#define GAS __attribute__((address_space(1)))
#define LAS __attribute__((address_space(3)))
typedef unsigned short bf16;
typedef unsigned v4u __attribute__((ext_vector_type(4)));
typedef float f32x4 __attribute__((ext_vector_type(4)));
typedef float f32x16 __attribute__((ext_vector_type(16)));
typedef short bf16x8 __attribute__((ext_vector_type(8)));
#define LDS_WAIT() asm volatile("s_waitcnt lgkmcnt(0)" ::: "memory")
__device__ __forceinline__ unsigned f2bf(float f) { unsigned u = __builtin_bit_cast(unsigned, f); return (u + 0x7fffu + ((u >> 16) & 1u)) >> 16; }
__device__ __forceinline__ unsigned pk2(float lo, float hi) { return f2bf(lo) | (f2bf(hi) << 16); }
__device__ __forceinline__ float bf2f(unsigned short b) { return __builtin_bit_cast(float, (unsigned)b << 16); }
__device__ __forceinline__ int crow16(int r, int hi) { return (r & 3) + 8 * (r >> 2) + 4 * hi; }

struct Frame {
    LAS unsigned char* lds; int tid, lane, wave, vcu, G;
};
__device__ __forceinline__ float wave_sum(float v) {
#pragma unroll
    for (int o = 1; o < 64; o <<= 1) v += __shfl_xor(v, o);
    return v;
}
__device__ __forceinline__ void p0_transpose_item(const float* W, int pitch, int K, const float* sc, bf16* WT, int dst_row0, int k0, int n0, LAS float* scr, int lane) {
#pragma unroll 8
    for (int i = 0; i < 32; ++i) { const int kk = 2 * i + (lane >> 5); float v = W[(size_t)(k0 + kk) * pitch + n0 + (lane & 31)]; if (sc) v *= sc[k0 + kk]; scr[kk * 33 + (lane & 31)] = v; }
    LDS_WAIT(); asm volatile("" ::: "memory");
    const int c = lane & 7;
#pragma unroll
    for (int j = 0; j < 4; ++j) { const int n = (lane >> 3) + 8 * j; const LAS float* s = scr + (8 * c) * 33 + n;
        v4u o; o.x = pk2(s[0 * 33], s[1 * 33]); o.y = pk2(s[2 * 33], s[3 * 33]); o.z = pk2(s[4 * 33], s[5 * 33]); o.w = pk2(s[6 * 33], s[7 * 33]);
        *(GAS v4u*)(WT + (size_t)(dst_row0 + n) * K + k0 + 8 * c) = o; }
    LDS_WAIT(); asm volatile("" ::: "memory");
}
__device__ __forceinline__ int map_in_row(int n) {
    if (n < 2048 || n >= 3072) return n;
    const int local = n - 2048, tile = local >> 8, o = local & 255, wc = o >> 6, w = o & 63, bj = w >> 5, x = w & 31;
    return 2048 + tile * 256 + bj * 128 + wc * 32 + x;
}
struct Ptrs {
    const float *x, *lower_bounds, *norm1_w, *w_in, *fox_f_bias, *q_norm_w, *k_norm_w, *hgrn_norm_w, *w_out, *norm2_w, *w_up, *w_down;
    float* out; unsigned char* ws;
};
__device__ __forceinline__ void p0_prologue(Frame& F, const Ptrs& P) {
    LAS float* scr = (LAS float*)(F.lds + F.wave * 16384);
    const int gw = F.vcu * NWAVES + F.wave, NGW = F.G * NWAVES;
    constexpr int I_IN = 16 * 112, I_OUT = 16 * 32, I_UP = 16 * 128, I_DN = 64 * 32, I_L = I_IN + I_OUT + I_UP + I_DN;
    for (int it = gw; it < DEPTH * I_L; it += NGW) {
        const int l = it / I_L; int r = it % I_L;
        if (r < I_IN) { const int kb = r / 112, nb = r % 112; p0_transpose_item(P.w_in + (size_t)l * D * IN_COLS, IN_COLS, D, P.norm1_w + l * D, (bf16*)(P.ws + WS_WIN + l * WIN_BYTES), map_in_row(32 * nb), 64 * kb, 32 * nb, scr, F.lane); continue; } r -= I_IN;
        if (r < I_OUT) { const int kb = r / 32, nb = r % 32; p0_transpose_item(P.w_out + (size_t)l * D * D, D, D, nullptr, (bf16*)(P.ws + WS_WOUT + l * 2 * MiB), 32 * nb, 64 * kb, 32 * nb, scr, F.lane); continue; } r -= I_OUT;
        if (r < I_UP) { const int kb = r / 128, nb = r % 128; p0_transpose_item(P.w_up + (size_t)l * D * FF, FF, D, P.norm2_w + l * D, (bf16*)(P.ws + WS_WUP + l * 8 * MiB), 32 * nb, 64 * kb, 32 * nb, scr, F.lane); continue; } r -= I_UP;
        { const int kb = r / 32, nb = r % 32; p0_transpose_item(P.w_down + (size_t)l * FF * D, D, FF, nullptr, (bf16*)(P.ws + WS_WDN + l * 8 * MiB), 32 * nb, 64 * kb, 32 * nb, scr, F.lane); }
    }
    { const int gt = F.vcu * NTHREADS + F.tid;
      for (int e = gt; e < DEPTH * 256 * 128; e += F.G * NTHREADS) { const int l = e >> 15, j = (e >> 7) & 255, kc = e & 127; float v[8];
#pragma unroll
          for (int i = 0; i < 8; ++i) v[i] = (j < 8) ? P.w_in[(size_t)l * D * IN_COLS + (size_t)(8 * kc + i) * IN_COLS + 3584 + j] * P.norm1_w[l * D + 8 * kc + i] : 0.f;
          v4u o; o.x = pk2(v[0], v[1]); o.y = pk2(v[2], v[3]); o.z = pk2(v[4], v[5]); o.w = pk2(v[6], v[7]);
          *(GAS v4u*)((bf16*)(P.ws + WS_WIN + l * WIN_BYTES) + (size_t)(3584 + j) * D + 8 * kc) = o; } }
    bf16* XB = (bf16*)(P.ws + WS_XB); float* ssq = (float*)(P.ws + WS_SSQ);
    for (int m = gw; m < M; m += NGW) { const GAS f32x4* xr = (const GAS f32x4*)(P.x + (size_t)m * D) + F.lane; f32x4 v[4]; float s = 0.f;
#pragma unroll
        for (int j = 0; j < 4; ++j) { v[j] = xr[64 * j]; s += (v[j].x * v[j].x + v[j].y * v[j].y) + (v[j].z * v[j].z + v[j].w * v[j].w); }
        s = wave_sum(s); if (F.lane == 0) ssq[m] = s;
        GAS unsigned long long* o8 = (GAS unsigned long long*)(XB + (size_t)m * D) + F.lane;
#pragma unroll
        for (int j = 0; j < 4; ++j) o8[64 * j] = (unsigned long long)pk2(v[j].x, v[j].y) | ((unsigned long long)pk2(v[j].z, v[j].w) << 32); }
}

constexpr int HC = 64, NCH = T / HC;
constexpr int H_KD = 0, H_QE = 0, H_QM = 17408, H_KM = 34816, H_VT = 52224, H_AM = 70656, H_OS = 79872, H_TOT = 113664, H_BM = 115712;
__device__ __forceinline__ f32x16 mfma32(bf16x8 a, bf16x8 b, f32x16 c) { return __builtin_amdgcn_mfma_f32_32x32x16_bf16(a, b, c, 0, 0, 0); }
#define HGRN_SCAN(lfv, bv, blast)  \
    float lfv[16], bv[16]; float blast; { const float* lfp = lf + (size_t)(m0 + part * 16) * 512 + h * 128 + k; \
      _Pragma("unroll") for (int i = 0; i < 16; ++i) lfv[i] = lfp[(size_t)i * 512]; \
      float run = 0.f; _Pragma("unroll") for (int i = 0; i < 16; ++i) { run += lfv[i]; bv[i] = run; } \
      LAS float* TOT = (LAS float*)(F.lds + H_TOT); TOT[part * 128 + k] = run; __syncthreads(); \
      const float t0 = TOT[k], t1 = TOT[128 + k], t2 = TOT[256 + k], t3 = TOT[384 + k]; \
      const float off = (part > 0 ? t0 : 0.f) + (part > 1 ? t1 : 0.f) + (part > 2 ? t2 : 0.f); blast = (t0 + t1) + (t2 + t3); \
      _Pragma("unroll") for (int i = 0; i < 16; ++i) bv[i] += off; }
#define HGRN_VT() { const bf16* vp = hv + (size_t)(m0 + part * 16) * 512 + h * 128 + k; unsigned w_[8]; \
      _Pragma("unroll") for (int i = 0; i < 8; ++i) w_[i] = (unsigned)vp[(size_t)(2 * i) * 512] | ((unsigned)vp[(size_t)(2 * i + 1) * 512] << 16); \
      LAS v4u* d_ = (LAS v4u*)(F.lds + H_VT + k * 144 + part * 32); d_[0] = (v4u){w_[0], w_[1], w_[2], w_[3]}; d_[1] = (v4u){w_[4], w_[5], w_[6], w_[7]}; }
__device__ __forceinline__ void hgrn_pass_a(Frame& F, const float* lf, const bf16* hv, bf16* ST, float* DL) {
    const int k = F.tid & 127, part = F.tid >> 7, l31 = F.lane & 31, hi = F.lane >> 5;
    for (int it = F.vcu; it < 8 * NCH; it += F.G) {
        const int bh = it >> 7, c = it & 127, b = bh >> 2, h = bh & 3; const int m0 = b * T + c * HC;
        HGRN_SCAN(lfv, bv, blast)
        { unsigned w_[8];
#pragma unroll
          for (int i = 0; i < 8; ++i) { const float a0 = (1.0f - __expf(lfv[2 * i])) * __expf(blast - bv[2 * i]), a1 = (1.0f - __expf(lfv[2 * i + 1])) * __expf(blast - bv[2 * i + 1]); w_[i] = pk2(a0, a1); }
          LAS v4u* d_ = (LAS v4u*)(F.lds + H_KD + k * 144 + part * 32); d_[0] = (v4u){w_[0], w_[1], w_[2], w_[3]}; d_[1] = (v4u){w_[4], w_[5], w_[6], w_[7]}; }
        if (part == 0) DL[(size_t)it * 128 + k] = __expf(blast);
        HGRN_VT()
        __syncthreads();
        const int mt = F.wave >> 1, nt0 = (F.wave & 1) * 2; f32x16 a0 = {}, a1 = {};
#pragma unroll
        for (int ks = 0; ks < 4; ++ks) { const bf16x8 av = *(const LAS bf16x8*)(F.lds + H_VT + (32 * mt + l31) * 144 + (16 * ks + 8 * hi) * 2);
            const bf16x8 b0 = *(const LAS bf16x8*)(F.lds + H_KD + (32 * nt0 + l31) * 144 + (16 * ks + 8 * hi) * 2), b1 = *(const LAS bf16x8*)(F.lds + H_KD + (32 * nt0 + 32 + l31) * 144 + (16 * ks + 8 * hi) * 2);
            a0 = mfma32(av, b0, a0); a1 = mfma32(av, b1, a1); }
        bf16* U = ST + (size_t)it * 16384;
#pragma unroll
        for (int r = 0; r < 16; ++r) { const int v = 32 * mt + crow16(r, hi); U[v * 128 + 32 * nt0 + l31] = (bf16)f2bf(a0[r]); U[v * 128 + 32 * nt0 + 32 + l31] = (bf16)f2bf(a1[r]); }
        __syncthreads();
    }
}
__device__ __forceinline__ void hgrn_pass_b(Frame& F, bf16* ST, const float* DL) {
    for (int e = F.vcu * NTHREADS + F.tid; e < 8 * 16384; e += F.G * NTHREADS) {
        const int bh = e >> 14, rem = e & 16383, k = rem & 127;
        bf16* up = ST + (size_t)bh * NCH * 16384 + rem; const float* dp = DL + (size_t)bh * NCH * 128 + k;
        float s = 0.f;
#pragma unroll 1
        for (int c0 = 0; c0 < NCH; c0 += 32) { unsigned short u[32]; float d[32];
#pragma unroll
            for (int j = 0; j < 32; ++j) { u[j] = up[(size_t)(c0 + j) * 16384]; d[j] = dp[(c0 + j) * 128]; }
#pragma unroll
            for (int j = 0; j < 32; ++j) { up[(size_t)(c0 + j) * 16384] = (bf16)f2bf(s); s = d[j] * s + bf2f(u[j]); } }
    }
}
__device__ __forceinline__ void hgrn_pass_c(Frame& F, const bf16* hq, const float* lf, const bf16* hv, const bf16* hg, const bf16* ST, const float* nw, bf16* mix) {
    const int k = F.tid & 127, part = F.tid >> 7, l31 = F.lane & 31, hi = F.lane >> 5;
    for (int it = F.vcu; it < 8 * NCH; it += F.G) {
        const int bh = it >> 7, c = it & 127, b = bh >> 2, h = bh & 3; const int m0 = b * T + c * HC;
        HGRN_SCAN(lfv, bv, blast)
        (void)blast;
        LAS float* BMID = (LAS float*)(F.lds + H_BM);
        if (part == 1) BMID[k] = bv[15];
        __syncthreads();
        const float bm = BMID[k];
        { const bf16* qp = hq + (size_t)(m0 + part * 16) * 512 + h * 128 + k;
#pragma unroll
          for (int i = 0; i < 16; ++i) { const int t = part * 16 + i; const float q = bf2f(qp[(size_t)i * 512]);
              *(LAS bf16*)(F.lds + H_QE + t * 272 + k * 2) = (bf16)f2bf(q * __expf(bv[i]));
              *(LAS bf16*)(F.lds + H_QM + t * 272 + k * 2) = (bf16)f2bf(q * __expf(fminf(bv[i] - bm, 80.f)));
              *(LAS bf16*)(F.lds + H_KM + t * 272 + k * 2) = (bf16)f2bf((1.0f - __expf(lfv[i])) * __expf(fminf(bm - bv[i], 80.f))); } }
        HGRN_VT()
        __syncthreads();
        const int mt = F.wave >> 2, nt = F.wave & 3; f32x16 acc = {};
        { const bf16* sp = ST + (size_t)it * 16384 + (size_t)(32 * nt + l31) * 128 + 8 * hi;
#pragma unroll
          for (int ks = 0; ks < 8; ++ks) { const bf16x8 av = *(const LAS bf16x8*)(F.lds + H_QE + (32 * mt + l31) * 272 + (16 * ks + 8 * hi) * 2); const bf16x8 bvv = *(const bf16x8*)(sp + 16 * ks); acc = mfma32(av, bvv, acc); } }
        if (F.wave < 4) { const int mt2 = F.wave >> 1, nt2 = F.wave & 1; f32x16 am = {};
#pragma unroll
            for (int ks = 0; ks < 8; ++ks) { const bf16x8 av = *(const LAS bf16x8*)(F.lds + H_QM + (32 * mt2 + l31) * 272 + (16 * ks + 8 * hi) * 2), bvv = *(const LAS bf16x8*)(F.lds + H_KM + (32 * nt2 + l31) * 272 + (16 * ks + 8 * hi) * 2); am = mfma32(av, bvv, am); }
#pragma unroll
            for (int r = 0; r < 16; ++r) { const int t = 32 * mt2 + crow16(r, hi), s = 32 * nt2 + l31; *(LAS bf16*)(F.lds + H_AM + t * 144 + s * 2) = (bf16)f2bf(s <= t ? am[r] : 0.f); } }
        __syncthreads();
#pragma unroll
        for (int ks = 0; ks < 4; ++ks) { const bf16x8 av = *(const LAS bf16x8*)(F.lds + H_AM + (32 * mt + l31) * 144 + (16 * ks + 8 * hi) * 2), bvv = *(const LAS bf16x8*)(F.lds + H_VT + (32 * nt + l31) * 144 + (16 * ks + 8 * hi) * 2); acc = mfma32(av, bvv, acc); }
#pragma unroll
        for (int r = 0; r < 16; ++r) *(LAS float*)(F.lds + H_OS + (32 * mt + crow16(r, hi)) * 528 + (32 * nt + l31) * 4) = acc[r];
        __syncthreads();
        { const int t = F.tid >> 3, seg = F.tid & 7; f32x4 o[4]; float ss = 0.f;
#pragma unroll
          for (int j = 0; j < 4; ++j) { o[j] = *(const LAS f32x4*)(F.lds + H_OS + t * 528 + (seg * 16 + 4 * j) * 4); ss += (o[j][0] * o[j][0] + o[j][1] * o[j][1]) + (o[j][2] * o[j][2] + o[j][3] * o[j][3]); }
          ss += __shfl_xor(ss, 1); ss += __shfl_xor(ss, 2); ss += __shfl_xor(ss, 4);
          const float rs = rsqrtf(ss * (1.0f / 128.0f) + 1e-6f);
          const v4u g0 = *(const v4u*)(hg + (size_t)(m0 + t) * 512 + h * 128 + seg * 16), g1 = *(const v4u*)(hg + (size_t)(m0 + t) * 512 + h * 128 + seg * 16 + 8);
          const unsigned gw_[8] = {g0.x, g0.y, g0.z, g0.w, g1.x, g1.y, g1.z, g1.w}; unsigned w_[8];
#pragma unroll
          for (int j = 0; j < 4; ++j) { const f32x4 wv = *(const f32x4*)(nw + seg * 16 + 4 * j);
              const float e0 = o[j][0] * rs * wv[0] * bf2f((unsigned short)(gw_[2 * j] & 0xffffu)), e1 = o[j][1] * rs * wv[1] * bf2f((unsigned short)(gw_[2 * j] >> 16));
              const float e2 = o[j][2] * rs * wv[2] * bf2f((unsigned short)(gw_[2 * j + 1] & 0xffffu)), e3 = o[j][3] * rs * wv[3] * bf2f((unsigned short)(gw_[2 * j + 1] >> 16));
              w_[2 * j] = pk2(e0, e1); w_[2 * j + 1] = pk2(e2, e3); }
          v4u* op = (v4u*)(mix + (size_t)(m0 + t) * 1024 + h * 128 + seg * 16); op[0] = (v4u){w_[0], w_[1], w_[2], w_[3]}; op[1] = (v4u){w_[4], w_[5], w_[6], w_[7]}; }
        __syncthreads();
    }
}
#ifndef REP_MASK
#define REP_MASK 0
#endif
#define RLX_AGENT __ATOMIC_RELAXED, __HIP_MEMORY_SCOPE_AGENT
#define XB_TMO      128
#define XB_XCNT(j)  (256  + 64 * (j))
#define XB_XSUB(j)  (1280 + 64 * (j))
#define XB_XGEN(j)  (2304 + 64 * (j))
#define XB_TOP      3328
#define XB_TOPGEN   3392
#define XCD_BAR_WORDS 3456
#define XB_SPIN_CAP (1u << 18)

__device__ __forceinline__ unsigned xb_ld(unsigned* p)              { return __hip_atomic_load(p, __ATOMIC_RELAXED, __HIP_MEMORY_SCOPE_AGENT); }
__device__ __forceinline__ unsigned xb_add(unsigned* p, unsigned v) { return __hip_atomic_fetch_add(p, v, __ATOMIC_RELAXED, __HIP_MEMORY_SCOPE_AGENT); }
__device__ __forceinline__ unsigned xb_xcc_id() { return (unsigned)__builtin_amdgcn_s_getreg((3 << 11) | 20) & 0xFu; }
#define XB_SPIN(cond, bar) do { unsigned _sp = 0; while (cond) { __builtin_amdgcn_s_sleep(1); \
    if ((++_sp & 255u) == 0u) { if (xb_ld(&(bar)[XB_TMO])) break; if (_sp > XB_SPIN_CAP) { atomicAdd(&(bar)[XB_TMO], 1u); break; } } } } while (0)

struct XcdBarrier {
    unsigned* bar; unsigned x;
    volatile LAS unsigned* st;
};

__device__ __forceinline__ XcdBarrier xcd_barrier_post(unsigned* bar, volatile LAS unsigned* st) {
    XcdBarrier b; b.bar = bar; b.x = xb_xcc_id(); b.st = st;
    if (threadIdx.x == 0) (void)xb_add(&bar[XB_XCNT(b.x)], 1u);
    return b;
}
__device__ __forceinline__ void xcd_barrier_complete(unsigned* bar, unsigned x, unsigned& nloc, unsigned& nx) {
    const unsigned G = gridDim.x * gridDim.y * gridDim.z;
    unsigned sum, cnt, mine, sp = 0u;
    for (;;) {
        sum = 0u; cnt = 0u; mine = 0u;
#pragma unroll
        for (unsigned j = 0; j < 16; ++j) { const unsigned c = xb_ld(&bar[XB_XCNT(j)]); sum += c; cnt += (c > 0u) ? 1u : 0u; mine = (j == x) ? c : mine; }
        if (sum == G) break;
        __builtin_amdgcn_s_sleep(1);
        if ((++sp & 255u) == 0u) { if (xb_ld(&bar[XB_TMO])) break; if (sp > XB_SPIN_CAP) { atomicAdd(&bar[XB_TMO], 1u); break; } }
    }
    nloc = mine > 0u ? mine : 1u; nx = cnt > 0u ? cnt : 1u;
}

__device__ __forceinline__ void xcd_barrier(const XcdBarrier& b) {
    asm volatile("s_waitcnt vmcnt(0)" ::: "memory");
    __syncthreads();
    if (threadIdx.x == 0) {
        unsigned* bar = b.bar;
        __builtin_amdgcn_s_waitcnt(0);
        unsigned nloc = b.st[0], nx = b.st[1];
        if (nloc == 0u) { xcd_barrier_complete(bar, b.x, nloc, nx); b.st[0] = nloc; b.st[1] = nx; }
        const unsigned old = xb_add(&bar[XB_XSUB(b.x)], 1u);
        const unsigned gen = old / nloc;
        if (old + 1u == (gen + 1u) * nloc) {
            __builtin_amdgcn_fence(__ATOMIC_RELEASE, "agent");
            asm volatile("s_waitcnt vmcnt(0)" ::: "memory");
            const unsigned og = xb_add(&bar[XB_TOP], 1u);
            const unsigned tg = og / nx;
            if (og + 1u == (tg + 1u) * nx) xb_add(&bar[XB_TOPGEN], 1u);
            else XB_SPIN(xb_ld(&bar[XB_TOPGEN]) == tg, bar);
            __builtin_amdgcn_fence(__ATOMIC_ACQUIRE, "agent");
            xb_add(&bar[XB_XGEN(b.x)], 1u);
            asm volatile("s_waitcnt vmcnt(0)" ::: "memory");
        } else {
            XB_SPIN(xb_ld(&bar[XB_XGEN(b.x)]) == gen, bar);
            __builtin_amdgcn_fence(__ATOMIC_ACQUIRE, "agent");
            asm volatile("s_waitcnt vmcnt(0)" ::: "memory");
        }
    }
    __syncthreads();
}

#ifndef FOX_SKIP
#define FOX_SKIP 1
#endif
__device__ __forceinline__ void fox_phase(Frame& F, unsigned char* lds_generic, const float* lsig, const bf16* Q, const bf16* Kb, const bf16* V, bf16* mix) {
    using attn_body::LDS_DK; using attn_body::LDS_WS; using attn_body::attn_unit;
    LAS float* dk = (LAS float*)(F.lds + LDS_DK);
    LAS double* wtot = (LAS double*)(F.lds + LDS_WS);
    for (int pr = F.vcu; pr < 256; pr += F.G) {
        const int bh = pr >> 4, s = pr & 15, b = bh >> 3, h = bh & 7;
        { int tid_ = F.tid; asm volatile("" : "+v"(tid_)); const int lane_ = tid_ & 63;
          const float* lp = lsig + ((size_t)b * T + tid_ * 16) * 8 + h; double v[16]; double run = 0.0;
#pragma unroll
          for (int i = 0; i < 16; ++i) { run -= (double)lp[i * 8]; v[i] = run; }
          double inc = run;
#pragma unroll
          for (int o = 1; o < 64; o <<= 1) { const double t = __shfl_up(inc, o); if (lane_ >= o) inc += t; }
          if (lane_ == 63) wtot[F.wave] = inc;
          __syncthreads();
          double off = inc - run;
          for (int w = 0; w < F.wave; ++w) off += wtot[w];
#pragma unroll
          for (int i = 0; i < 16; ++i) dk[tid_ * 16 + i] = (float)((v[i] + off) * 1.4426950408889634);
          __syncthreads(); }
#pragma unroll 1
        for (int i = 0; i < 2; ++i) {
            const int qb = (i == 0) ? 31 - s : s; const int NTA = 4 * qb + 4; int NT = NTA;
#if FOX_SKIP
            { const float ref = dk[qb * 256]; int lo = 0, hi_ = NTA - 4;
              while (lo < hi_) { const int mid = (lo + hi_) >> 1; if (dk[64 * mid + 63] - ref < -200.0f) lo = mid + 1; else hi_ = mid; }
              int nold = (NTA - 4) - lo; nold += (nold & 1); NT = 4 + nold; }
#endif
            attn_unit<8>(b, h, qb, NT, (const attn_body::bf16*)Q, (const attn_body::bf16*)Kb, (const attn_body::bf16*)V, (attn_body::bf16*)(mix + 512), (char*)lds_generic);
        }
        __syncthreads();
    }
}

struct Args { Ptrs p; int ph_lo, ph_hi; };
constexpr int N_PHASES = 1 + 7 * DEPTH;
__global__ void __launch_bounds__(NTHREADS, 2) hymba_fwd(Args args) {
    extern __shared__ __attribute__((aligned(16))) unsigned char lds[];
    Frame F; F.lds = (LAS unsigned char*)lds; F.tid = threadIdx.x; F.lane = F.tid & 63; F.wave = __builtin_amdgcn_readfirstlane(F.tid >> 6);
    F.G = gridDim.x; { const int bx = blockIdx.x; F.vcu = (F.G % 8 == 0) ? (bx % 8) * (F.G / 8) + bx / 8 : bx; }
    const Ptrs& P = args.p;
    const int lo = args.ph_lo, hi = args.ph_hi;
    volatile LAS unsigned* bst = (volatile LAS unsigned*)(F.lds + 131072 + 64);
    if (F.tid < 2) bst[F.tid] = 0u;
    __syncthreads();
    XcdBarrier bar; bar.bar = (unsigned*)(P.ws + WS_CTL + 16384); bar.x = 0; bar.st = bst;
    if (hi - lo > 1) bar = xcd_barrier_post((unsigned*)(P.ws + WS_CTL + 16384), bst);
#define PHASE_ENV() int t__ = threadIdx.x; asm volatile("" : "+v"(t__)); F.tid = t__; F.lane = t__ & 63; unsigned char* ws = P.ws; asm volatile("" : "+s"(ws)); \
    float* ssq = (float*)(ws + WS_SSQ); float* lsig = (float*)(ws + WS_LSIG); \
    bf16* XB = (bf16*)(ws + WS_XB); bf16* ST = (bf16*)(ws + WS_ST); float* DL = (float*)(ws + WS_DL); \
    bf16* HQ = (bf16*)(ws + WS_HQ); float* LF = (float*)(ws + WS_LF); bf16* HV = (bf16*)(ws + WS_HV); bf16* HG = (bf16*)(ws + WS_HG); \
    bf16* Qb = (bf16*)(ws + WS_Q); bf16* Kb = (bf16*)(ws + WS_K); bf16* Vb = (bf16*)(ws + WS_V); bf16* HB = (bf16*)(ws + WS_H); \
    (void)ssq; (void)lsig; (void)XB; (void)ST; (void)DL; (void)HQ; (void)LF; (void)HV; (void)HG; (void)Qb; (void)Kb; (void)Vb; (void)HB;
#define IN(k) (lo <= (k) && (k) < hi)
#define SEAM(k) do { if (IN(k) && IN((k) + 1)) { if (lo == -12345) cg::this_grid().sync(); else { xcd_barrier(bar); if (REP_MASK & 64) { xcd_barrier(bar); xcd_barrier(bar); } } } } while (0)
    if (IN(0)) { PHASE_ENV() p0_prologue(F, P); if (REP_MASK & 1) { __syncthreads(); p0_prologue(F, P); } }
    SEAM(0);
#pragma unroll 1
    for (int l = 0; l < DEPTH; ++l) {
        const int pb = 1 + 7 * l;
        if (IN(pb)) { PHASE_ENV()
            pg8::Gemm g{l == 0 ? XB : (const bf16*)P.out, (const bf16*)(ws + WS_WIN + l * WIN_BYTES), M, NIN, D}; pg8::StaticOrder S; S.init(M, NIN, F.G, (int)blockIdx.x);
            pg8::EpiIn E{ssq + (size_t)(2 * l) * M, HQ, HV, HG, Qb, Kb, Vb, LF, lsig, P.lower_bounds, P.lower_bounds + 512, l, P.q_norm_w + l * 64, P.k_norm_w + l * 64, P.fox_f_bias + l * 8};
            pg8::gemm_phase<pg8::EpiIn, pg8::StaticOrder, true, true>(F.lds, g, S, E);
            if (REP_MASK & 2) pg8::gemm_phase<pg8::EpiIn, pg8::StaticOrder, true, true>(F.lds, g, S, E);
        }
        SEAM(pb);
        if (IN(pb + 1)) { PHASE_ENV()
            fox_phase(F, lds, lsig, Qb, Kb, Vb, XB);
            if (REP_MASK & 4) fox_phase(F, lds, lsig, Qb, Kb, Vb, XB);
            hgrn_pass_a(F, LF, HV, ST, DL);
            if (REP_MASK & 8) hgrn_pass_a(F, LF, HV, ST, DL);
        }
        SEAM(pb + 1);
        if (IN(pb + 2)) { PHASE_ENV() hgrn_pass_b(F, ST, DL); }
        SEAM(pb + 2);
        if (IN(pb + 3)) { PHASE_ENV() hgrn_pass_c(F, HQ, LF, HV, HG, ST, P.hgrn_norm_w + l * 128, XB); if (REP_MASK & 16) hgrn_pass_c(F, HQ, LF, HV, HG, ST, P.hgrn_norm_w + l * 128, XB); }
        SEAM(pb + 3);
        if (IN(pb + 4)) { PHASE_ENV()
            pg8::Gemm g{XB, (const bf16*)(ws + WS_WOUT + l * 2 * MiB), M, D, D}; pg8::StaticOrder S; S.init(M, D, F.G, (int)blockIdx.x);
            bf16* X2 = (bf16*)P.out;
            pg8::EpiRes E{l == 0 ? P.x : nullptr, l == 0 ? nullptr : X2, nullptr, ST, ssq + (size_t)(2 * l + 1) * M};
            pg8::gemm_phase<pg8::EpiRes, pg8::StaticOrder, true, true>(F.lds, g, S, E);
        }
        SEAM(pb + 4);
        if (IN(pb + 5)) { PHASE_ENV()
            pg8::Gemm g{ST, (const bf16*)(ws + WS_WUP + l * 8 * MiB), M, FF, D}; pg8::StaticOrder S; S.init(M, FF, F.G, (int)blockIdx.x);
            pg8::EpiUp E{ssq + (size_t)(2 * l + 1) * M, HB};
            pg8::gemm_phase<pg8::EpiUp, pg8::StaticOrder, true, true>(F.lds, g, S, E);
            if (REP_MASK & 32) pg8::gemm_phase<pg8::EpiUp, pg8::StaticOrder, true, true>(F.lds, g, S, E);
        }
        SEAM(pb + 5);
        if (IN(pb + 6)) { PHASE_ENV()
            pg8::Gemm g{HB, (const bf16*)(ws + WS_WDN + l * 8 * MiB), M, D, FF}; pg8::StaticOrder S; S.init(M, D, F.G, (int)blockIdx.x);
            const bool last = (l == DEPTH - 1);
            pg8::EpiRes E{nullptr, ST, last ? P.out : nullptr, last ? nullptr : (bf16*)P.out, last ? nullptr : ssq + (size_t)(2 * l + 2) * M};
            pg8::gemm_phase<pg8::EpiRes, pg8::StaticOrder, true, true>(F.lds, g, S, E);
        }
        SEAM(pb + 6);
    }
#undef IN
#undef SEAM
}

#ifndef MK_PER_PHASE
#define MK_PER_PHASE 0
#endif
extern "C" void kernel_launch(void* const* d_in, const int* in_sizes, int n_in, void* d_out, int out_size, void* d_ws, size_t ws_size, hipStream_t stream) {
    static int grid = 0;
    if (grid == 0) {
        if (n_in != 12 || out_size != M * D || ws_size < WS_DL + MiB) { fprintf(stderr, "kernel_launch: unexpected sizes (n_in %d out %d ws %zu)\n", n_in, out_size, ws_size); grid = -1; return; }
        int dev = 0, cus = 0, per_cu = 0;
        (void)hipGetDevice(&dev); (void)hipDeviceGetAttribute(&cus, hipDeviceAttributeMultiprocessorCount, dev);
        if (hipFuncSetAttribute((const void*)hymba_fwd, hipFuncAttributeMaxDynamicSharedMemorySize, LDS_BYTES) != hipSuccess) { fprintf(stderr, "kernel_launch: hipFuncSetAttribute failed\n"); grid = -1; return; }
        if (hipOccupancyMaxActiveBlocksPerMultiprocessor(&per_cu, (const void*)hymba_fwd, NTHREADS, LDS_BYTES) != hipSuccess || per_cu < 1) { fprintf(stderr, "kernel_launch: occupancy query gave %d\n", per_cu); per_cu = 1; }
        (void)hipGetLastError();
        grid = cus * 1;
        fprintf(stderr, "kernel_launch: cus %d per_cu %d grid %d\n", cus, per_cu, grid);
    }
    if (grid < 0) return;
    (void)hipMemsetAsync((char*)d_ws + WS_CTL, 0, CTL_ZERO_BYTES, stream);
    Args a{};
    a.p.x = (const float*)d_in[0]; a.p.lower_bounds = (const float*)d_in[1]; a.p.norm1_w = (const float*)d_in[2]; a.p.w_in = (const float*)d_in[3];
    a.p.fox_f_bias = (const float*)d_in[4]; a.p.q_norm_w = (const float*)d_in[5]; a.p.k_norm_w = (const float*)d_in[6]; a.p.hgrn_norm_w = (const float*)d_in[7];
    a.p.w_out = (const float*)d_in[8]; a.p.norm2_w = (const float*)d_in[9]; a.p.w_up = (const float*)d_in[10]; a.p.w_down = (const float*)d_in[11];
    a.p.out = (float*)d_out; a.p.ws = (unsigned char*)d_ws;
#if MK_PER_PHASE
    for (int ph = 0; ph < N_PHASES; ++ph) { a.ph_lo = ph; a.ph_hi = ph + 1; hipLaunchKernelGGL(hymba_fwd, dim3(grid), dim3(NTHREADS), LDS_BYTES, stream, a); }
#else
    a.ph_lo = 0; a.ph_hi = N_PHASES;
    void* kargs[] = {&a};
    const hipError_t e = hipLaunchCooperativeKernel((const void*)hymba_fwd, dim3(grid), dim3(NTHREADS), kargs, LDS_BYTES, stream);
    if (e != hipSuccess) fprintf(stderr, "kernel_launch: cooperative launch failed: %s (grid %d)\n", hipGetErrorString(e), grid);
#endif
}
```

```cpp
#include <hip/hip_runtime.h>
#include <hip/hip_cooperative_groups.h>
#include <cstdio>
#include <cstdint>
namespace cg = cooperative_groups;
namespace pg8 {
#define PG8_LAS __attribute__((address_space(3)))
typedef unsigned short bf16_t;
typedef short bf16x8 __attribute__((ext_vector_type(8)));
typedef float f32x4 __attribute__((ext_vector_type(4)));
typedef unsigned u32x4 __attribute__((ext_vector_type(4)));
constexpr int BM = 256, BK = 64, HALF = 128, HTB = HALF * BK * 2  , STAGE_BYTES = 8 * HTB, NXCD = 8, WGM = 8;

__host__ __device__ __forceinline__ int lds_byte(int r, int c) { const int st = (r >> 4) * 2 + (c >> 5), rr = r & 15, cc = c & 31, ob = rr * 64 + cc * 2; return st * 1024 + (ob ^ (((ob >> 9) & 1) << 5)); }
__host__ __device__ __forceinline__ void stage_rc(int b, int& R, int& C) { const int st = b / 1024, sb = b % 1024, swz = sb ^ (((sb >> 9) & 1) << 5); R = (st >> 1) * 16 + swz / 64; C = (st & 1) * 32 + (swz % 64) / 2; }
__host__ __device__ __forceinline__ int perm32(int rho) { const int n = rho >> 4, i = rho & 15; return 8 * (i >> 2) + 4 * n + (i & 3); }

struct Unit { int pm, pn; };
struct Gemm { const bf16_t* A; const bf16_t* Bt; int M, N, K; };

struct StaticOrder {
    int nM, nN, nwg, G, c;
    __host__ __device__ void init(int M, int N, int G_, int c_) { nM = M / BM; nN = N / BM; nwg = nM * nN; G = G_; c = c_; }
    __host__ __device__ bool next(int i, Unit& u) const {
        const long L = (long)i * G + c; if (L >= nwg) return false;
        int wgid = (int)L; { const int q = nwg / NXCD, r = nwg % NXCD, xcd = wgid % NXCD, off = wgid / NXCD; wgid = (xcd < r ? xcd * (q + 1) : r * (q + 1) + (xcd - r) * q) + off; }
        const int nig = WGM * nN, gid = wgid / nig, fm = gid * WGM, gsz = (nM - fm) < WGM ? (nM - fm) : WGM;
        u.pm = fm + ((wgid % nig) % gsz); u.pn = (wgid % nig) / gsz; return true;
    }
    __device__ __forceinline__ void a_ready(const Unit&) const {}
    __device__ __forceinline__ void done(const Unit&) const {}
};

__device__ __forceinline__ unsigned cvt_pk_bf16(float lo, float hi) { unsigned r; asm volatile("v_cvt_pk_bf16_f32 %0, %1, %2" : "=v"(r) : "v"(lo), "v"(hi)); return r; }
typedef float f32x2 __attribute__((ext_vector_type(2)));
template <class Epi, class Sched, bool ALIGN_EPI = false, bool SP2 = false>
__device__ __forceinline__ void gemm_phase(PG8_LAS unsigned char* lds, const Gemm g, const Sched& S, const Epi& E) {
    int tid_o = threadIdx.x; asm volatile("" : "+v"(tid_o));
    const int tid = tid_o, wid = __builtin_amdgcn_readfirstlane(tid >> 6), lane = tid & 63, wr = wid >> 2, wc = wid & 3, fr = lane & 15, fq = lane >> 4;
    const int K = g.K, nt = K / BK;
    unsigned voffA[2], voffB[2];
#pragma unroll
    for (int i = 0; i < 2; ++i) { int R, C; stage_rc(tid * 16 + i * 8192, R, C); const int Rb = Epi::PERM ? ((R & ~31) + perm32(R & 31)) : R;
        voffA[i] = (unsigned)(R * K + C) * 2u; voffB[i] = (unsigned)(Rb * K + C) * 2u; }
    const size_t kstep = (size_t)(BK * 2);
    const size_t hstep = (size_t)HALF * K * 2;
    const size_t tstep = 2 * hstep;
    const unsigned ldsw = (unsigned)wid * 1024u;
    const int aoff = lds_byte(wr * 64 + fr, fq * 8), boff = lds_byte(wc * 32 + fr, fq * 8);
#define PG8_SA(b, h) (((b) * 2 + (h)) * HTB)
#define PG8_SB(b, h) ((4 + (b) * 2 + (h)) * HTB)
#define PG8_STAGE(bufoff, gbase, voff) do { _Pragma("unroll") for (int _i = 0; _i < 2; ++_i) \
        __builtin_amdgcn_global_load_lds((const unsigned*)((const char*)(gbase) + (voff)[_i]), (PG8_LAS unsigned*)(lds + (bufoff) + ldsw + _i * 8192), 16, 0, 0); } while (0)
#define PG8_LDA(dst, b, h) do { _Pragma("unroll") for (int m = 0; m < 4; ++m) _Pragma("unroll") for (int k = 0; k < 2; ++k) dst[m][k] = *(const PG8_LAS bf16x8*)(lds + PG8_SA(b, h) + aoff + m * 2048 + k * 1024); } while (0)
#define PG8_LDB(dst, b, h) do { _Pragma("unroll") for (int n = 0; n < 2; ++n) _Pragma("unroll") for (int k = 0; k < 2; ++k) dst[n][k] = *(const PG8_LAS bf16x8*)(lds + PG8_SB(b, h) + boff + n * 2048 + k * 1024); } while (0)
#define PG8_MMA(ai, bj, At, Bt) do { __builtin_amdgcn_s_setprio(1); _Pragma("unroll") for (int m = 0; m < 4; ++m) _Pragma("unroll") for (int n = 0; n < 2; ++n) _Pragma("unroll") for (int k = 0; k < 2; ++k) \
        acc[ai][bj][m][n] = __builtin_amdgcn_mfma_f32_16x16x32_bf16(Bt[n][k], At[m][k], acc[ai][bj][m][n], 0, 0, 0); __builtin_amdgcn_s_setprio(0); } while (0)
#define PG8_WAIT_V(n) asm volatile("s_waitcnt vmcnt(" #n ")" ::: "memory")
#define PG8_WAIT_L(n) asm volatile("s_waitcnt lgkmcnt(" #n ")" ::: "memory")
#define PG8_BAR __builtin_amdgcn_s_barrier()
#define PG8_SCHED __builtin_amdgcn_sched_barrier(0)
    Unit cur, nxt; int ui = 0;
    if (!S.next(0, cur)) return;
    f32x4 acc[2][2][4][2];
#pragma unroll
    for (int a = 0; a < 2; ++a)
#pragma unroll
        for (int b = 0; b < 2; ++b)
#pragma unroll
            for (int m = 0; m < 4; ++m)
#pragma unroll
                for (int n = 0; n < 2; ++n) acc[a][b][m][n] = (f32x4){0.f, 0.f, 0.f, 0.f};
    bf16x8 At[4][2], B0[2][2], B1[2][2];
    const char* cA = (const char*)g.A + (size_t)cur.pm * tstep; const char* cB = (const char*)g.Bt + (size_t)cur.pn * tstep;
    S.a_ready(cur);
    if constexpr (SP2) {
        PG8_STAGE(PG8_SB(0, 0), cB, voffB); PG8_STAGE(PG8_SB(0, 1), cB + hstep, voffB); PG8_STAGE(PG8_SA(0, 0), cA, voffA); PG8_STAGE(PG8_SA(0, 1), cA + hstep, voffA);
        if (wr == 1) PG8_BAR;
        PG8_WAIT_V(2); PG8_BAR;
        PG8_STAGE(PG8_SB(1, 0), cB + kstep, voffB); PG8_STAGE(PG8_SA(1, 0), cA + kstep, voffA); PG8_STAGE(PG8_SB(1, 1), cB + hstep + kstep, voffB);
        PG8_WAIT_V(6); PG8_BAR;
    } else {
        PG8_STAGE(PG8_SB(0, 0), cB, voffB); PG8_STAGE(PG8_SA(0, 0), cA, voffA); PG8_STAGE(PG8_SB(0, 1), cB + hstep, voffB); PG8_STAGE(PG8_SA(0, 1), cA + hstep, voffA);
        if (wr == 1) PG8_BAR;
        PG8_WAIT_V(4); PG8_BAR;
        PG8_STAGE(PG8_SB(1, 0), cB + kstep, voffB); PG8_STAGE(PG8_SA(1, 0), cA + kstep, voffA); PG8_STAGE(PG8_SB(1, 1), cB + hstep + kstep, voffB);
        PG8_WAIT_V(6); PG8_BAR;
    }
    for (;;) {
        const bool has_next = S.next(ui + 1, nxt);
        const char* nA = has_next ? (const char*)g.A + (size_t)nxt.pm * tstep : cA; const char* nB = has_next ? (const char*)g.Bt + (size_t)nxt.pn * tstep : cB;
        for (int t = 0; t < nt; t += 2) {
            const bool last = (t == nt - 2);
            const char* a1 = cA + (size_t)(t + 1) * kstep;
            const char* a2 = last ? nA : cA + (size_t)(t + 2) * kstep; const char* b2 = last ? nB : cB + (size_t)(t + 2) * kstep;
            const char* a3 = a2 + kstep; const char* b3 = b2 + kstep;
            if (last && has_next) S.a_ready(nxt);
            if constexpr (SP2) {
            PG8_LDB(B0, 0, 0); PG8_LDB(B1, 0, 1); PG8_SCHED; PG8_LDA(At, 0, 0); PG8_STAGE(PG8_SA(1, 1), a1 + hstep, voffA);
            PG8_WAIT_V(8); PG8_WAIT_L(0); PG8_BAR; PG8_MMA(0, 0, At, B0); PG8_MMA(0, 1, At, B1); PG8_BAR; PG8_SCHED;
            PG8_LDA(At, 0, 1); PG8_STAGE(PG8_SB(0, 0), b2, voffB); PG8_STAGE(PG8_SB(0, 1), b2 + hstep, voffB); PG8_STAGE(PG8_SA(0, 0), a2, voffA);
            PG8_WAIT_V(8); PG8_WAIT_L(0); PG8_BAR; PG8_MMA(1, 0, At, B0); PG8_MMA(1, 1, At, B1); PG8_BAR; PG8_SCHED;
            PG8_LDB(B0, 1, 0); PG8_LDB(B1, 1, 1); PG8_SCHED; PG8_LDA(At, 1, 0); PG8_STAGE(PG8_SA(0, 1), a2 + hstep, voffA);
            PG8_WAIT_V(8); PG8_WAIT_L(0); PG8_BAR; PG8_MMA(0, 0, At, B0); PG8_MMA(0, 1, At, B1); PG8_BAR; PG8_SCHED;
            PG8_LDA(At, 1, 1); PG8_STAGE(PG8_SB(1, 0), b3, voffB); PG8_STAGE(PG8_SB(1, 1), b3 + hstep, voffB); PG8_STAGE(PG8_SA(1, 0), a3, voffA);
            PG8_WAIT_V(8); PG8_WAIT_L(0); PG8_BAR; PG8_MMA(1, 0, At, B0); PG8_MMA(1, 1, At, B1); PG8_BAR; PG8_SCHED;
            } else {
            PG8_LDB(B0, 0, 0); PG8_SCHED; PG8_LDA(At, 0, 0); PG8_STAGE(PG8_SA(1, 1), a1 + hstep, voffA);
            PG8_WAIT_L(8); PG8_BAR; PG8_WAIT_L(0); PG8_MMA(0, 0, At, B0); PG8_BAR; PG8_SCHED;
            PG8_LDB(B1, 0, 1); PG8_STAGE(PG8_SB(0, 0), b2, voffB);
            PG8_BAR; PG8_WAIT_L(0); PG8_MMA(0, 1, At, B1); PG8_BAR;
            PG8_LDA(At, 0, 1); PG8_STAGE(PG8_SA(0, 0), a2, voffA);
            PG8_BAR; PG8_WAIT_L(0); PG8_MMA(1, 0, At, B0); PG8_BAR; PG8_SCHED;
            PG8_STAGE(PG8_SB(0, 1), b2 + hstep, voffB);
            PG8_WAIT_V(6); PG8_BAR; PG8_MMA(1, 1, At, B1); PG8_BAR;
            PG8_LDB(B0, 1, 0); PG8_SCHED; PG8_LDA(At, 1, 0); PG8_STAGE(PG8_SA(0, 1), a2 + hstep, voffA);
            PG8_WAIT_L(8); PG8_BAR; PG8_WAIT_L(0); PG8_MMA(0, 0, At, B0); PG8_BAR; PG8_SCHED;
            PG8_LDB(B1, 1, 1); PG8_STAGE(PG8_SB(1, 0), b3, voffB);
            PG8_BAR; PG8_WAIT_L(0); PG8_MMA(0, 1, At, B1); PG8_BAR;
            PG8_LDA(At, 1, 1); PG8_STAGE(PG8_SA(1, 0), a3, voffA);
            PG8_BAR; PG8_WAIT_L(0); PG8_MMA(1, 0, At, B0); PG8_BAR; PG8_SCHED;
            PG8_STAGE(PG8_SB(1, 1), b3 + hstep, voffB);
            PG8_WAIT_V(6); PG8_BAR; PG8_MMA(1, 1, At, B1); PG8_BAR;
            }
        }
        if constexpr (ALIGN_EPI) { if (wr == 0) PG8_BAR; }
        if constexpr (!Epi::AFTER_DRAIN) { E(acc, cur, wr, wc, fr, fq); S.done(cur); }
        if (!has_next) break;
#pragma unroll
        for (int a = 0; a < 2; ++a)
#pragma unroll
            for (int b = 0; b < 2; ++b)
#pragma unroll
                for (int m = 0; m < 4; ++m)
#pragma unroll
                    for (int n = 0; n < 2; ++n) acc[a][b][m][n] = (f32x4){0.f, 0.f, 0.f, 0.f};
        cur = nxt; cA = nA; cB = nB; ++ui;
        if constexpr (ALIGN_EPI) { if (wr == 1) PG8_BAR; }
    }
    PG8_WAIT_V(0);
    if constexpr (!ALIGN_EPI) { if (wr == 0) PG8_BAR; }
    PG8_BAR;
    if constexpr (Epi::AFTER_DRAIN) { E.fused(acc, cur, wr, wc, fr, fq, lds, wid, lane); S.done(cur); }
#undef PG8_SA
#undef PG8_SB
#undef PG8_STAGE
#undef PG8_LDA
#undef PG8_LDB
#undef PG8_MMA
#undef PG8_WAIT_V
#undef PG8_WAIT_L
#undef PG8_BAR
#undef PG8_SCHED
}
}
namespace pg8 {
typedef unsigned u32x2 __attribute__((ext_vector_type(2)));
__device__ __forceinline__ float fsigmoid(float v) { return 1.0f / (1.0f + __expf(-v)); }
struct EpiIn {
    static constexpr bool PERM = true, AFTER_DRAIN = false;
    const float* ssq;
    bf16_t *hq, *hv, *hg, *Q, *Kb, *V; float* lf; float* lsig;
    const float* lba; const float* lbb;
    int layer; const float* qw; const float* kw; const float* fbias;
    __device__ __forceinline__ void operator()(const f32x4 (&acc)[2][2][4][2], const Unit& u, int wr, int wc, int fr, int fq) const {
        const int pn = u.pn, g = pn >> 1, half = pn & 1;
        const int row0 = u.pm * BM + wr * 64 + fr;
        if (pn == 14) {
            if (wc == 0 && fq == 0) {
                const f32x4 b0 = *(const f32x4*)(fbias), b1 = *(const f32x4*)(fbias + 4);
#pragma unroll
                for (int ai = 0; ai < 2; ++ai)
#pragma unroll
                    for (int m = 0; m < 4; ++m) { const int row = row0 + ai * HALF + m * 16; const float rs = rsqrtf(ssq[row] * (1.0f / 1024.0f) + 1e-6f);
                        f32x4 v0 = acc[ai][0][m][0] * rs + b0, v1 = acc[ai][0][m][1] * rs + b1;
#pragma unroll
                        for (int j = 0; j < 4; ++j) { v0[j] = fminf(v0[j], 0.f) - log1pf(__expf(-fabsf(v0[j]))); v1[j] = fminf(v1[j], 0.f) - log1pf(__expf(-fabsf(v1[j]))); }
                        *(f32x4*)(lsig + (size_t)row * 8) = v0; *(f32x4*)(lsig + (size_t)row * 8 + 4) = v1; }
            }
            return;
        }
        if (g == 4 || g == 5) {
            bf16_t* dst = (g == 4) ? Q : Kb; const float* nw = (g == 4) ? qw : kw; const float osc = (g == 4) ? 0.125f * 1.4426950408889634f : 1.0f;
            f32x4 w[2][2];
#pragma unroll
            for (int bj = 0; bj < 2; ++bj)
#pragma unroll
                for (int n = 0; n < 2; ++n) w[bj][n] = *(const f32x4*)(nw + 32 * bj + 8 * fq + 4 * n) * osc;
            const int col0 = (half * 4 + wc) * 64 + 8 * fq;
#pragma unroll
            for (int ai = 0; ai < 2; ++ai)
#pragma unroll
                for (int m = 0; m < 4; ++m) { const int row = row0 + ai * HALF + m * 16; const float rs = rsqrtf(ssq[row] * (1.0f / 1024.0f) + 1e-6f);
                    f32x4 v[2][2]; float ss = 0.f;
#pragma unroll
                    for (int bj = 0; bj < 2; ++bj)
#pragma unroll
                        for (int n = 0; n < 2; ++n) { v[bj][n] = acc[ai][bj][m][n] * rs; ss += (v[bj][n][0] * v[bj][n][0] + v[bj][n][1] * v[bj][n][1]) + (v[bj][n][2] * v[bj][n][2] + v[bj][n][3] * v[bj][n][3]); }
                    ss += __shfl_xor(ss, 16); ss += __shfl_xor(ss, 32);
                    const float hr = rsqrtf(ss * (1.0f / 64.0f) + 1e-6f);
#pragma unroll
                    for (int bj = 0; bj < 2; ++bj) { const f32x4 a = v[bj][0] * hr * w[bj][0], b = v[bj][1] * hr * w[bj][1];
                        u32x4 o; o.x = cvt_pk_bf16(a[0], a[1]); o.y = cvt_pk_bf16(a[2], a[3]); o.z = cvt_pk_bf16(b[0], b[1]); o.w = cvt_pk_bf16(b[2], b[3]);
                        *(u32x4*)(dst + (size_t)row * 512 + col0 + 32 * bj) = o; } }
            return;
        }
        const int col0 = half * 256 + wc * 32 + 8 * fq;
        if (g == 1) {
            f32x4 lbv[2][2];
#pragma unroll
            for (int bj = 0; bj < 2; ++bj)
#pragma unroll
                for (int n = 0; n < 2; ++n) { f32x4 t = (f32x4){0.f, 0.f, 0.f, 0.f};
                    if (layer == 1) { const f32x4 a0 = *(const f32x4*)(lba + col0 + 128 * bj + 4 * n), a1 = *(const f32x4*)(lbb + col0 + 128 * bj + 4 * n);
#pragma unroll
                        for (int j = 0; j < 4; ++j) t[j] = fsigmoid(a1[j] - a0[j]); }
                    lbv[bj][n] = t; }
#pragma unroll
            for (int ai = 0; ai < 2; ++ai)
#pragma unroll
                for (int m = 0; m < 4; ++m) { const int row = row0 + ai * HALF + m * 16; const float rs = rsqrtf(ssq[row] * (1.0f / 1024.0f) + 1e-6f);
#pragma unroll
                    for (int bj = 0; bj < 2; ++bj)
#pragma unroll
                        for (int n = 0; n < 2; ++n) { f32x4 v = acc[ai][bj][m][n] * rs;
#pragma unroll
                            for (int j = 0; j < 4; ++j) v[j] = __logf(lbv[bj][n][j] + (1.0f - lbv[bj][n][j]) * fsigmoid(v[j]));
                            *(f32x4*)(lf + (size_t)row * 512 + col0 + 128 * bj + 4 * n) = v; } }
            return;
        }
        bf16_t* dst = (g == 0) ? hq : (g == 2) ? hv : (g == 3) ? hg : V;
        const float sc = (g == 0) ? 0.08838834764831845f : 1.0f;
#pragma unroll
        for (int ai = 0; ai < 2; ++ai)
#pragma unroll
            for (int m = 0; m < 4; ++m) { const int row = row0 + ai * HALF + m * 16; const float rs = rsqrtf(ssq[row] * (1.0f / 1024.0f) + 1e-6f) * sc;
#pragma unroll
                for (int bj = 0; bj < 2; ++bj) { f32x4 a = acc[ai][bj][m][0] * rs, b = acc[ai][bj][m][1] * rs;
                    if (g == 3) {
#pragma unroll
                        for (int j = 0; j < 4; ++j) { a[j] = a[j] * fsigmoid(a[j]); b[j] = b[j] * fsigmoid(b[j]); } }
                    u32x4 o; o.x = cvt_pk_bf16(a[0], a[1]); o.y = cvt_pk_bf16(a[2], a[3]); o.z = cvt_pk_bf16(b[0], b[1]); o.w = cvt_pk_bf16(b[2], b[3]);
                    *(u32x4*)(dst + (size_t)row * 512 + col0 + 128 * bj) = o; } }
    }
};
struct EpiRes {
    static constexpr bool PERM = false, AFTER_DRAIN = false;
    const float* base32; const bf16_t* base16; float* out32; bf16_t* out16; float* ssq;
    __device__ __forceinline__ void operator()(const f32x4 (&acc)[2][2][4][2], const Unit& u, int wr, int wc, int fr, int fq) const {
        const int col0 = u.pn * BM + wc * 32 + 4 * fq;
#pragma unroll
        for (int ai = 0; ai < 2; ++ai)
#pragma unroll
            for (int m = 0; m < 4; ++m) { const int row = u.pm * BM + ai * HALF + wr * 64 + m * 16 + fr; const size_t off = (size_t)row * 1024 + col0; float ss = 0.f;
#pragma unroll
                for (int bj = 0; bj < 2; ++bj)
#pragma unroll
                    for (int n = 0; n < 2; ++n) { const size_t o_ = off + bj * HALF + n * 16; f32x4 b;
                        if (base32) b = *(const f32x4*)(base32 + o_);
                        else { const u32x2 w = *(const u32x2*)(base16 + o_); b = (f32x4){__builtin_bit_cast(float, w.x << 16), __builtin_bit_cast(float, w.x & 0xffff0000u), __builtin_bit_cast(float, w.y << 16), __builtin_bit_cast(float, w.y & 0xffff0000u)}; }
                        const f32x4 o = b + acc[ai][bj][m][n];
                        ss += (o[0] * o[0] + o[1] * o[1]) + (o[2] * o[2] + o[3] * o[3]);
                        if (out32) *(f32x4*)(out32 + o_) = o;
                        else { u32x2 w; w.x = cvt_pk_bf16(o[0], o[1]); w.y = cvt_pk_bf16(o[2], o[3]); *(u32x2*)(out16 + o_) = w; } }
                if (ssq) { ss += __shfl_xor(ss, 16); ss += __shfl_xor(ss, 32); if (fq == 0) unsafeAtomicAdd(ssq + row, ss); } }
    }
};
struct EpiUp {
    static constexpr bool PERM = true, AFTER_DRAIN = false;
    const float* ssq; bf16_t* H;
    __device__ __forceinline__ void operator()(const f32x4 (&acc)[2][2][4][2], const Unit& u, int wr, int wc, int fr, int fq) const {
        const int row0 = u.pm * BM + wr * 64 + fr, col0 = u.pn * BM + wc * 32 + 8 * fq;
#pragma unroll
        for (int ai = 0; ai < 2; ++ai)
#pragma unroll
            for (int m = 0; m < 4; ++m) { const int row = row0 + ai * HALF + m * 16; const float rs = rsqrtf(ssq[row] * (1.0f / 1024.0f) + 1e-6f);
#pragma unroll
                for (int bj = 0; bj < 2; ++bj) { f32x4 a = acc[ai][bj][m][0] * rs, b = acc[ai][bj][m][1] * rs;
#pragma unroll
                    for (int j = 0; j < 4; ++j) { a[j] = fmaxf(a[j], 0.f); a[j] *= a[j]; b[j] = fmaxf(b[j], 0.f); b[j] *= b[j]; }
                    u32x4 o; o.x = cvt_pk_bf16(a[0], a[1]); o.y = cvt_pk_bf16(a[2], a[3]); o.z = cvt_pk_bf16(b[0], b[1]); o.w = cvt_pk_bf16(b[2], b[3]);
                    *(u32x4*)(H + (size_t)row * 4096 + col0 + 128 * bj) = o; } }
    }
};
}
#include <hip/hip_bf16.h>
#include <cmath>
namespace attn_body {
using bf16=__hip_bfloat16;
using bf16x8=__attribute__((ext_vector_type(8)))short;
using s16x4=__attribute__((ext_vector_type(4)))short;
using f32x16=__attribute__((ext_vector_type(16)))float;
using u32x4=__attribute__((ext_vector_type(4)))unsigned;
using f32x4v=__attribute__((ext_vector_type(4)))float;
constexpr int BATCH=2,NHEAD=8,SEQ=8192,D=64,DM=NHEAD*D,ODM=1024;
constexpr int NW=8,QBLK=32,QB=QBLK*NW,KVBLK=64,NQB=SEQ/QB;
constexpr int ATTN_PITCH=DM, ATTN_UNIT_ROWS=QB;
__device__ __forceinline__ int crow(int r,int hi){return (r&3)+8*(r>>2)+4*hi;}
#define SBAR() __builtin_amdgcn_sched_barrier(0)
__device__ __forceinline__ void cmask(f32x16&p0,f32x16&p1,int jb,int qrel,int hi){
  const float NEG=-INFINITY; int kb=64*jb+4*hi;
  #pragma unroll
  for(int r=0;r<16;++r){int kv=kb+(r&3)+8*(r>>2); if(kv>qrel)p0[r]=NEG; if(kv+32>qrel)p1[r]=NEG;}
}

constexpr int NSLOT=3, SLOTB=8192;
constexpr int LDS_K=0, LDS_V=NSLOT*SLOTB, LDS_WS=2*NSLOT*SLOTB, LDS_OST=LDS_WS+NW*64*4, LDS_BYTES=LDS_OST+NW*4096, LDS_DK=86016, LDS_END=LDS_DK+SEQ*4;
constexpr float C2=0.125f*1.4426950408889634f;
__device__ __forceinline__ void glds16(const void*gsrc,unsigned lds_dst){unsigned keep;
  asm volatile("s_mov_b32 %0, m0\n\ts_mov_b32 m0, %2\n\ts_nop 0\n\tglobal_load_lds_dwordx4 %1, off\n\ts_mov_b32 m0, %0":"=&s"(keep):"v"(gsrc),"s"(lds_dst):"memory");}
__device__ __forceinline__ float max3f(float a,float b,float c){float r;asm("v_max3_f32 %0, %1, %2, %3":"=v"(r):"v"(a),"v"(b),"v"(c));return r;}
__device__ __forceinline__ float max2f(float a,float b){float r;asm("v_max_f32_e32 %0, %1, %2":"=v"(r):"v"(a),"v"(b));return r;}
__device__ __forceinline__ float fadd_s(float a,float b){float r;asm("v_add_f32_e32 %0, %1, %2":"=v"(r):"v"(a),"v"(b));return r;}
__device__ __forceinline__ float fsub_s(float a,float b){float r;asm("v_sub_f32_e32 %0, %1, %2":"=v"(r):"v"(a),"v"(b));return r;}
typedef float f32x2_t __attribute__((ext_vector_type(2))); typedef __bf16 bf16x2_t __attribute__((ext_vector_type(2)));
__device__ __forceinline__ unsigned cvtpk_s(float lo,float hi){f32x2_t v={lo,hi};bf16x2_t b=__builtin_convertvector(v,bf16x2_t);return __builtin_bit_cast(unsigned,b);}
#define WAIT_BAR(N) asm volatile("s_waitcnt vmcnt(" #N ") lgkmcnt(0)\n\ts_barrier":::"memory")

__device__ __forceinline__ void qkt(f32x16&p0,f32x16&p1,const char*Kslot,const bf16x8*qr,int r32,int hi){
  const char*kb=Kslot+hi*1024+r32*16;
  #pragma unroll
  for(int d0=0;d0<4;++d0){
    const bf16x8 b0=*reinterpret_cast<const bf16x8*>(kb+d0*2048);
    const bf16x8 b1=*reinterpret_cast<const bf16x8*>(kb+d0*2048+512);
    {p0=__builtin_amdgcn_mfma_f32_32x32x16_bf16(b0,qr[d0],p0,0,0,0);p1=__builtin_amdgcn_mfma_f32_32x32x16_bf16(b1,qr[d0],p1,0,0,0);}}
}
typedef __attribute__((address_space(3))) const char* lds_cptr;
typedef short v4i16_t __attribute__((ext_vector_type(4)));
__device__ __forceinline__ void kload8(bf16x8*kf,lds_cptr kp){
  kf[0]=*(const __attribute__((address_space(3))) bf16x8*)(kp);      kf[1]=*(const __attribute__((address_space(3))) bf16x8*)(kp+512);
  kf[2]=*(const __attribute__((address_space(3))) bf16x8*)(kp+2048); kf[3]=*(const __attribute__((address_space(3))) bf16x8*)(kp+2560);
  kf[4]=*(const __attribute__((address_space(3))) bf16x8*)(kp+4096); kf[5]=*(const __attribute__((address_space(3))) bf16x8*)(kp+4608);
  kf[6]=*(const __attribute__((address_space(3))) bf16x8*)(kp+6144); kf[7]=*(const __attribute__((address_space(3))) bf16x8*)(kp+6656);
}
__device__ __forceinline__ void kload2(bf16x8*kf,lds_cptr kp,int j){ kf[2*j]=*(const __attribute__((address_space(3))) bf16x8*)(kp+j*2048); kf[2*j+1]=*(const __attribute__((address_space(3))) bf16x8*)(kp+j*2048+512); }
__device__ __forceinline__ s16x4 vtr(lds_cptr p){ return __builtin_bit_cast(s16x4,__builtin_amdgcn_ds_read_tr16_b64_v4i16((__attribute__((address_space(3))) v4i16_t*)p)); }
__device__ __forceinline__ float rowmax(const f32x16&p0,const f32x16&p1){
  float a=max3f(p0[0],p0[1],p1[0]),b=max3f(p0[2],p0[3],p1[1]);a=max3f(a,p1[2],p1[3]);
  #pragma unroll
  for(int r=4;r<16;r+=4){a=max3f(a,p0[r],p0[r+1]);b=max3f(b,p0[r+2],p0[r+3]);a=max3f(a,p1[r],p1[r+1]);b=max3f(b,p1[r+2],p1[r+3]);}
  const float m=max2f(a,b);
  auto rr=__builtin_amdgcn_permlane32_swap(__float_as_uint(m),__float_as_uint(m),false,false);
  return max2f(__uint_as_float(rr[0]),__uint_as_float(rr[1]));
}
__device__ __forceinline__ void pv(f32x16*o,int vb,bf16x8 pa0,bf16x8 pa1,bf16x8 pa2,bf16x8 pa3){
  #pragma unroll
  for(int d0=0;d0<2;++d0){s16x4 lo[4],hi[4];
    #pragma unroll
    for(int ks=0;ks<4;++ks){
      asm volatile("ds_read_b64_tr_b16 %0,%1 offset:%c2":"=&v"(lo[ks]):"v"(vb),"i"(d0*4096+ks*1024):"memory");
      asm volatile("ds_read_b64_tr_b16 %0,%1 offset:%c2":"=&v"(hi[ks]):"v"(vb),"i"(d0*4096+ks*1024+512):"memory");}
    asm volatile("s_waitcnt lgkmcnt(0)":::"memory");SBAR();
    #define PK(k) (bf16x8){lo[k][0],lo[k][1],lo[k][2],lo[k][3],hi[k][0],hi[k][1],hi[k][2],hi[k][3]}
    o[d0]=__builtin_amdgcn_mfma_f32_32x32x16_bf16(pa0,PK(0),o[d0],0,0,0);
    o[d0]=__builtin_amdgcn_mfma_f32_32x32x16_bf16(pa1,PK(1),o[d0],0,0,0);
    o[d0]=__builtin_amdgcn_mfma_f32_32x32x16_bf16(pa2,PK(2),o[d0],0,0,0);
    o[d0]=__builtin_amdgcn_mfma_f32_32x32x16_bf16(pa3,PK(3),o[d0],0,0,0);
    #undef PK
  }
}

#ifndef ATTN_STORE16
#define ATTN_STORE16(p,v) (*(u32x4*)(p)=(v))
#endif
template<int THRL> __device__ __forceinline__ void attn_unit(int b,int h,int qb,int NT,const bf16*Q,const bf16*__restrict__ K,const bf16*__restrict__ V,bf16*O,char*shm){
  int tid_o=threadIdx.x; asm volatile("":"+v"(tid_o));
  const int tid=tid_o,lane=tid&63,r32=lane&31,hi=lane>>5; const int wid=__builtin_amdgcn_readfirstlane(tid>>6);
  const long rowbase=(long)b*SEQ; const int q0=qb*QB;
  const bf16*Qw=Q+(rowbase+q0+wid*QBLK)*DM+h*D;
  const bf16*Kh=K+rowbase*DM+h*D,*Vh=V+rowbase*DM+h*D;
  const unsigned lds0=(unsigned)(uintptr_t)shm;
  float*wsf=(float*)(shm+LDS_WS)+wid*64;
  const bf16*ksrc=Kh+(long)lane*DM+wid*8;
  const bf16*vsrc=Vh+(long)(16*(wid&3)+(lane>>2))*DM+(wid>>2)*32+(lane&3)*8;
  const unsigned kdst=lds0+LDS_K+wid*1024, vdst=lds0+LDS_V+wid*1024;
  #define TA(t) (((t)<4)?(NTA-4+(t)):(NTA-1-(t)))
  #define DMA_K(t,slot) glds16(ksrc+(long)TA(t)*KVBLK*DM,(unsigned)__builtin_amdgcn_readfirstlane(kdst+(slot)))
  #define DMA_V(t,slot) glds16(vsrc+(long)TA(t)*KVBLK*DM,(unsigned)__builtin_amdgcn_readfirstlane(vdst+(slot)))
  const int vb0=(int)(lds0+LDS_V)+((lane>>4)&1)*32+(lane&3)*8+(4*hi+((lane&15)>>2))*64;
  const char*Kbase=shm+LDS_K; bf16x8 kf[8];
  const lds_cptr shm3=(lds_cptr)shm; const lds_cptr kp0=shm3+LDS_K+hi*1024+r32*16; const lds_cptr vp0=shm3+LDS_V+((lane>>4)&1)*32+(lane&3)*8+(4*hi+((lane&15)>>2))*64;
  const int NTA=(q0+QB)/KVBLK;
  typedef __attribute__((address_space(3))) const f32x4v* dk_cptr; const dk_cptr dkp=(dk_cptr)(shm3+LDS_DK+hi*16);
  #define CINIT1(C0,t,o8) do{ const dk_cptr dp_=dkp+TA(t)*16+(o8); _Pragma("unroll") for(int j_=0;j_<4;++j_){ const f32x4v a_=dp_[2*j_]; \
      C0[4*j_]=a_[0]+nmh;C0[4*j_+1]=a_[1]+nmh;C0[4*j_+2]=a_[2]+nmh;C0[4*j_+3]=a_[3]+nmh; } }while(0)
  #define CINIT(C0,C1,t) do{ CINIT1(C0,t,0); SBAR(); CINIT1(C1,t,8); }while(0)
  DMA_K(0,0);DMA_V(0,0);DMA_K(1,SLOTB);
  bf16x8 qr[4];
  #pragma unroll
  for(int d0=0;d0<4;++d0)qr[d0]=*reinterpret_cast<const bf16x8*>(&Qw[(long)r32*DM+d0*16+hi*8]);
  float mhat=0.f,l_reg=0.f,nmh=0.f;f32x16 o[2];o[0]=f32x16{};o[1]=f32x16{};
  const int qrel=wid*QBLK+r32;
  #define CMASK(P0,P1,t) do{int jb_=(t); if(jb_<4)cmask(P0,P1,jb_,qrel,hi);}while(0)
  bool resc=false;
  #define START(P0,P1) do{ const float rm=rowmax(P0,P1); resc=false; \
    { const float dl=rm; mhat=fadd_s(mhat,dl); \
      _Pragma("unroll") for(int r=0;r<16;++r){P0[r]=fsub_s(P0[r],dl);P1[r]=fsub_s(P1[r],dl);} \
      nmh=-mhat; } \
    _Pragma("unroll") for(int r=0;r<16;++r)P0[r]=__builtin_amdgcn_exp2f(P0[r]); }while(0)
  #define RESC() do{ if(resc){ asm volatile("s_waitcnt lgkmcnt(0)":::"memory"); \
      _Pragma("unroll") for(int d_=0;d_<2;++d_) _Pragma("unroll") for(int r=0;r<16;++r)o[d_][r]*=wsf[crow(r,hi)]; } }while(0)
  f32x16 pA0,pA1,pB0,pB1;
  int sl_prev=0,sl_cur=0,sl_next=SLOTB;
  #define ROT() do{sl_prev=sl_cur;sl_cur=sl_next;sl_next=(sl_next==(NSLOT-1)*SLOTB)?0:sl_next+SLOTB;}while(0)
  DMA_K(2,2*SLOTB);
  WAIT_BAR(3);
  CINIT(pA0,pA1,0); qkt(pA0,pA1,Kbase,qr,r32,hi);asm volatile("s_nop 15\n\ts_nop 7":"+v"(pA0),"+v"(pA1));CMASK(pA0,pA1,0);
  START(pA0,pA1);
  _Pragma("unroll") for(int r=0;r<16;++r)pA1[r]=__builtin_amdgcn_exp2f(pA1[r]);
  WAIT_BAR(0);
  DMA_K(3,0);DMA_V(1,SLOTB);
  ROT();
  kload8(kf,kp0+sl_cur);
  WAIT_BAR(2);
  s16x4 vlo[8],vhi[8]; u32x4 pw0,pw1,pw2,pw3;
  #define PKW(P,B) cvtpk_s(P[B],P[B+1])
  #define PAF(k) __builtin_bit_cast(bf16x8,pw##k)
  #define VFR(i) (bf16x8){vlo[i][0],vlo[i][1],vlo[i][2],vlo[i][3],vhi[i][0],vhi[i][1],vhi[i][2],vhi[i][3]}
  #define PIN(x) asm volatile("":"+v"(x))
  #define MX3(a,b,c) __builtin_fmaxf(__builtin_fmaxf((a),(b)),(c))
  #define GAPA(MF,A0,A1,A2,A3,W0,W1,PW) do{ MF; sacc+=A0; sacc+=A1; sacc+=A2; sacc+=A3; PIN(sacc); W0; W1; PIN(PW); SBAR(); }while(0)
  #define EX(v) __builtin_amdgcn_exp2f(v)
  #define GAPB(MF,X,B) do{ MF; X[B]=EX(X[B]); X[B+1]=EX(X[B+1]); X[B+2]=EX(X[B+2]); X[B+3]=EX(X[B+3]); PIN(X); SBAR(); }while(0)
  #define VRD(i) do{ vlo[i]=vtr(vp_+(((i)>>2)*4096+((i)&3)*1024)); vhi[i]=vtr(vp_+(((i)>>2)*4096+((i)&3)*1024+512)); }while(0)
  #define KRD(G,j) do{ if(G){ kload2(kf,kp0+sl_next,j); SBAR(); } }while(0)
  #define STEP(C0,C1,P0,P1,t,GK,GV,GL) do{ SBAR(); CINIT(C0,C1,t); SBAR(); \
    const lds_cptr vp_=vp0+sl_prev; \
    float sacc=(P0[0]+P0[1]); \
    GAPA(C0=__builtin_amdgcn_mfma_f32_32x32x16_bf16(kf[0],qr[0],C0,0,0,0), P0[2],P0[3],P0[4],P0[5],     pw0[0]=PKW(P0,0), pw0[1]=PKW(P0,2), pw0); \
    GAPA(C1=__builtin_amdgcn_mfma_f32_32x32x16_bf16(kf[1],qr[0],C1,0,0,0), P0[6],P0[7],P0[8],P0[9],     pw0[2]=PKW(P0,4), pw0[3]=PKW(P0,6), pw0); \
    GAPA(C0=__builtin_amdgcn_mfma_f32_32x32x16_bf16(kf[2],qr[1],C0,0,0,0),   P0[10],P0[11],P0[12],P0[13], pw1[0]=PKW(P0,8), pw1[1]=PKW(P0,10), pw1); \
    GAPA(C1=__builtin_amdgcn_mfma_f32_32x32x16_bf16(kf[3],qr[1],C1,0,0,0),   P0[14],P0[15],P1[0],P1[1],   pw1[2]=PKW(P0,12),pw1[3]=PKW(P0,14), pw1); \
    GAPA(C0=__builtin_amdgcn_mfma_f32_32x32x16_bf16(kf[4],qr[2],C0,0,0,0),   P1[2],P1[3],P1[4],P1[5],     pw2[0]=PKW(P1,0), pw2[1]=PKW(P1,2), pw2); \
    GAPA(C1=__builtin_amdgcn_mfma_f32_32x32x16_bf16(kf[5],qr[2],C1,0,0,0),   P1[6],P1[7],P1[8],P1[9],     pw2[2]=PKW(P1,4), pw2[3]=PKW(P1,6), pw2); \
    GAPA(C0=__builtin_amdgcn_mfma_f32_32x32x16_bf16(kf[6],qr[3],C0,0,0,0),   P1[10],P1[11],P1[12],P1[13], pw3[0]=PKW(P1,8), pw3[1]=PKW(P1,10), pw3); \
    GAPA(C1=__builtin_amdgcn_mfma_f32_32x32x16_bf16(kf[7],qr[3],C1,0,0,0),   P1[14],P1[15],0.f,0.f,       pw3[2]=PKW(P1,12),pw3[3]=PKW(P1,14), pw3); \
    l_reg+=sacc; VRD(0); VRD(4); \
    if(GK){DMA_K((t)+3,sl_cur);} if(GV){DMA_V((t)+1,sl_next);} \
    CMASK(C0,C1,t); \
    { float a=MX3(C0[0],C0[1],C1[0]),b=MX3(C0[2],C0[3],C1[1]); a=MX3(a,C1[2],C1[3]); \
      _Pragma("unroll") for(int r=4;r<16;r+=4){a=MX3(a,C0[r],C0[r+1]);b=MX3(b,C0[r+2],C0[r+3]);a=MX3(a,C1[r],C1[r+1]);b=MX3(b,C1[r+2],C1[r+3]);} \
      float rm=__builtin_fmaxf(a,b); { auto rr=__builtin_amdgcn_permlane32_swap(__float_as_uint(rm),__float_as_uint(rm),false,false); rm=__builtin_fmaxf(__uint_as_float(rr[0]),__uint_as_float(rr[1])); } \
      resc=false; \
      if(__builtin_expect(__any(rm>(float)THRL),0)){ const float dl=__builtin_fmaxf(rm,0.f); mhat+=dl; \
        _Pragma("unroll") for(int r=0;r<16;++r){C0[r]-=dl;C1[r]-=dl;} \
        nmh=-mhat; \
        const float f=__builtin_amdgcn_exp2f(-dl); l_reg*=f; if(hi==0)wsf[r32]=f; resc=true; } } \
    SBAR(); \
    VRD(1); GAPB(o[0]=__builtin_amdgcn_mfma_f32_32x32x16_bf16(PAF(0),VFR(0),o[0],0,0,0), C0,0); \
    VRD(5); GAPB(o[1]=__builtin_amdgcn_mfma_f32_32x32x16_bf16(PAF(0),VFR(4),o[1],0,0,0), C0,4); \
    KRD(GL,0); VRD(2); GAPB(o[0]=__builtin_amdgcn_mfma_f32_32x32x16_bf16(PAF(1),VFR(1),o[0],0,0,0), C0,8); \
    KRD(GL,1); VRD(6); GAPB(o[1]=__builtin_amdgcn_mfma_f32_32x32x16_bf16(PAF(1),VFR(5),o[1],0,0,0), C0,12); \
    KRD(GL,2); VRD(3); GAPB(o[0]=__builtin_amdgcn_mfma_f32_32x32x16_bf16(PAF(2),VFR(2),o[0],0,0,0), C1,0); \
    KRD(GL,3); VRD(7); GAPB(o[1]=__builtin_amdgcn_mfma_f32_32x32x16_bf16(PAF(2),VFR(6),o[1],0,0,0), C1,4); \
    GAPB(o[0]=__builtin_amdgcn_mfma_f32_32x32x16_bf16(PAF(3),VFR(3),o[0],0,0,0), C1,8); \
    GAPB(o[1]=__builtin_amdgcn_mfma_f32_32x32x16_bf16(PAF(3),VFR(7),o[1],0,0,0), C1,12); \
    }while(0)
  int t=1;
  #define ENDW(tt) do{ if((tt)+3<NT){WAIT_BAR(2);} else if((tt)+2<NT){WAIT_BAR(1);} else {WAIT_BAR(0);} }while(0)
  for(;t+1<NT;t+=2){
    STEP(pB0,pB1,pA0,pA1,t,(t+3<NT),(t+1<NT),(t+1<NT));       ENDW(t);   RESC(); ROT();
    STEP(pA0,pA1,pB0,pB1,t+1,(t+4<NT),(t+2<NT),(t+2<NT));     ENDW(t+1); RESC(); ROT();
  }
  STEP(pB0,pB1,pA0,pA1,NT-1,false,false,false); RESC();
  { float sacc=pB0[0]+pB0[1]; _Pragma("unroll") for(int r=2;r<16;++r)sacc+=pB0[r]; _Pragma("unroll") for(int r=0;r<16;++r)sacc+=pB1[r]; l_reg+=sacc;
    pw0=(u32x4){PKW(pB0,0),PKW(pB0,2),PKW(pB0,4),PKW(pB0,6)};pw1=(u32x4){PKW(pB0,8),PKW(pB0,10),PKW(pB0,12),PKW(pB0,14)};pw2=(u32x4){PKW(pB1,0),PKW(pB1,2),PKW(pB1,4),PKW(pB1,6)};pw3=(u32x4){PKW(pB1,8),PKW(pB1,10),PKW(pB1,12),PKW(pB1,14)};
    SBAR(); pv(o,vb0+sl_cur,PAF(0),PAF(1),PAF(2),PAF(3)); }
  #undef PKW
  #undef PAF
  #undef VFR
  #undef PIN
  #undef MX3
  #undef GAPA
  #undef GAPB
  #undef EX
  #undef VRD
  #undef KRD
  #undef STEP
  #undef ENDW
  {auto rr=__builtin_amdgcn_permlane32_swap(__float_as_uint(l_reg),__float_as_uint(l_reg),false,false);l_reg=__uint_as_float(rr[0])+__uint_as_float(rr[1]);}
  if(hi==0)wsf[32+r32]=l_reg;asm volatile("s_waitcnt lgkmcnt(0)":::"memory");
  float rli[16];
  #pragma unroll
  for(int r=0;r<16;++r)rli[r]=__builtin_amdgcn_rcpf(wsf[32+crow(r,hi)]);
  bf16*Ow=O+(rowbase+q0+wid*QBLK)*ODM+h*D;
  { bf16*stg=(bf16*)(shm+LDS_OST)+wid*2048;
    #pragma unroll
    for(int r=0;r<16;++r){const int orow=crow(r,hi);
      #pragma unroll
      for(int d0=0;d0<2;++d0)stg[orow*64+d0*32+r32]=__float2bfloat16(o[d0][r]*rli[r]);}
    asm volatile("s_waitcnt lgkmcnt(0)":::"memory");
    #pragma unroll
    for(int i=0;i<4;++i){const int row=i*8+(lane>>3),ch=lane&7; const u32x4 v=*(const u32x4*)(stg+row*64+ch*8); ATTN_STORE16(Ow+(long)row*ODM+ch*8,v);} }
  asm volatile("s_waitcnt lgkmcnt(0)\n\ts_barrier":::"memory");
  #undef DMA_K
  #undef TA
  #undef CINIT
  #undef CINIT1
  #undef DMA_V
  #undef CMASK
  #undef START
  #undef RESC
  #undef ROT
}
constexpr int ATTN_LDS_BYTES=LDS_END;
#undef SBAR
#undef WAIT_BAR
}
constexpr int NWAVES = 8, NTHREADS = 512;
constexpr int BATCH = 2, T = 8192, D = 1024, FF = 4096, M = BATCH * T, DEPTH = 2;
constexpr int IN_COLS = 3592, NIN = 3840;
constexpr size_t MiB = 1u << 20;
constexpr size_t WS_CTL = 0, CTL_ZERO_BYTES = 1 * MiB;
constexpr size_t WS_SSQ = 64 * 1024;
constexpr size_t WS_LSIG = 512 * 1024;
constexpr size_t WS_WIN = 1 * MiB, WIN_BYTES = (size_t)NIN * D * 2;
constexpr size_t WS_WOUT = 16 * MiB, WS_WUP = 20 * MiB, WS_WDN = 36 * MiB;
constexpr size_t WS_XB = 52 * MiB;
constexpr size_t WS_ST = 84 * MiB;
constexpr size_t WS_HQ = 116 * MiB, WS_LF = 132 * MiB, WS_HV = 164 * MiB, WS_HG = 180 * MiB, WS_Q = 196 * MiB, WS_K = 212 * MiB, WS_V = 228 * MiB, WS_END = 244 * MiB;
constexpr size_t WS_H = 116 * MiB;
constexpr size_t WS_DL = 244 * MiB;
constexpr int LDS_BYTES = 147456;

#define GAS __attribute__((address_space(1)))
#define LAS __attribute__((address_space(3)))
typedef unsigned short bf16;
typedef unsigned v4u __attribute__((ext_vector_type(4)));
typedef float f32x4 __attribute__((ext_vector_type(4)));
typedef float f32x16 __attribute__((ext_vector_type(16)));
typedef short bf16x8 __attribute__((ext_vector_type(8)));
#define LDS_WAIT() asm volatile("s_waitcnt lgkmcnt(0)" ::: "memory")
__device__ __forceinline__ unsigned f2bf(float f) { unsigned u = __builtin_bit_cast(unsigned, f); return (u + 0x7fffu + ((u >> 16) & 1u)) >> 16; }
__device__ __forceinline__ unsigned pk2(float lo, float hi) { return f2bf(lo) | (f2bf(hi) << 16); }
__device__ __forceinline__ float bf2f(unsigned short b) { return __builtin_bit_cast(float, (unsigned)b << 16); }
__device__ __forceinline__ int crow16(int r, int hi) { return (r & 3) + 8 * (r >> 2) + 4 * hi; }

struct Frame {
    LAS unsigned char* lds; int tid, lane, wave, vcu, G;
};
__device__ __forceinline__ float wave_sum(float v) {
#pragma unroll
    for (int o = 1; o < 64; o <<= 1) v += __shfl_xor(v, o);
    return v;
}
__device__ __forceinline__ void p0_transpose_item(const float* W, int pitch, int K, const float* sc, bf16* WT, int dst_row0, int k0, int n0, LAS float* scr, int lane) {
#pragma unroll 8
    for (int i = 0; i < 32; ++i) { const int kk = 2 * i + (lane >> 5); float v = W[(size_t)(k0 + kk) * pitch + n0 + (lane & 31)]; if (sc) v *= sc[k0 + kk]; scr[kk * 33 + (lane & 31)] = v; }
    LDS_WAIT(); asm volatile("" ::: "memory");
    const int c = lane & 7;
#pragma unroll
    for (int j = 0; j < 4; ++j) { const int n = (lane >> 3) + 8 * j; const LAS float* s = scr + (8 * c) * 33 + n;
        v4u o; o.x = pk2(s[0 * 33], s[1 * 33]); o.y = pk2(s[2 * 33], s[3 * 33]); o.z = pk2(s[4 * 33], s[5 * 33]); o.w = pk2(s[6 * 33], s[7 * 33]);
        *(GAS v4u*)(WT + (size_t)(dst_row0 + n) * K + k0 + 8 * c) = o; }
    LDS_WAIT(); asm volatile("" ::: "memory");
}
__device__ __forceinline__ int map_in_row(int n) {
    if (n < 2048 || n >= 3072) return n;
    const int local = n - 2048, tile = local >> 8, o = local & 255, wc = o >> 6, w = o & 63, bj = w >> 5, x = w & 31;
    return 2048 + tile * 256 + bj * 128 + wc * 32 + x;
}
struct Ptrs {
    const float *x, *lower_bounds, *norm1_w, *w_in, *fox_f_bias, *q_norm_w, *k_norm_w, *hgrn_norm_w, *w_out, *norm2_w, *w_up, *w_down;
    float* out; unsigned char* ws;
};
__device__ __forceinline__ void p0_prologue(Frame& F, const Ptrs& P) {
    LAS float* scr = (LAS float*)(F.lds + F.wave * 16384);
    const int gw = F.vcu * NWAVES + F.wave, NGW = F.G * NWAVES;
    constexpr int I_IN = 16 * 112, I_OUT = 16 * 32, I_UP = 16 * 128, I_DN = 64 * 32, I_L = I_IN + I_OUT + I_UP + I_DN;
    for (int it = gw; it < DEPTH * I_L; it += NGW) {
        const int l = it / I_L; int r = it % I_L;
        if (r < I_IN) { const int kb = r / 112, nb = r % 112; p0_transpose_item(P.w_in + (size_t)l * D * IN_COLS, IN_COLS, D, P.norm1_w + l * D, (bf16*)(P.ws + WS_WIN + l * WIN_BYTES), map_in_row(32 * nb), 64 * kb, 32 * nb, scr, F.lane); continue; } r -= I_IN;
        if (r < I_OUT) { const int kb = r / 32, nb = r % 32; p0_transpose_item(P.w_out + (size_t)l * D * D, D, D, nullptr, (bf16*)(P.ws + WS_WOUT + l * 2 * MiB), 32 * nb, 64 * kb, 32 * nb, scr, F.lane); continue; } r -= I_OUT;
        if (r < I_UP) { const int kb = r / 128, nb = r % 128; p0_transpose_item(P.w_up + (size_t)l * D * FF, FF, D, P.norm2_w + l * D, (bf16*)(P.ws + WS_WUP + l * 8 * MiB), 32 * nb, 64 * kb, 32 * nb, scr, F.lane); continue; } r -= I_UP;
        { const int kb = r / 32, nb = r % 32; p0_transpose_item(P.w_down + (size_t)l * FF * D, D, FF, nullptr, (bf16*)(P.ws + WS_WDN + l * 8 * MiB), 32 * nb, 64 * kb, 32 * nb, scr, F.lane); }
    }
    { const int gt = F.vcu * NTHREADS + F.tid;
      for (int e = gt; e < DEPTH * 256 * 128; e += F.G * NTHREADS) { const int l = e >> 15, j = (e >> 7) & 255, kc = e & 127; float v[8];
#pragma unroll
          for (int i = 0; i < 8; ++i) v[i] = (j < 8) ? P.w_in[(size_t)l * D * IN_COLS + (size_t)(8 * kc + i) * IN_COLS + 3584 + j] * P.norm1_w[l * D + 8 * kc + i] : 0.f;
          v4u o; o.x = pk2(v[0], v[1]); o.y = pk2(v[2], v[3]); o.z = pk2(v[4], v[5]); o.w = pk2(v[6], v[7]);
          *(GAS v4u*)((bf16*)(P.ws + WS_WIN + l * WIN_BYTES) + (size_t)(3584 + j) * D + 8 * kc) = o; } }
    bf16* XB = (bf16*)(P.ws + WS_XB); float* ssq = (float*)(P.ws + WS_SSQ);
    for (int m = gw; m < M; m += NGW) { const GAS f32x4* xr = (const GAS f32x4*)(P.x + (size_t)m * D) + F.lane; f32x4 v[4]; float s = 0.f;
#pragma unroll
        for (int j = 0; j < 4; ++j) { v[j] = xr[64 * j]; s += (v[j].x * v[j].x + v[j].y * v[j].y) + (v[j].z * v[j].z + v[j].w * v[j].w); }
        s = wave_sum(s); if (F.lane == 0) ssq[m] = s;
        GAS unsigned long long* o8 = (GAS unsigned long long*)(XB + (size_t)m * D) + F.lane;
#pragma unroll
        for (int j = 0; j < 4; ++j) o8[64 * j] = (unsigned long long)pk2(v[j].x, v[j].y) | ((unsigned long long)pk2(v[j].z, v[j].w) << 32); }
}

constexpr int HC = 64, NCH = T / HC;
constexpr int H_KD = 0, H_QE = 0, H_QM = 17408, H_KM = 34816, H_VT = 52224, H_AM = 70656, H_OS = 79872, H_TOT = 113664, H_BM = 115712;
__device__ __forceinline__ f32x16 mfma32(bf16x8 a, bf16x8 b, f32x16 c) { return __builtin_amdgcn_mfma_f32_32x32x16_bf16(a, b, c, 0, 0, 0); }
#define HBAR() asm volatile("s_waitcnt lgkmcnt(0)\n\ts_barrier" ::: "memory")
#define HGRN_ITEM(it_) const int bh = (it_) >> 7, c = (it_) & 127, b = bh >> 2, h = bh & 3; const int m0 = b * T + c * HC; (void)c; (void)m0;
#define HGRN_LD16F(dst, base) { const float* p_ = (base) + (size_t)(m0 + part * 16) * 512 + h * 128 + k; _Pragma("unroll") for (int i = 0; i < 16; ++i) dst[i] = p_[(size_t)i * 512]; }
#define HGRN_LD16H(dst, base) { const bf16* p_ = (base) + (size_t)(m0 + part * 16) * 512 + h * 128 + k; _Pragma("unroll") for (int i = 0; i < 16; ++i) dst[i] = p_[(size_t)i * 512]; }
#define HGRN_SCAN(lfv, bv, blast)  \
    float bv[16]; float blast; { \
      float run = 0.f; _Pragma("unroll") for (int i = 0; i < 16; ++i) { run += lfv[i]; bv[i] = run; } \
      LAS float* TOT = (LAS float*)(F.lds + H_TOT); TOT[part * 128 + k] = run; HBAR(); \
      const float t0 = TOT[k], t1 = TOT[128 + k], t2 = TOT[256 + k], t3 = TOT[384 + k]; \
      const float off = (part > 0 ? t0 : 0.f) + (part > 1 ? t1 : 0.f) + (part > 2 ? t2 : 0.f); blast = (t0 + t1) + (t2 + t3); \
      _Pragma("unroll") for (int i = 0; i < 16; ++i) bv[i] += off; }
#define HGRN_VT_STORE(vw) { unsigned w_[8]; _Pragma("unroll") for (int i = 0; i < 8; ++i) w_[i] = (unsigned)vw[2 * i] | ((unsigned)vw[2 * i + 1] << 16); \
      LAS v4u* d_ = (LAS v4u*)(F.lds + H_VT + k * 144 + part * 32); d_[0] = (v4u){w_[0], w_[1], w_[2], w_[3]}; d_[1] = (v4u){w_[4], w_[5], w_[6], w_[7]}; }
__device__ __forceinline__ void hgrn_pass_a(Frame& F, const float* lf, const bf16* hv, bf16* ST, float* DL) {
    const int k = F.tid & 127, part = F.tid >> 7, l31 = F.lane & 31, hi = F.lane >> 5;
    float nlf[16]; unsigned short nvw[16];
    if (F.vcu < 8 * NCH) { HGRN_ITEM(F.vcu) HGRN_LD16F(nlf, lf) HGRN_LD16H(nvw, hv) }
    for (int it = F.vcu; it < 8 * NCH; it += F.G) {
        float lfv[16]; unsigned short vw[16];
#pragma unroll
        for (int i = 0; i < 16; ++i) { lfv[i] = nlf[i]; vw[i] = nvw[i]; }
        if (it + F.G < 8 * NCH) { HGRN_ITEM(it + F.G) HGRN_LD16F(nlf, lf) HGRN_LD16H(nvw, hv) }
        HGRN_ITEM(it)
        HGRN_SCAN(lfv, bv, blast)
        { unsigned w_[8];
#pragma unroll
          for (int i = 0; i < 8; ++i) { const float a0 = (1.0f - __expf(lfv[2 * i])) * __expf(blast - bv[2 * i]), a1 = (1.0f - __expf(lfv[2 * i + 1])) * __expf(blast - bv[2 * i + 1]); w_[i] = pk2(a0, a1); }
          LAS v4u* d_ = (LAS v4u*)(F.lds + H_KD + k * 144 + part * 32); d_[0] = (v4u){w_[0], w_[1], w_[2], w_[3]}; d_[1] = (v4u){w_[4], w_[5], w_[6], w_[7]}; }
        if (part == 0) DL[(size_t)it * 128 + k] = __expf(blast);
        HGRN_VT_STORE(vw)
        HBAR();
        const int mt = F.wave >> 1, nt0 = (F.wave & 1) * 2; f32x16 a0 = {}, a1 = {};
#pragma unroll
        for (int ks = 0; ks < 4; ++ks) { const bf16x8 av = *(const LAS bf16x8*)(F.lds + H_VT + (32 * mt + l31) * 144 + (16 * ks + 8 * hi) * 2);
            const bf16x8 b0 = *(const LAS bf16x8*)(F.lds + H_KD + (32 * nt0 + l31) * 144 + (16 * ks + 8 * hi) * 2), b1 = *(const LAS bf16x8*)(F.lds + H_KD + (32 * nt0 + 32 + l31) * 144 + (16 * ks + 8 * hi) * 2);
            a0 = mfma32(av, b0, a0); a1 = mfma32(av, b1, a1); }
        bf16* U = ST + (size_t)it * 16384;
#pragma unroll
        for (int r = 0; r < 16; ++r) { const int v = 32 * mt + crow16(r, hi); U[v * 128 + 32 * nt0 + l31] = (bf16)f2bf(a0[r]); U[v * 128 + 32 * nt0 + 32 + l31] = (bf16)f2bf(a1[r]); }
        HBAR();
    }
}
__device__ __forceinline__ void hgrn_pass_b_item(Frame& F, bf16* ST, const float* DL, int item) {
    int tid_ = F.tid; asm volatile("" : "+v"(tid_));
    const int e = item * NTHREADS + tid_, bh = e >> 14, rem = e & 16383, k = rem & 127;
    bf16* up = ST + (size_t)bh * NCH * 16384 + rem; const float* dp = DL + (size_t)bh * NCH * 128 + k;
    float s = 0.f;
#pragma unroll 1
    for (int c0 = 0; c0 < NCH; c0 += 32) { unsigned short u[32]; float d[32];
#pragma unroll
        for (int j = 0; j < 32; ++j) { u[j] = up[(size_t)(c0 + j) * 16384]; d[j] = dp[(c0 + j) * 128]; }
#pragma unroll
        for (int j = 0; j < 32; ++j) { up[(size_t)(c0 + j) * 16384] = (bf16)f2bf(s); s = d[j] * s + bf2f(u[j]); } }
}
__device__ __forceinline__ void hgrn_pass_c(Frame& F, const bf16* hq, const float* lf, const bf16* hv, const bf16* hg, const bf16* ST, const float* nw, bf16* mix) {
    const int k = F.tid & 127, part = F.tid >> 7, l31 = F.lane & 31, hi = F.lane >> 5;
    const int mt = F.wave >> 2, nt = F.wave & 3; const int t_o = F.tid >> 3, seg_o = F.tid & 7;
#define HGRN_C_LOADS(it_) { HGRN_ITEM(it_) HGRN_LD16F(nlf, lf) HGRN_LD16H(nqw, hq) HGRN_LD16H(nvw, hv) \
      { const bf16* sp = ST + (size_t)(it_) * 16384 + (size_t)(32 * nt + l31) * 128 + 8 * hi; _Pragma("unroll") for (int ks = 0; ks < 8; ++ks) nsf[ks] = *(const bf16x8*)(sp + 16 * ks); } \
      ng0 = *(const v4u*)(hg + (size_t)(m0 + t_o) * 512 + h * 128 + seg_o * 16); ng1 = *(const v4u*)(hg + (size_t)(m0 + t_o) * 512 + h * 128 + seg_o * 16 + 8); }
    float nlf[16]; unsigned short nqw[16], nvw[16]; bf16x8 nsf[8]; v4u ng0, ng1;
    if (F.vcu < 8 * NCH) HGRN_C_LOADS(F.vcu)
    for (int it = F.vcu; it < 8 * NCH; it += F.G) {
        float lfv[16]; unsigned short qw_[16], vw[16]; bf16x8 sfr[8];
#pragma unroll
        for (int i = 0; i < 16; ++i) { lfv[i] = nlf[i]; qw_[i] = nqw[i]; vw[i] = nvw[i]; }
#pragma unroll
        for (int i = 0; i < 8; ++i) sfr[i] = nsf[i];
        const v4u g0 = ng0, g1 = ng1;
        if (it + F.G < 8 * NCH) HGRN_C_LOADS(it + F.G)
        HGRN_ITEM(it)
        HGRN_SCAN(lfv, bv, blast)
        (void)blast;
        LAS float* BMID = (LAS float*)(F.lds + H_BM);
        if (part == 1) BMID[k] = bv[15];
        HBAR();
        const float bm = BMID[k];
        {
#pragma unroll
          for (int i = 0; i < 16; ++i) { const int t = part * 16 + i; const float q = bf2f(qw_[i]);
              *(LAS bf16*)(F.lds + H_QE + t * 272 + k * 2) = (bf16)f2bf(q * __expf(bv[i]));
              *(LAS bf16*)(F.lds + H_QM + t * 272 + k * 2) = (bf16)f2bf(q * __expf(fminf(bv[i] - bm, 80.f)));
              *(LAS bf16*)(F.lds + H_KM + t * 272 + k * 2) = (bf16)f2bf((1.0f - __expf(lfv[i])) * __expf(fminf(bm - bv[i], 80.f))); } }
        HGRN_VT_STORE(vw)
        HBAR();
        f32x16 acc = {};
        {
#pragma unroll
          for (int ks = 0; ks < 8; ++ks) { const bf16x8 av = *(const LAS bf16x8*)(F.lds + H_QE + (32 * mt + l31) * 272 + (16 * ks + 8 * hi) * 2); acc = mfma32(av, sfr[ks], acc); } }
        if (F.wave < 4) { const int mt2 = F.wave >> 1, nt2 = F.wave & 1; f32x16 am = {};
#pragma unroll
            for (int ks = 0; ks < 8; ++ks) { const bf16x8 av = *(const LAS bf16x8*)(F.lds + H_QM + (32 * mt2 + l31) * 272 + (16 * ks + 8 * hi) * 2), bvv = *(const LAS bf16x8*)(F.lds + H_KM + (32 * nt2 + l31) * 272 + (16 * ks + 8 * hi) * 2); am = mfma32(av, bvv, am); }
#pragma unroll
            for (int r = 0; r < 16; ++r) { const int t = 32 * mt2 + crow16(r, hi), s = 32 * nt2 + l31; *(LAS bf16*)(F.lds + H_AM + t * 144 + s * 2) = (bf16)f2bf(s <= t ? am[r] : 0.f); } }
        HBAR();
#pragma unroll
        for (int ks = 0; ks < 4; ++ks) { const bf16x8 av = *(const LAS bf16x8*)(F.lds + H_AM + (32 * mt + l31) * 144 + (16 * ks + 8 * hi) * 2), bvv = *(const LAS bf16x8*)(F.lds + H_VT + (32 * nt + l31) * 144 + (16 * ks + 8 * hi) * 2); acc = mfma32(av, bvv, acc); }
#pragma unroll
        for (int r = 0; r < 16; ++r) *(LAS float*)(F.lds + H_OS + (32 * mt + crow16(r, hi)) * 528 + (32 * nt + l31) * 4) = acc[r];
        HBAR();
        { const int t = t_o, seg = seg_o; f32x4 o[4]; float ss = 0.f;
#pragma unroll
          for (int j = 0; j < 4; ++j) { o[j] = *(const LAS f32x4*)(F.lds + H_OS + t * 528 + (seg * 16 + 4 * j) * 4); ss += (o[j][0] * o[j][0] + o[j][1] * o[j][1]) + (o[j][2] * o[j][2] + o[j][3] * o[j][3]); }
          ss += __shfl_xor(ss, 1); ss += __shfl_xor(ss, 2); ss += __shfl_xor(ss, 4);
          const float rs = rsqrtf(ss * (1.0f / 128.0f) + 1e-6f);
          const unsigned gw_[8] = {g0.x, g0.y, g0.z, g0.w, g1.x, g1.y, g1.z, g1.w}; unsigned w_[8];
#pragma unroll
          for (int j = 0; j < 4; ++j) { const f32x4 wv = *(const f32x4*)(nw + seg * 16 + 4 * j);
              const float e0 = o[j][0] * rs * wv[0] * bf2f((unsigned short)(gw_[2 * j] & 0xffffu)), e1 = o[j][1] * rs * wv[1] * bf2f((unsigned short)(gw_[2 * j] >> 16));
              const float e2 = o[j][2] * rs * wv[2] * bf2f((unsigned short)(gw_[2 * j + 1] & 0xffffu)), e3 = o[j][3] * rs * wv[3] * bf2f((unsigned short)(gw_[2 * j + 1] >> 16));
              w_[2 * j] = pk2(e0, e1); w_[2 * j + 1] = pk2(e2, e3); }
          v4u* op = (v4u*)(mix + (size_t)(m0 + t) * 1024 + h * 128 + seg * 16); op[0] = (v4u){w_[0], w_[1], w_[2], w_[3]}; op[1] = (v4u){w_[4], w_[5], w_[6], w_[7]}; }
        HBAR();
    }
#undef HGRN_C_LOADS
}
#ifndef REP_MASK
#define REP_MASK 0
#endif
#define RLX_AGENT __ATOMIC_RELAXED, __HIP_MEMORY_SCOPE_AGENT
#define XB_TMO      128
#define XB_XCNT(j)  (256  + 64 * (j))
#define XB_XSUB(j)  (1280 + 64 * (j))
#define XB_XGEN(j)  (2304 + 64 * (j))
#define XB_TOP      3328
#define XB_TOPGEN   3392
#define XCD_BAR_WORDS 3456
#define XB_SPIN_CAP (1u << 18)

__device__ __forceinline__ unsigned xb_ld(unsigned* p)              { return __hip_atomic_load(p, __ATOMIC_RELAXED, __HIP_MEMORY_SCOPE_AGENT); }
__device__ __forceinline__ unsigned xb_add(unsigned* p, unsigned v) { return __hip_atomic_fetch_add(p, v, __ATOMIC_RELAXED, __HIP_MEMORY_SCOPE_AGENT); }
__device__ __forceinline__ unsigned xb_xcc_id() { return (unsigned)__builtin_amdgcn_s_getreg((3 << 11) | 20) & 0xFu; }
#define XB_SPIN(cond, bar) do { unsigned _sp = 0; while (cond) { __builtin_amdgcn_s_sleep(1); \
    if ((++_sp & 255u) == 0u) { if (xb_ld(&(bar)[XB_TMO])) break; if (_sp > XB_SPIN_CAP) { atomicAdd(&(bar)[XB_TMO], 1u); break; } } } } while (0)

struct XcdBarrier {
    unsigned* bar; unsigned x;
    volatile LAS unsigned* st;
};

__device__ __forceinline__ XcdBarrier xcd_barrier_post(unsigned* bar, volatile LAS unsigned* st) {
    XcdBarrier b; b.bar = bar; b.x = xb_xcc_id(); b.st = st;
    if (threadIdx.x == 0) (void)xb_add(&bar[XB_XCNT(b.x)], 1u);
    return b;
}
__device__ __forceinline__ void xcd_barrier_complete(unsigned* bar, unsigned x, unsigned& nloc, unsigned& nx) {
    const unsigned G = gridDim.x * gridDim.y * gridDim.z;
    unsigned sum, cnt, mine, sp = 0u;
    for (;;) {
        sum = 0u; cnt = 0u; mine = 0u;
#pragma unroll
        for (unsigned j = 0; j < 16; ++j) { const unsigned c = xb_ld(&bar[XB_XCNT(j)]); sum += c; cnt += (c > 0u) ? 1u : 0u; mine = (j == x) ? c : mine; }
        if (sum == G) break;
        __builtin_amdgcn_s_sleep(1);
        if ((++sp & 255u) == 0u) { if (xb_ld(&bar[XB_TMO])) break; if (sp > XB_SPIN_CAP) { atomicAdd(&bar[XB_TMO], 1u); break; } }
    }
    nloc = mine > 0u ? mine : 1u; nx = cnt > 0u ? cnt : 1u;
}

__device__ __forceinline__ void xcd_barrier(const XcdBarrier& b) {
    asm volatile("s_waitcnt vmcnt(0)" ::: "memory");
    __syncthreads();
    if (threadIdx.x == 0) {
        unsigned* bar = b.bar;
        __builtin_amdgcn_s_waitcnt(0);
        unsigned nloc = b.st[0], nx = b.st[1];
        if (nloc == 0u) { xcd_barrier_complete(bar, b.x, nloc, nx); b.st[0] = nloc; b.st[1] = nx; }
        const unsigned old = xb_add(&bar[XB_XSUB(b.x)], 1u);
        const unsigned gen = old / nloc;
        if (old + 1u == (gen + 1u) * nloc) {
            __builtin_amdgcn_fence(__ATOMIC_RELEASE, "agent");
            asm volatile("s_waitcnt vmcnt(0)" ::: "memory");
            const unsigned og = xb_add(&bar[XB_TOP], 1u);
            const unsigned tg = og / nx;
            if (og + 1u == (tg + 1u) * nx) xb_add(&bar[XB_TOPGEN], 1u);
            else XB_SPIN(xb_ld(&bar[XB_TOPGEN]) == tg, bar);
            __builtin_amdgcn_fence(__ATOMIC_ACQUIRE, "agent");
            xb_add(&bar[XB_XGEN(b.x)], 1u);
            asm volatile("s_waitcnt vmcnt(0)" ::: "memory");
        } else {
            XB_SPIN(xb_ld(&bar[XB_XGEN(b.x)]) == gen, bar);
            __builtin_amdgcn_fence(__ATOMIC_ACQUIRE, "agent");
            asm volatile("s_waitcnt vmcnt(0)" ::: "memory");
        }
    }
    __syncthreads();
}

#ifndef FOX_SKIP
#define FOX_SKIP 1
#endif
__device__ __forceinline__ void fox_scan(Frame& F, const float* lsig, float* DKG) {
    LAS double* wtot = (LAS double*)(F.lds + attn_body::LDS_WS);
    for (int bh = F.vcu; bh < 16; bh += F.G) {
        const int b = bh >> 3, h = bh & 7;
        const float* lp = lsig + ((size_t)b * T + F.tid * 16) * 8 + h; double v[16]; double run = 0.0;
#pragma unroll
        for (int i = 0; i < 16; ++i) { run -= (double)lp[i * 8]; v[i] = run; }
        double inc = run;
#pragma unroll
        for (int o = 1; o < 64; o <<= 1) { const double t = __shfl_up(inc, o); if (F.lane >= o) inc += t; }
        if (F.lane == 63) wtot[F.wave] = inc;
        __syncthreads();
        double off = inc - run;
        for (int w = 0; w < F.wave; ++w) off += wtot[w];
        f32x4* dst = (f32x4*)(DKG + (size_t)bh * T + F.tid * 16);
#pragma unroll
        for (int i = 0; i < 4; ++i) dst[i] = (f32x4){(float)((v[4 * i] + off) * 1.4426950408889634), (float)((v[4 * i + 1] + off) * 1.4426950408889634), (float)((v[4 * i + 2] + off) * 1.4426950408889634), (float)((v[4 * i + 3] + off) * 1.4426950408889634)};
        __syncthreads();
    }
}
__device__ __forceinline__ void fox_queue_phase(Frame& F, unsigned char* lds_generic, unsigned* queue, const float* fbias, const float* DKG, const bf16* Q, const bf16* Kb, const bf16* V, bf16* mix, bf16* ST, const float* DL) {
    using attn_body::LDS_DK; using attn_body::attn_unit;
    LAS float* dk = (LAS float*)(F.lds + LDS_DK);
    volatile LAS int* qslot = (volatile LAS int*)(F.lds + 131072 + 128);
    if (F.tid == 0) qslot[0] = (int)__hip_atomic_fetch_add(queue, 1u, __ATOMIC_RELAXED, __HIP_MEMORY_SCOPE_AGENT);
    __syncthreads();
    for (;;) {
        const int u = qslot[0];
        if (u >= 768) break;
        int nxt = 0;
        if (F.tid == 0) nxt = (int)__hip_atomic_fetch_add(queue, 1u, __ATOMIC_RELAXED, __HIP_MEMORY_SCOPE_AGENT);
        if (u < 512) {
            const int r = u >> 6, b = (u >> 5) & 1, qb = 31 - (u & 31);
            int h = 0;
            { float bs[8];
#pragma unroll
              for (int i = 0; i < 8; ++i) bs[i] = fbias[i];
#pragma unroll
              for (int i = 0; i < 8; ++i) { int rk = 0;
#pragma unroll
                  for (int j = 0; j < 8; ++j) rk += (bs[j] > bs[i] || (bs[j] == bs[i] && j < i)) ? 1 : 0;
                  if (rk == r) h = i; } }
            const int bh = b * 8 + h, npos = 256 * (qb + 1);
            { int tid_ = F.tid; asm volatile("" : "+v"(tid_));
              if (tid_ * 16 < npos) { const f32x4* src = (const f32x4*)(DKG + (size_t)bh * T + tid_ * 16); LAS f32x4* dst = (LAS f32x4*)(dk + tid_ * 16);
#pragma unroll
                  for (int i = 0; i < 4; ++i) dst[i] = src[i]; } }
            __syncthreads();
            const int NTA = 4 * qb + 4; int NT = NTA;
#if FOX_SKIP
            { const float ref = dk[qb * 256]; int lo = 0, hi_ = NTA - 4;
              while (lo < hi_) { const int mid = (lo + hi_) >> 1; if (dk[64 * mid + 63] - ref < -200.0f) lo = mid + 1; else hi_ = mid; }
              int nold = (NTA - 4) - lo; nold += (nold & 1); NT = 4 + nold; }
#endif
            attn_unit<8>(b, h, qb, NT, (const attn_body::bf16*)Q, (const attn_body::bf16*)Kb, (const attn_body::bf16*)V, (attn_body::bf16*)(mix + 512), (char*)lds_generic);
        } else {
            hgrn_pass_b_item(F, ST, DL, u - 512);
        }
        __syncthreads();
        if (F.tid == 0) qslot[0] = nxt;
        __syncthreads();
    }
}

struct Args { Ptrs p; int ph_lo, ph_hi; };
constexpr int N_PHASES = 1 + 7 * DEPTH;
__global__ void __launch_bounds__(NTHREADS, 2) hymba_fwd(Args args) {
    extern __shared__ __attribute__((aligned(16))) unsigned char lds[];
    Frame F; F.lds = (LAS unsigned char*)lds; F.tid = threadIdx.x; F.lane = F.tid & 63; F.wave = __builtin_amdgcn_readfirstlane(F.tid >> 6);
    F.G = gridDim.x; { const int bx = blockIdx.x; F.vcu = (F.G % 8 == 0) ? (bx % 8) * (F.G / 8) + bx / 8 : bx; }
    const Ptrs& P = args.p;
    const int lo = args.ph_lo, hi = args.ph_hi;
    volatile LAS unsigned* bst = (volatile LAS unsigned*)(F.lds + 131072 + 64);
    if (F.tid < 2) bst[F.tid] = 0u;
    __syncthreads();
    XcdBarrier bar; bar.bar = (unsigned*)(P.ws + WS_CTL + 16384); bar.x = 0; bar.st = bst;
    if (hi - lo > 1) bar = xcd_barrier_post((unsigned*)(P.ws + WS_CTL + 16384), bst);
#define PHASE_ENV() int t__ = threadIdx.x; asm volatile("" : "+v"(t__)); F.tid = t__; F.lane = t__ & 63; unsigned char* ws = P.ws; asm volatile("" : "+s"(ws)); \
    float* ssq = (float*)(ws + WS_SSQ); float* lsig = (float*)(ws + WS_LSIG); \
    bf16* XB = (bf16*)(ws + WS_XB); bf16* ST = (bf16*)(ws + WS_ST); float* DL = (float*)(ws + WS_DL); float* DKG = (float*)(ws + WS_DL + 512 * 1024); (void)DKG; \
    bf16* HQ = (bf16*)(ws + WS_HQ); float* LF = (float*)(ws + WS_LF); bf16* HV = (bf16*)(ws + WS_HV); bf16* HG = (bf16*)(ws + WS_HG); \
    bf16* Qb = (bf16*)(ws + WS_Q); bf16* Kb = (bf16*)(ws + WS_K); bf16* Vb = (bf16*)(ws + WS_V); bf16* HB = (bf16*)(ws + WS_H); \
    (void)ssq; (void)lsig; (void)XB; (void)ST; (void)DL; (void)HQ; (void)LF; (void)HV; (void)HG; (void)Qb; (void)Kb; (void)Vb; (void)HB;
#define IN(k) (lo <= (k) && (k) < hi)
#define SEAM(k) do { if (IN(k) && IN((k) + 1)) { if (lo == -12345) cg::this_grid().sync(); else { xcd_barrier(bar); if (REP_MASK & 64) { xcd_barrier(bar); xcd_barrier(bar); } } } } while (0)
    if (IN(0)) { PHASE_ENV() p0_prologue(F, P); if (REP_MASK & 1) { __syncthreads(); p0_prologue(F, P); } }
    SEAM(0);
#pragma unroll 1
    for (int l = 0; l < DEPTH; ++l) {
        const int pb = 1 + 7 * l;
        if (IN(pb)) { PHASE_ENV()
            pg8::Gemm g{l == 0 ? XB : (const bf16*)P.out, (const bf16*)(ws + WS_WIN + l * WIN_BYTES), M, NIN, D}; pg8::StaticOrder S; S.init(M, NIN, F.G, (int)blockIdx.x);
            pg8::EpiIn E{ssq + (size_t)(2 * l) * M, HQ, HV, HG, Qb, Kb, Vb, LF, lsig, P.lower_bounds, P.lower_bounds + 512, l, P.q_norm_w + l * 64, P.k_norm_w + l * 64, P.fox_f_bias + l * 8};
            pg8::gemm_phase<pg8::EpiIn, pg8::StaticOrder, true, true>(F.lds, g, S, E);
            if (REP_MASK & 2) pg8::gemm_phase<pg8::EpiIn, pg8::StaticOrder, true, true>(F.lds, g, S, E);
        }
        SEAM(pb);
        if (IN(pb + 1)) { PHASE_ENV()
            fox_scan(F, lsig, DKG);
            hgrn_pass_a(F, LF, HV, ST, DL);
            if (REP_MASK & 8) hgrn_pass_a(F, LF, HV, ST, DL);
        }
        SEAM(pb + 1);
        if (IN(pb + 2)) { PHASE_ENV()
            fox_queue_phase(F, lds, (unsigned*)(ws + WS_CTL + 40960) + 64 * l, P.fox_f_bias + l * 8, DKG, Qb, Kb, Vb, XB, ST, DL);
        }
        SEAM(pb + 2);
        if (IN(pb + 3)) { PHASE_ENV() hgrn_pass_c(F, HQ, LF, HV, HG, ST, P.hgrn_norm_w + l * 128, XB); if (REP_MASK & 16) hgrn_pass_c(F, HQ, LF, HV, HG, ST, P.hgrn_norm_w + l * 128, XB); }
        SEAM(pb + 3);
        if (IN(pb + 4)) { PHASE_ENV()
            pg8::Gemm g{XB, (const bf16*)(ws + WS_WOUT + l * 2 * MiB), M, D, D}; pg8::StaticOrder S; S.init(M, D, F.G, (int)blockIdx.x);
            bf16* X2 = (bf16*)P.out;
            pg8::EpiRes E{l == 0 ? P.x : nullptr, l == 0 ? nullptr : X2, nullptr, ST, ssq + (size_t)(2 * l + 1) * M};
            pg8::gemm_phase<pg8::EpiRes, pg8::StaticOrder, true, true>(F.lds, g, S, E);
        }
        SEAM(pb + 4);
        if (IN(pb + 5)) { PHASE_ENV()
            pg8::Gemm g{ST, (const bf16*)(ws + WS_WUP + l * 8 * MiB), M, FF, D}; pg8::StaticOrder S; S.init(M, FF, F.G, (int)blockIdx.x);
            pg8::EpiUp E{ssq + (size_t)(2 * l + 1) * M, HB};
            pg8::gemm_phase<pg8::EpiUp, pg8::StaticOrder, true, true>(F.lds, g, S, E);
            if (REP_MASK & 32) pg8::gemm_phase<pg8::EpiUp, pg8::StaticOrder, true, true>(F.lds, g, S, E);
        }
        SEAM(pb + 5);
        if (IN(pb + 6)) { PHASE_ENV()
            pg8::Gemm g{HB, (const bf16*)(ws + WS_WDN + l * 8 * MiB), M, D, FF}; pg8::StaticOrder S; S.init(M, D, F.G, (int)blockIdx.x);
            const bool last = (l == DEPTH - 1);
            pg8::EpiRes E{nullptr, ST, last ? P.out : nullptr, last ? nullptr : (bf16*)P.out, last ? nullptr : ssq + (size_t)(2 * l + 2) * M};
            pg8::gemm_phase<pg8::EpiRes, pg8::StaticOrder, true, true>(F.lds, g, S, E);
        }
        SEAM(pb + 6);
    }
#undef IN
#undef SEAM
}

#ifndef MK_PER_PHASE
#define MK_PER_PHASE 0
#endif
extern "C" void kernel_launch(void* const* d_in, const int* in_sizes, int n_in, void* d_out, int out_size, void* d_ws, size_t ws_size, hipStream_t stream) {
    static int grid = 0;
    if (grid == 0) {
        if (n_in != 12 || out_size != M * D || ws_size < WS_DL + MiB) { fprintf(stderr, "kernel_launch: unexpected sizes (n_in %d out %d ws %zu)\n", n_in, out_size, ws_size); grid = -1; return; }
        int dev = 0, cus = 0, per_cu = 0;
        (void)hipGetDevice(&dev); (void)hipDeviceGetAttribute(&cus, hipDeviceAttributeMultiprocessorCount, dev);
        if (hipFuncSetAttribute((const void*)hymba_fwd, hipFuncAttributeMaxDynamicSharedMemorySize, LDS_BYTES) != hipSuccess) { fprintf(stderr, "kernel_launch: hipFuncSetAttribute failed\n"); grid = -1; return; }
        if (hipOccupancyMaxActiveBlocksPerMultiprocessor(&per_cu, (const void*)hymba_fwd, NTHREADS, LDS_BYTES) != hipSuccess || per_cu < 1) { fprintf(stderr, "kernel_launch: occupancy query gave %d\n", per_cu); per_cu = 1; }
        (void)hipGetLastError();
        grid = cus * 1;
        fprintf(stderr, "kernel_launch: cus %d per_cu %d grid %d\n", cus, per_cu, grid);
    }
    if (grid < 0) return;
    (void)hipMemsetAsync((char*)d_ws + WS_CTL, 0, CTL_ZERO_BYTES, stream);
    Args a{};
    a.p.x = (const float*)d_in[0]; a.p.lower_bounds = (const float*)d_in[1]; a.p.norm1_w = (const float*)d_in[2]; a.p.w_in = (const float*)d_in[3];
    a.p.fox_f_bias = (const float*)d_in[4]; a.p.q_norm_w = (const float*)d_in[5]; a.p.k_norm_w = (const float*)d_in[6]; a.p.hgrn_norm_w = (const float*)d_in[7];
    a.p.w_out = (const float*)d_in[8]; a.p.norm2_w = (const float*)d_in[9]; a.p.w_up = (const float*)d_in[10]; a.p.w_down = (const float*)d_in[11];
    a.p.out = (float*)d_out; a.p.ws = (unsigned char*)d_ws;
#if MK_PER_PHASE
    for (int ph = 0; ph < N_PHASES; ++ph) { a.ph_lo = ph; a.ph_hi = ph + 1; hipLaunchKernelGGL(hymba_fwd, dim3(grid), dim3(NTHREADS), LDS_BYTES, stream, a); }
#else
    a.ph_lo = 0; a.ph_hi = N_PHASES;
    void* kargs[] = {&a};
    const hipError_t e = hipLaunchCooperativeKernel((const void*)hymba_fwd, dim3(grid), dim3(NTHREADS), kargs, LDS_BYTES, stream);
    if (e != hipSuccess) fprintf(stderr, "kernel_launch: cooperative launch failed: %s (grid %d)\n", hipGetErrorString(e), grid);
#endif
}
```

```cpp
#include <hip/hip_runtime.h>
#include <hip/hip_cooperative_groups.h>
#include <cstdio>
#include <cstdint>
namespace cg = cooperative_groups;
namespace pg8 {
#define PG8_LAS __attribute__((address_space(3)))
typedef unsigned short bf16_t;
typedef short bf16x8 __attribute__((ext_vector_type(8)));
typedef float f32x4 __attribute__((ext_vector_type(4)));
typedef unsigned u32x4 __attribute__((ext_vector_type(4)));
constexpr int BM = 256, BK = 64, HALF = 128, HTB = HALF * BK * 2  , STAGE_BYTES = 8 * HTB, NXCD = 8, WGM = 8;

__host__ __device__ __forceinline__ int lds_byte(int r, int c) { const int st = (r >> 4) * 2 + (c >> 5), rr = r & 15, cc = c & 31, ob = rr * 64 + cc * 2; return st * 1024 + (ob ^ (((ob >> 9) & 1) << 5)); }
__host__ __device__ __forceinline__ void stage_rc(int b, int& R, int& C) { const int st = b / 1024, sb = b % 1024, swz = sb ^ (((sb >> 9) & 1) << 5); R = (st >> 1) * 16 + swz / 64; C = (st & 1) * 32 + (swz % 64) / 2; }
__host__ __device__ __forceinline__ int perm32(int rho) { const int n = rho >> 4, i = rho & 15; return 8 * (i >> 2) + 4 * n + (i & 3); }

struct Unit { int pm, pn; };
struct Gemm { const bf16_t* A; const bf16_t* Bt; int M, N, K; };

struct StaticOrder {
    int nM, nN, nwg, G, c;
    __host__ __device__ void init(int M, int N, int G_, int c_) { nM = M / BM; nN = N / BM; nwg = nM * nN; G = G_; c = c_; }
    __host__ __device__ bool next(int i, Unit& u) const {
        const long L = (long)i * G + c; if (L >= nwg) return false;
        int wgid = (int)L; { const int q = nwg / NXCD, r = nwg % NXCD, xcd = wgid % NXCD, off = wgid / NXCD; wgid = (xcd < r ? xcd * (q + 1) : r * (q + 1) + (xcd - r) * q) + off; }
        const int nig = WGM * nN, gid = wgid / nig, fm = gid * WGM, gsz = (nM - fm) < WGM ? (nM - fm) : WGM;
        u.pm = fm + ((wgid % nig) % gsz); u.pn = (wgid % nig) / gsz; return true;
    }
    __device__ __forceinline__ void a_ready(const Unit&) const {}
    __device__ __forceinline__ void done(const Unit&) const {}
};

__device__ __forceinline__ unsigned cvt_pk_bf16(float lo, float hi) { unsigned r; asm volatile("v_cvt_pk_bf16_f32 %0, %1, %2" : "=v"(r) : "v"(lo), "v"(hi)); return r; }
typedef float f32x2 __attribute__((ext_vector_type(2)));
template <class Epi, class Sched, bool ALIGN_EPI = false, bool SP2 = false, bool PROBE_EPI = false>
__device__ __forceinline__ void gemm_phase(PG8_LAS unsigned char* lds, const Gemm g, const Sched& S, const Epi& E, unsigned long long& eacc) {
    int tid_o = threadIdx.x; asm volatile("" : "+v"(tid_o));
    const int tid = tid_o, wid = __builtin_amdgcn_readfirstlane(tid >> 6), lane = tid & 63, wr = wid >> 2, wc = wid & 3, fr = lane & 15, fq = lane >> 4;
    const int K = g.K, nt = K / BK;
    unsigned voffA[2], voffB[2];
#pragma unroll
    for (int i = 0; i < 2; ++i) { int R, C; stage_rc(tid * 16 + i * 8192, R, C); const int Rb = Epi::PERM ? ((R & ~31) + perm32(R & 31)) : R;
        voffA[i] = (unsigned)(R * K + C) * 2u; voffB[i] = (unsigned)(Rb * K + C) * 2u; }
    const size_t kstep = (size_t)(BK * 2);
    const size_t hstep = (size_t)HALF * K * 2;
    const size_t tstep = 2 * hstep;
    const unsigned ldsw = (unsigned)wid * 1024u;
    const int aoff = lds_byte(wr * 64 + fr, fq * 8), boff = lds_byte(wc * 32 + fr, fq * 8);
#define PG8_SA(b, h) (((b) * 2 + (h)) * HTB)
#define PG8_SB(b, h) ((4 + (b) * 2 + (h)) * HTB)
#define PG8_STAGE(bufoff, gbase, voff) do { _Pragma("unroll") for (int _i = 0; _i < 2; ++_i) \
        __builtin_amdgcn_global_load_lds((const unsigned*)((const char*)(gbase) + (voff)[_i]), (PG8_LAS unsigned*)(lds + (bufoff) + ldsw + _i * 8192), 16, 0, 0); } while (0)
#define PG8_LDA(dst, b, h) do { _Pragma("unroll") for (int m = 0; m < 4; ++m) _Pragma("unroll") for (int k = 0; k < 2; ++k) dst[m][k] = *(const PG8_LAS bf16x8*)(lds + PG8_SA(b, h) + aoff + m * 2048 + k * 1024); } while (0)
#define PG8_LDB(dst, b, h) do { _Pragma("unroll") for (int n = 0; n < 2; ++n) _Pragma("unroll") for (int k = 0; k < 2; ++k) dst[n][k] = *(const PG8_LAS bf16x8*)(lds + PG8_SB(b, h) + boff + n * 2048 + k * 1024); } while (0)
#define PG8_MMA(ai, bj, At, Bt) do { __builtin_amdgcn_s_setprio(1); _Pragma("unroll") for (int m = 0; m < 4; ++m) _Pragma("unroll") for (int n = 0; n < 2; ++n) _Pragma("unroll") for (int k = 0; k < 2; ++k) \
        acc[ai][bj][m][n] = __builtin_amdgcn_mfma_f32_16x16x32_bf16(Bt[n][k], At[m][k], acc[ai][bj][m][n], 0, 0, 0); __builtin_amdgcn_s_setprio(0); } while (0)
#define PG8_WAIT_V(n) asm volatile("s_waitcnt vmcnt(" #n ")" ::: "memory")
#define PG8_WAIT_L(n) asm volatile("s_waitcnt lgkmcnt(" #n ")" ::: "memory")
#define PG8_BAR __builtin_amdgcn_s_barrier()
#define PG8_SCHED __builtin_amdgcn_sched_barrier(0)
    Unit cur, nxt; int ui = 0;
    if (!S.next(0, cur)) return;
    f32x4 acc[2][2][4][2];
#pragma unroll
    for (int a = 0; a < 2; ++a)
#pragma unroll
        for (int b = 0; b < 2; ++b)
#pragma unroll
            for (int m = 0; m < 4; ++m)
#pragma unroll
                for (int n = 0; n < 2; ++n) acc[a][b][m][n] = (f32x4){0.f, 0.f, 0.f, 0.f};
    bf16x8 At[4][2], B0[2][2], B1[2][2];
    const char* cA = (const char*)g.A + (size_t)cur.pm * tstep; const char* cB = (const char*)g.Bt + (size_t)cur.pn * tstep;
    S.a_ready(cur);
    if constexpr (SP2) {
        PG8_STAGE(PG8_SB(0, 0), cB, voffB); PG8_STAGE(PG8_SB(0, 1), cB + hstep, voffB); PG8_STAGE(PG8_SA(0, 0), cA, voffA); PG8_STAGE(PG8_SA(0, 1), cA + hstep, voffA);
        if (wr == 1) PG8_BAR;
        PG8_WAIT_V(2); PG8_BAR;
        PG8_STAGE(PG8_SB(1, 0), cB + kstep, voffB); PG8_STAGE(PG8_SA(1, 0), cA + kstep, voffA); PG8_STAGE(PG8_SB(1, 1), cB + hstep + kstep, voffB);
        PG8_WAIT_V(6); PG8_BAR;
    } else {
        PG8_STAGE(PG8_SB(0, 0), cB, voffB); PG8_STAGE(PG8_SA(0, 0), cA, voffA); PG8_STAGE(PG8_SB(0, 1), cB + hstep, voffB); PG8_STAGE(PG8_SA(0, 1), cA + hstep, voffA);
        if (wr == 1) PG8_BAR;
        PG8_WAIT_V(4); PG8_BAR;
        PG8_STAGE(PG8_SB(1, 0), cB + kstep, voffB); PG8_STAGE(PG8_SA(1, 0), cA + kstep, voffA); PG8_STAGE(PG8_SB(1, 1), cB + hstep + kstep, voffB);
        PG8_WAIT_V(6); PG8_BAR;
    }
    for (;;) {
        const bool has_next = S.next(ui + 1, nxt);
        const char* nA = has_next ? (const char*)g.A + (size_t)nxt.pm * tstep : cA; const char* nB = has_next ? (const char*)g.Bt + (size_t)nxt.pn * tstep : cB;
        for (int t = 0; t < nt; t += 2) {
            const bool last = (t == nt - 2);
            const char* a1 = cA + (size_t)(t + 1) * kstep;
            const char* a2 = last ? nA : cA + (size_t)(t + 2) * kstep; const char* b2 = last ? nB : cB + (size_t)(t + 2) * kstep;
            const char* a3 = a2 + kstep; const char* b3 = b2 + kstep;
            if (last && has_next) S.a_ready(nxt);
            if constexpr (SP2) {
            PG8_LDB(B0, 0, 0); PG8_LDB(B1, 0, 1); PG8_SCHED; PG8_LDA(At, 0, 0); PG8_STAGE(PG8_SA(1, 1), a1 + hstep, voffA);
            PG8_WAIT_V(8); PG8_WAIT_L(0); PG8_BAR; PG8_MMA(0, 0, At, B0); PG8_MMA(0, 1, At, B1); PG8_BAR; PG8_SCHED;
            PG8_LDA(At, 0, 1); PG8_STAGE(PG8_SB(0, 0), b2, voffB); PG8_STAGE(PG8_SB(0, 1), b2 + hstep, voffB); PG8_STAGE(PG8_SA(0, 0), a2, voffA);
            PG8_WAIT_V(8); PG8_WAIT_L(0); PG8_BAR; PG8_MMA(1, 0, At, B0); PG8_MMA(1, 1, At, B1); PG8_BAR; PG8_SCHED;
            PG8_LDB(B0, 1, 0); PG8_LDB(B1, 1, 1); PG8_SCHED; PG8_LDA(At, 1, 0); PG8_STAGE(PG8_SA(0, 1), a2 + hstep, voffA);
            PG8_WAIT_V(8); PG8_WAIT_L(0); PG8_BAR; PG8_MMA(0, 0, At, B0); PG8_MMA(0, 1, At, B1); PG8_BAR; PG8_SCHED;
            PG8_LDA(At, 1, 1); PG8_STAGE(PG8_SB(1, 0), b3, voffB); PG8_STAGE(PG8_SB(1, 1), b3 + hstep, voffB); PG8_STAGE(PG8_SA(1, 0), a3, voffA);
            PG8_WAIT_V(8); PG8_WAIT_L(0); PG8_BAR; PG8_MMA(1, 0, At, B0); PG8_MMA(1, 1, At, B1); PG8_BAR; PG8_SCHED;
            } else {
            PG8_LDB(B0, 0, 0); PG8_SCHED; PG8_LDA(At, 0, 0); PG8_STAGE(PG8_SA(1, 1), a1 + hstep, voffA);
            PG8_WAIT_L(8); PG8_BAR; PG8_WAIT_L(0); PG8_MMA(0, 0, At, B0); PG8_BAR; PG8_SCHED;
            PG8_LDB(B1, 0, 1); PG8_STAGE(PG8_SB(0, 0), b2, voffB);
            PG8_BAR; PG8_WAIT_L(0); PG8_MMA(0, 1, At, B1); PG8_BAR;
            PG8_LDA(At, 0, 1); PG8_STAGE(PG8_SA(0, 0), a2, voffA);
            PG8_BAR; PG8_WAIT_L(0); PG8_MMA(1, 0, At, B0); PG8_BAR; PG8_SCHED;
            PG8_STAGE(PG8_SB(0, 1), b2 + hstep, voffB);
            PG8_WAIT_V(6); PG8_BAR; PG8_MMA(1, 1, At, B1); PG8_BAR;
            PG8_LDB(B0, 1, 0); PG8_SCHED; PG8_LDA(At, 1, 0); PG8_STAGE(PG8_SA(0, 1), a2 + hstep, voffA);
            PG8_WAIT_L(8); PG8_BAR; PG8_WAIT_L(0); PG8_MMA(0, 0, At, B0); PG8_BAR; PG8_SCHED;
            PG8_LDB(B1, 1, 1); PG8_STAGE(PG8_SB(1, 0), b3, voffB);
            PG8_BAR; PG8_WAIT_L(0); PG8_MMA(0, 1, At, B1); PG8_BAR;
            PG8_LDA(At, 1, 1); PG8_STAGE(PG8_SA(1, 0), a3, voffA);
            PG8_BAR; PG8_WAIT_L(0); PG8_MMA(1, 0, At, B0); PG8_BAR; PG8_SCHED;
            PG8_STAGE(PG8_SB(1, 1), b3 + hstep, voffB);
            PG8_WAIT_V(6); PG8_BAR; PG8_MMA(1, 1, At, B1); PG8_BAR;
            }
        }
        if constexpr (ALIGN_EPI) { if (wr == 0) PG8_BAR; }
        if constexpr (!Epi::AFTER_DRAIN) { unsigned long long t0_ = 0; if constexpr (PROBE_EPI) t0_ = __builtin_amdgcn_s_memrealtime(); E(acc, cur, wr, wc, fr, fq); if constexpr (PROBE_EPI) { asm volatile("s_waitcnt vmcnt(0)" ::: "memory"); eacc += __builtin_amdgcn_s_memrealtime() - t0_; } S.done(cur); }
        if (!has_next) break;
#pragma unroll
        for (int a = 0; a < 2; ++a)
#pragma unroll
            for (int b = 0; b < 2; ++b)
#pragma unroll
                for (int m = 0; m < 4; ++m)
#pragma unroll
                    for (int n = 0; n < 2; ++n) acc[a][b][m][n] = (f32x4){0.f, 0.f, 0.f, 0.f};
        cur = nxt; cA = nA; cB = nB; ++ui;
        if constexpr (ALIGN_EPI) { if (wr == 1) PG8_BAR; }
    }
    PG8_WAIT_V(0);
    if constexpr (!ALIGN_EPI) { if (wr == 0) PG8_BAR; }
    PG8_BAR;
    if constexpr (Epi::AFTER_DRAIN) { E.fused(acc, cur, wr, wc, fr, fq, lds, wid, lane); S.done(cur); }
#undef PG8_SA
#undef PG8_SB
#undef PG8_STAGE
#undef PG8_LDA
#undef PG8_LDB
#undef PG8_MMA
#undef PG8_WAIT_V
#undef PG8_WAIT_L
#undef PG8_BAR
#undef PG8_SCHED
}
}
namespace pg8 {
typedef unsigned u32x2 __attribute__((ext_vector_type(2)));
__device__ __forceinline__ float fsigmoid(float v) { return __builtin_amdgcn_rcpf(1.0f + __expf(-v)); }
__host__ __device__ __forceinline__ int in_tile_sem(int t) { const int m[15] = {7, 8, 10, 2, 0, 9, 11, 3, 4, 1, 5, 6, 12, 13, 14}; int r = 14;
#pragma unroll
    for (int i = 0; i < 15; ++i) r = (t == i) ? m[i] : r;
    return r; }
__host__ __device__ __forceinline__ int in_tile_log(int s) { const int m[15] = {4, 9, 3, 7, 8, 10, 11, 0, 1, 5, 2, 6, 12, 13, 14}; int r = 14;
#pragma unroll
    for (int i = 0; i < 15; ++i) r = (s == i) ? m[i] : r;
    return r; }
struct EpiIn {
    static constexpr bool PERM = true, AFTER_DRAIN = false;
    const float* ssq;
    bf16_t *hq, *hv, *hg, *Q, *Kb, *V; bf16_t* lf; float* lsig;
    const float* lba; const float* lbb;
    int layer; const float* qw; const float* kw; const float* fbias;
    __device__ __forceinline__ void operator()(const f32x4 (&acc)[2][2][4][2], const Unit& u, int wr, int wc, int fr, int fq) const {
        const int pn = in_tile_sem(u.pn), g = pn >> 1, half = pn & 1;
        const int row0 = u.pm * BM + wr * 64 + fr;
        if (pn == 14) {
            if (wc == 0 && fq == 0) {
                const f32x4 b0 = *(const f32x4*)(fbias), b1 = *(const f32x4*)(fbias + 4);
#pragma unroll
                for (int ai = 0; ai < 2; ++ai)
#pragma unroll
                    for (int m = 0; m < 4; ++m) { const int row = row0 + ai * HALF + m * 16; const float rs = rsqrtf(ssq[row] * (1.0f / 1024.0f) + 1e-6f);
                        f32x4 v0 = acc[ai][0][m][0] * rs + b0, v1 = acc[ai][0][m][1] * rs + b1;
#pragma unroll
                        for (int j = 0; j < 4; ++j) { v0[j] = fminf(v0[j], 0.f) - __logf(1.0f + __expf(-fabsf(v0[j]))); v1[j] = fminf(v1[j], 0.f) - __logf(1.0f + __expf(-fabsf(v1[j]))); }
                        *(f32x4*)(lsig + (size_t)row * 8) = v0; *(f32x4*)(lsig + (size_t)row * 8 + 4) = v1; }
            }
            return;
        }
        if (g == 4 || g == 5) {
            bf16_t* dst = (g == 4) ? Q : Kb; const float* nw = (g == 4) ? qw : kw; const float osc = (g == 4) ? 0.125f * 1.4426950408889634f : 1.0f;
            f32x4 w[2][2];
#pragma unroll
            for (int bj = 0; bj < 2; ++bj)
#pragma unroll
                for (int n = 0; n < 2; ++n) w[bj][n] = *(const f32x4*)(nw + 32 * bj + 8 * fq + 4 * n) * osc;
            const int col0 = (half * 4 + wc) * 64 + 8 * fq;
#pragma unroll
            for (int ai = 0; ai < 2; ++ai)
#pragma unroll
                for (int m = 0; m < 4; ++m) { const int row = row0 + ai * HALF + m * 16; const float rs = rsqrtf(ssq[row] * (1.0f / 1024.0f) + 1e-6f);
                    f32x4 v[2][2]; float ss = 0.f;
#pragma unroll
                    for (int bj = 0; bj < 2; ++bj)
#pragma unroll
                        for (int n = 0; n < 2; ++n) { v[bj][n] = acc[ai][bj][m][n] * rs; ss += (v[bj][n][0] * v[bj][n][0] + v[bj][n][1] * v[bj][n][1]) + (v[bj][n][2] * v[bj][n][2] + v[bj][n][3] * v[bj][n][3]); }
                    ss += __shfl_xor(ss, 16); ss += __shfl_xor(ss, 32);
                    const float hr = rsqrtf(ss * (1.0f / 64.0f) + 1e-6f);
#pragma unroll
                    for (int bj = 0; bj < 2; ++bj) { const f32x4 a = v[bj][0] * hr * w[bj][0], b = v[bj][1] * hr * w[bj][1];
                        u32x4 o; o.x = cvt_pk_bf16(a[0], a[1]); o.y = cvt_pk_bf16(a[2], a[3]); o.z = cvt_pk_bf16(b[0], b[1]); o.w = cvt_pk_bf16(b[2], b[3]);
                        *(u32x4*)(dst + (size_t)row * 512 + col0 + 32 * bj) = o; } }
            return;
        }
        const int col0 = half * 256 + wc * 32 + 8 * fq;
        if (g == 1) {
            f32x4 lbv[2][2];
#pragma unroll
            for (int bj = 0; bj < 2; ++bj)
#pragma unroll
                for (int n = 0; n < 2; ++n) { f32x4 t = (f32x4){0.f, 0.f, 0.f, 0.f};
                    if (layer == 1) { const f32x4 a0 = *(const f32x4*)(lba + col0 + 128 * bj + 4 * n), a1 = *(const f32x4*)(lbb + col0 + 128 * bj + 4 * n);
#pragma unroll
                        for (int j = 0; j < 4; ++j) t[j] = fsigmoid(a1[j] - a0[j]); }
                    lbv[bj][n] = t; }
#pragma unroll
            for (int ai = 0; ai < 2; ++ai)
#pragma unroll
                for (int m = 0; m < 4; ++m) { const int row = row0 + ai * HALF + m * 16; const float rs = rsqrtf(ssq[row] * (1.0f / 1024.0f) + 1e-6f);
#pragma unroll
                    for (int bj = 0; bj < 2; ++bj) { f32x4 v[2];
#pragma unroll
                        for (int n = 0; n < 2; ++n) { v[n] = acc[ai][bj][m][n] * rs;
#pragma unroll
                            for (int j = 0; j < 4; ++j) v[n][j] = __logf(lbv[bj][n][j] + (1.0f - lbv[bj][n][j]) * fsigmoid(v[n][j])); }
                        u32x4 o; o.x = cvt_pk_bf16(v[0][0], v[0][1]); o.y = cvt_pk_bf16(v[0][2], v[0][3]); o.z = cvt_pk_bf16(v[1][0], v[1][1]); o.w = cvt_pk_bf16(v[1][2], v[1][3]);
                        *(u32x4*)(lf + (size_t)row * 512 + col0 + 128 * bj) = o; } }
            return;
        }
        bf16_t* dst = (g == 0) ? hq : (g == 2) ? hv : (g == 3) ? hg : V;
        const float sc = (g == 0) ? 0.08838834764831845f : 1.0f;
#pragma unroll
        for (int ai = 0; ai < 2; ++ai)
#pragma unroll
            for (int m = 0; m < 4; ++m) { const int row = row0 + ai * HALF + m * 16; const float rs = rsqrtf(ssq[row] * (1.0f / 1024.0f) + 1e-6f) * sc;
#pragma unroll
                for (int bj = 0; bj < 2; ++bj) { f32x4 a = acc[ai][bj][m][0] * rs, b = acc[ai][bj][m][1] * rs;
                    if (g == 3) {
#pragma unroll
                        for (int j = 0; j < 4; ++j) { a[j] = a[j] * fsigmoid(a[j]); b[j] = b[j] * fsigmoid(b[j]); } }
                    u32x4 o; o.x = cvt_pk_bf16(a[0], a[1]); o.y = cvt_pk_bf16(a[2], a[3]); o.z = cvt_pk_bf16(b[0], b[1]); o.w = cvt_pk_bf16(b[2], b[3]);
                    *(u32x4*)(dst + (size_t)row * 512 + col0 + 128 * bj) = o; } }
    }
};
struct EpiRes {
    static constexpr bool PERM = false, AFTER_DRAIN = false;
    const float* base32; const bf16_t* base16; float* out32; bf16_t* out16; float* ssq;
    __device__ __forceinline__ void operator()(const f32x4 (&acc)[2][2][4][2], const Unit& u, int wr, int wc, int fr, int fq) const {
        const int col0 = u.pn * BM + wc * 32 + 4 * fq;
#pragma unroll
        for (int ai = 0; ai < 2; ++ai)
#pragma unroll
            for (int m = 0; m < 4; ++m) { const int row = u.pm * BM + ai * HALF + wr * 64 + m * 16 + fr; const size_t off = (size_t)row * 1024 + col0; float ss = 0.f;
#pragma unroll
                for (int bj = 0; bj < 2; ++bj)
#pragma unroll
                    for (int n = 0; n < 2; ++n) { const size_t o_ = off + bj * HALF + n * 16; f32x4 b;
                        if (base32) b = *(const f32x4*)(base32 + o_);
                        else { const u32x2 w = *(const u32x2*)(base16 + o_); b = (f32x4){__builtin_bit_cast(float, w.x << 16), __builtin_bit_cast(float, w.x & 0xffff0000u), __builtin_bit_cast(float, w.y << 16), __builtin_bit_cast(float, w.y & 0xffff0000u)}; }
                        const f32x4 o = b + acc[ai][bj][m][n];
                        ss += (o[0] * o[0] + o[1] * o[1]) + (o[2] * o[2] + o[3] * o[3]);
                        if (out32) *(f32x4*)(out32 + o_) = o;
                        else { u32x2 w; w.x = cvt_pk_bf16(o[0], o[1]); w.y = cvt_pk_bf16(o[2], o[3]); *(u32x2*)(out16 + o_) = w; } }
                if (ssq) { ss += __shfl_xor(ss, 16); ss += __shfl_xor(ss, 32); if (fq == 0) unsafeAtomicAdd(ssq + row, ss); } }
    }
};
struct EpiUp {
    static constexpr bool PERM = true, AFTER_DRAIN = false;
    const float* ssq; bf16_t* H;
    __device__ __forceinline__ void operator()(const f32x4 (&acc)[2][2][4][2], const Unit& u, int wr, int wc, int fr, int fq) const {
        const int row0 = u.pm * BM + wr * 64 + fr, col0 = u.pn * BM + wc * 32 + 8 * fq;
#pragma unroll
        for (int ai = 0; ai < 2; ++ai)
#pragma unroll
            for (int m = 0; m < 4; ++m) { const int row = row0 + ai * HALF + m * 16; const float rs = rsqrtf(ssq[row] * (1.0f / 1024.0f) + 1e-6f);
#pragma unroll
                for (int bj = 0; bj < 2; ++bj) { f32x4 a = acc[ai][bj][m][0] * rs, b = acc[ai][bj][m][1] * rs;
#pragma unroll
                    for (int j = 0; j < 4; ++j) { a[j] = fmaxf(a[j], 0.f); a[j] *= a[j]; b[j] = fmaxf(b[j], 0.f); b[j] *= b[j]; }
                    u32x4 o; o.x = cvt_pk_bf16(a[0], a[1]); o.y = cvt_pk_bf16(a[2], a[3]); o.z = cvt_pk_bf16(b[0], b[1]); o.w = cvt_pk_bf16(b[2], b[3]);
                    *(u32x4*)(H + (size_t)row * 4096 + col0 + 128 * bj) = o; } }
    }
};
}
#include <hip/hip_bf16.h>
#include <cmath>
namespace attn_body {
using bf16=__hip_bfloat16;
using bf16x8=__attribute__((ext_vector_type(8)))short;
using s16x4=__attribute__((ext_vector_type(4)))short;
using f32x16=__attribute__((ext_vector_type(16)))float;
using u32x4=__attribute__((ext_vector_type(4)))unsigned;
using f32x4v=__attribute__((ext_vector_type(4)))float;
constexpr int BATCH=2,NHEAD=8,SEQ=8192,D=64,DM=NHEAD*D,ODM=1024;
constexpr int NW=8,QBLK=32,QB=QBLK*NW,KVBLK=64,NQB=SEQ/QB;
constexpr int ATTN_PITCH=DM, ATTN_UNIT_ROWS=QB;
__device__ __forceinline__ int crow(int r,int hi){return (r&3)+8*(r>>2)+4*hi;}
#define SBAR() __builtin_amdgcn_sched_barrier(0)
__device__ __forceinline__ void cmask(f32x16&p0,f32x16&p1,int jb,int qrel,int hi){
  const float NEG=-INFINITY; int kb=64*jb+4*hi;
  #pragma unroll
  for(int r=0;r<16;++r){int kv=kb+(r&3)+8*(r>>2); if(kv>qrel)p0[r]=NEG; if(kv+32>qrel)p1[r]=NEG;}
}

constexpr int NSLOT=3, SLOTB=8192;
constexpr int LDS_K=0, LDS_V=NSLOT*SLOTB, LDS_WS=2*NSLOT*SLOTB, LDS_OST=LDS_WS+NW*64*4, LDS_BYTES=LDS_OST+NW*4096, LDS_DK=86016, LDS_END=LDS_DK+SEQ*4;
constexpr float C2=0.125f*1.4426950408889634f;
__device__ __forceinline__ void glds16(const void*gsrc,unsigned lds_dst){unsigned keep;
  asm volatile("s_mov_b32 %0, m0\n\ts_mov_b32 m0, %2\n\ts_nop 0\n\tglobal_load_lds_dwordx4 %1, off\n\ts_mov_b32 m0, %0":"=&s"(keep):"v"(gsrc),"s"(lds_dst):"memory");}
__device__ __forceinline__ float max3f(float a,float b,float c){float r;asm("v_max3_f32 %0, %1, %2, %3":"=v"(r):"v"(a),"v"(b),"v"(c));return r;}
__device__ __forceinline__ float max2f(float a,float b){float r;asm("v_max_f32_e32 %0, %1, %2":"=v"(r):"v"(a),"v"(b));return r;}
__device__ __forceinline__ float fadd_s(float a,float b){float r;asm("v_add_f32_e32 %0, %1, %2":"=v"(r):"v"(a),"v"(b));return r;}
__device__ __forceinline__ float fsub_s(float a,float b){float r;asm("v_sub_f32_e32 %0, %1, %2":"=v"(r):"v"(a),"v"(b));return r;}
typedef float f32x2_t __attribute__((ext_vector_type(2))); typedef __bf16 bf16x2_t __attribute__((ext_vector_type(2)));
__device__ __forceinline__ unsigned cvtpk_s(float lo,float hi){f32x2_t v={lo,hi};bf16x2_t b=__builtin_convertvector(v,bf16x2_t);return __builtin_bit_cast(unsigned,b);}
#define WAIT_BAR(N) asm volatile("s_waitcnt vmcnt(" #N ") lgkmcnt(0)\n\ts_barrier":::"memory")

__device__ __forceinline__ void qkt(f32x16&p0,f32x16&p1,const char*Kslot,const bf16x8*qr,int r32,int hi){
  const char*kb=Kslot+hi*1024+r32*16;
  #pragma unroll
  for(int d0=0;d0<4;++d0){
    const bf16x8 b0=*reinterpret_cast<const bf16x8*>(kb+d0*2048);
    const bf16x8 b1=*reinterpret_cast<const bf16x8*>(kb+d0*2048+512);
    {p0=__builtin_amdgcn_mfma_f32_32x32x16_bf16(b0,qr[d0],p0,0,0,0);p1=__builtin_amdgcn_mfma_f32_32x32x16_bf16(b1,qr[d0],p1,0,0,0);}}
}
typedef __attribute__((address_space(3))) const char* lds_cptr;
typedef short v4i16_t __attribute__((ext_vector_type(4)));
__device__ __forceinline__ void kload8(bf16x8*kf,lds_cptr kp){
  kf[0]=*(const __attribute__((address_space(3))) bf16x8*)(kp);      kf[1]=*(const __attribute__((address_space(3))) bf16x8*)(kp+512);
  kf[2]=*(const __attribute__((address_space(3))) bf16x8*)(kp+2048); kf[3]=*(const __attribute__((address_space(3))) bf16x8*)(kp+2560);
  kf[4]=*(const __attribute__((address_space(3))) bf16x8*)(kp+4096); kf[5]=*(const __attribute__((address_space(3))) bf16x8*)(kp+4608);
  kf[6]=*(const __attribute__((address_space(3))) bf16x8*)(kp+6144); kf[7]=*(const __attribute__((address_space(3))) bf16x8*)(kp+6656);
}
__device__ __forceinline__ void kload2(bf16x8*kf,lds_cptr kp,int j){ kf[2*j]=*(const __attribute__((address_space(3))) bf16x8*)(kp+j*2048); kf[2*j+1]=*(const __attribute__((address_space(3))) bf16x8*)(kp+j*2048+512); }
__device__ __forceinline__ s16x4 vtr(lds_cptr p){ return __builtin_bit_cast(s16x4,__builtin_amdgcn_ds_read_tr16_b64_v4i16((__attribute__((address_space(3))) v4i16_t*)p)); }
__device__ __forceinline__ float rowmax(const f32x16&p0,const f32x16&p1){
  float a=max3f(p0[0],p0[1],p1[0]),b=max3f(p0[2],p0[3],p1[1]);a=max3f(a,p1[2],p1[3]);
  #pragma unroll
  for(int r=4;r<16;r+=4){a=max3f(a,p0[r],p0[r+1]);b=max3f(b,p0[r+2],p0[r+3]);a=max3f(a,p1[r],p1[r+1]);b=max3f(b,p1[r+2],p1[r+3]);}
  const float m=max2f(a,b);
  auto rr=__builtin_amdgcn_permlane32_swap(__float_as_uint(m),__float_as_uint(m),false,false);
  return max2f(__uint_as_float(rr[0]),__uint_as_float(rr[1]));
}
__device__ __forceinline__ void pv(f32x16*o,int vb,bf16x8 pa0,bf16x8 pa1,bf16x8 pa2,bf16x8 pa3){
  #pragma unroll
  for(int d0=0;d0<2;++d0){s16x4 lo[4],hi[4];
    #pragma unroll
    for(int ks=0;ks<4;++ks){
      asm volatile("ds_read_b64_tr_b16 %0,%1 offset:%c2":"=&v"(lo[ks]):"v"(vb),"i"(d0*4096+ks*1024):"memory");
      asm volatile("ds_read_b64_tr_b16 %0,%1 offset:%c2":"=&v"(hi[ks]):"v"(vb),"i"(d0*4096+ks*1024+512):"memory");}
    asm volatile("s_waitcnt lgkmcnt(0)":::"memory");SBAR();
    #define PK(k) (bf16x8){lo[k][0],lo[k][1],lo[k][2],lo[k][3],hi[k][0],hi[k][1],hi[k][2],hi[k][3]}
    o[d0]=__builtin_amdgcn_mfma_f32_32x32x16_bf16(pa0,PK(0),o[d0],0,0,0);
    o[d0]=__builtin_amdgcn_mfma_f32_32x32x16_bf16(pa1,PK(1),o[d0],0,0,0);
    o[d0]=__builtin_amdgcn_mfma_f32_32x32x16_bf16(pa2,PK(2),o[d0],0,0,0);
    o[d0]=__builtin_amdgcn_mfma_f32_32x32x16_bf16(pa3,PK(3),o[d0],0,0,0);
    #undef PK
  }
}

#ifndef ATTN_STORE16
#define ATTN_STORE16(p,v) (*(u32x4*)(p)=(v))
#endif
template<int THRL> __device__ __forceinline__ void attn_unit(int b,int h,int qb,int NT,const float*dkg,const bf16*Q,const bf16*__restrict__ K,const bf16*__restrict__ V,bf16*O,char*shm){
  int tid_o=threadIdx.x; asm volatile("":"+v"(tid_o));
  const int tid=tid_o,lane=tid&63,r32=lane&31,hi=lane>>5; const int wid=__builtin_amdgcn_readfirstlane(tid>>6);
  const long rowbase=(long)b*SEQ; const int q0=qb*QB;
  const bf16*Qw=Q+(rowbase+q0+wid*QBLK)*DM+h*D;
  const bf16*Kh=K+rowbase*DM+h*D,*Vh=V+rowbase*DM+h*D;
  const unsigned lds0=(unsigned)(uintptr_t)shm;
  float*wsf=(float*)(shm+LDS_WS)+wid*64;
  const bf16*ksrc=Kh+(long)lane*DM+wid*8;
  const bf16*vsrc=Vh+(long)(16*(wid&3)+(lane>>2))*DM+(wid>>2)*32+(lane&3)*8;
  const unsigned kdst=lds0+LDS_K+wid*1024, vdst=lds0+LDS_V+wid*1024;
  #define TA(t) (((t)<4)?(NTA-4+(t)):(NTA-1-(t)))
  #define DMA_K(t,slot) glds16(ksrc+(long)TA(t)*KVBLK*DM,(unsigned)__builtin_amdgcn_readfirstlane(kdst+(slot)))
  #define DMA_V(t,slot) glds16(vsrc+(long)TA(t)*KVBLK*DM,(unsigned)__builtin_amdgcn_readfirstlane(vdst+(slot)))
  const int vb0=(int)(lds0+LDS_V)+((lane>>4)&1)*32+(lane&3)*8+(4*hi+((lane&15)>>2))*64;
  const char*Kbase=shm+LDS_K; bf16x8 kf[8];
  const lds_cptr shm3=(lds_cptr)shm; const lds_cptr kp0=shm3+LDS_K+hi*1024+r32*16; const lds_cptr vp0=shm3+LDS_V+((lane>>4)&1)*32+(lane&3)*8+(4*hi+((lane&15)>>2))*64;
  const int NTA=(q0+QB)/KVBLK;
  typedef __attribute__((address_space(3))) const f32x4v* dk_cptr; const dk_cptr dkp=(dk_cptr)(shm3+LDS_DK+hi*16);
  #define CINIT1(C0,t,o8) do{ const dk_cptr dp_=dkp+TA(t)*16+(o8); _Pragma("unroll") for(int j_=0;j_<4;++j_){ const f32x4v a_=dp_[2*j_]; \
      C0[4*j_]=a_[0]+nmh;C0[4*j_+1]=a_[1]+nmh;C0[4*j_+2]=a_[2]+nmh;C0[4*j_+3]=a_[3]+nmh; } }while(0)
  #define CINIT(C0,C1,t) do{ CINIT1(C0,t,0); SBAR(); CINIT1(C1,t,8); }while(0)
  DMA_K(0,0);DMA_V(0,0);DMA_K(1,SLOTB);
  bf16x8 qr[4];
  #pragma unroll
  for(int d0=0;d0<4;++d0)qr[d0]=*reinterpret_cast<const bf16x8*>(&Qw[(long)r32*DM+d0*16+hi*8]);
  float mhat=0.f,l_reg=0.f,nmh=0.f;f32x16 o[2];o[0]=f32x16{};o[1]=f32x16{};
  const int qrel=wid*QBLK+r32;
  #define CMASK(P0,P1,t) do{int jb_=(t); if(jb_<4)cmask(P0,P1,jb_,qrel,hi);}while(0)
  bool resc=false;
  #define START(P0,P1) do{ const float rm=rowmax(P0,P1); resc=false; \
    { const float dl=rm; mhat=fadd_s(mhat,dl); \
      _Pragma("unroll") for(int r=0;r<16;++r){P0[r]=fsub_s(P0[r],dl);P1[r]=fsub_s(P1[r],dl);} \
      nmh=-mhat; } \
    _Pragma("unroll") for(int r=0;r<16;++r)P0[r]=__builtin_amdgcn_exp2f(P0[r]); }while(0)
  #define RESC() do{ if(resc){ asm volatile("s_waitcnt lgkmcnt(0)":::"memory"); \
      _Pragma("unroll") for(int d_=0;d_<2;++d_) _Pragma("unroll") for(int r=0;r<16;++r)o[d_][r]*=wsf[crow(r,hi)]; } }while(0)
  f32x16 pA0,pA1,pB0,pB1;
  int sl_prev=0,sl_cur=0,sl_next=SLOTB;
  #define ROT() do{sl_prev=sl_cur;sl_cur=sl_next;sl_next=(sl_next==(NSLOT-1)*SLOTB)?0:sl_next+SLOTB;}while(0)
  DMA_K(2,2*SLOTB);
  { typedef __attribute__((address_space(3))) f32x4v* dk_wptr; for(int p=64*(NTA-NT)+4*tid;p<64*NTA;p+=2048) *(dk_wptr)(shm3+LDS_DK+p*4)=*reinterpret_cast<const f32x4v*>(dkg+p); }
  WAIT_BAR(3);
  CINIT(pA0,pA1,0); qkt(pA0,pA1,Kbase,qr,r32,hi);asm volatile("s_nop 15\n\ts_nop 7":"+v"(pA0),"+v"(pA1));CMASK(pA0,pA1,0);
  START(pA0,pA1);
  _Pragma("unroll") for(int r=0;r<16;++r)pA1[r]=__builtin_amdgcn_exp2f(pA1[r]);
  WAIT_BAR(0);
  DMA_K(3,0);DMA_V(1,SLOTB);
  ROT();
  kload8(kf,kp0+sl_cur);
  WAIT_BAR(2);
  s16x4 vlo[8],vhi[8]; u32x4 pw0,pw1,pw2,pw3;
  #define PKW(P,B) cvtpk_s(P[B],P[B+1])
  #define PAF(k) __builtin_bit_cast(bf16x8,pw##k)
  #define VFR(i) (bf16x8){vlo[i][0],vlo[i][1],vlo[i][2],vlo[i][3],vhi[i][0],vhi[i][1],vhi[i][2],vhi[i][3]}
  #define PIN(x) asm volatile("":"+v"(x))
  #define MX3(a,b,c) __builtin_fmaxf(__builtin_fmaxf((a),(b)),(c))
  #define GAPA(MF,A0,A1,A2,A3,W0,W1,PW) do{ MF; sacc+=A0; sacc+=A1; sacc+=A2; sacc+=A3; PIN(sacc); W0; W1; PIN(PW); SBAR(); }while(0)
  #define EX(v) __builtin_amdgcn_exp2f(v)
  #define GAPB(MF,X,B) do{ MF; X[B]=EX(X[B]); X[B+1]=EX(X[B+1]); X[B+2]=EX(X[B+2]); X[B+3]=EX(X[B+3]); PIN(X); SBAR(); }while(0)
  #define VRD(i) do{ vlo[i]=vtr(vp_+(((i)>>2)*4096+((i)&3)*1024)); vhi[i]=vtr(vp_+(((i)>>2)*4096+((i)&3)*1024+512)); }while(0)
  #define KRD(G,j) do{ if(G){ kload2(kf,kp0+sl_next,j); SBAR(); } }while(0)
  #define STEP(C0,C1,P0,P1,t,GK,GV,GL) do{ SBAR(); CINIT(C0,C1,t); SBAR(); \
    const lds_cptr vp_=vp0+sl_prev; \
    VRD(0); SBAR(); float sacc=(P0[0]+P0[1]); \
    GAPA(C0=__builtin_amdgcn_mfma_f32_32x32x16_bf16(kf[0],qr[0],C0,0,0,0), P0[2],P0[3],P0[4],P0[5],     pw0[0]=PKW(P0,0), pw0[1]=PKW(P0,2), pw0); \
    VRD(4); SBAR(); GAPA(C1=__builtin_amdgcn_mfma_f32_32x32x16_bf16(kf[1],qr[0],C1,0,0,0), P0[6],P0[7],P0[8],P0[9],     pw0[2]=PKW(P0,4), pw0[3]=PKW(P0,6), pw0); \
    VRD(1); SBAR(); GAPA(C0=__builtin_amdgcn_mfma_f32_32x32x16_bf16(kf[2],qr[1],C0,0,0,0),   P0[10],P0[11],P0[12],P0[13], pw1[0]=PKW(P0,8), pw1[1]=PKW(P0,10), pw1); \
    VRD(5); SBAR(); GAPA(C1=__builtin_amdgcn_mfma_f32_32x32x16_bf16(kf[3],qr[1],C1,0,0,0),   P0[14],P0[15],P1[0],P1[1],   pw1[2]=PKW(P0,12),pw1[3]=PKW(P0,14), pw1); \
    VRD(2); SBAR(); GAPA(C0=__builtin_amdgcn_mfma_f32_32x32x16_bf16(kf[4],qr[2],C0,0,0,0),   P1[2],P1[3],P1[4],P1[5],     pw2[0]=PKW(P1,0), pw2[1]=PKW(P1,2), pw2); \
    VRD(6); SBAR(); GAPA(C1=__builtin_amdgcn_mfma_f32_32x32x16_bf16(kf[5],qr[2],C1,0,0,0),   P1[6],P1[7],P1[8],P1[9],     pw2[2]=PKW(P1,4), pw2[3]=PKW(P1,6), pw2); \
    VRD(3); SBAR(); GAPA(C0=__builtin_amdgcn_mfma_f32_32x32x16_bf16(kf[6],qr[3],C0,0,0,0),   P1[10],P1[11],P1[12],P1[13], pw3[0]=PKW(P1,8), pw3[1]=PKW(P1,10), pw3); \
    VRD(7); SBAR(); GAPA(C1=__builtin_amdgcn_mfma_f32_32x32x16_bf16(kf[7],qr[3],C1,0,0,0),   P1[14],P1[15],0.f,0.f,       pw3[2]=PKW(P1,12),pw3[3]=PKW(P1,14), pw3); \
    l_reg+=sacc; \
    if(GK){DMA_K((t)+3,sl_cur);} if(GV){DMA_V((t)+1,sl_next);} \
    CMASK(C0,C1,t); \
    { float a=MX3(C0[0],C0[1],C1[0]),b=MX3(C0[2],C0[3],C1[1]); a=MX3(a,C1[2],C1[3]); \
      _Pragma("unroll") for(int r=4;r<16;r+=4){a=MX3(a,C0[r],C0[r+1]);b=MX3(b,C0[r+2],C0[r+3]);a=MX3(a,C1[r],C1[r+1]);b=MX3(b,C1[r+2],C1[r+3]);} \
      float rm=__builtin_fmaxf(a,b); { auto rr=__builtin_amdgcn_permlane32_swap(__float_as_uint(rm),__float_as_uint(rm),false,false); rm=__builtin_fmaxf(__uint_as_float(rr[0]),__uint_as_float(rr[1])); } \
      resc=false; \
      if(__builtin_expect(__any(rm>(float)THRL),0)){ const float dl=__builtin_fmaxf(rm,0.f); mhat+=dl; \
        _Pragma("unroll") for(int r=0;r<16;++r){C0[r]-=dl;C1[r]-=dl;} \
        nmh=-mhat; \
        const float f=__builtin_amdgcn_exp2f(-dl); l_reg*=f; if(hi==0)wsf[r32]=f; resc=true; } } \
    SBAR(); \
    GAPB(o[0]=__builtin_amdgcn_mfma_f32_32x32x16_bf16(PAF(0),VFR(0),o[0],0,0,0), C0,0); \
    GAPB(o[1]=__builtin_amdgcn_mfma_f32_32x32x16_bf16(PAF(0),VFR(4),o[1],0,0,0), C0,4); \
    KRD(GL,0); GAPB(o[0]=__builtin_amdgcn_mfma_f32_32x32x16_bf16(PAF(1),VFR(1),o[0],0,0,0), C0,8); \
    KRD(GL,1); GAPB(o[1]=__builtin_amdgcn_mfma_f32_32x32x16_bf16(PAF(1),VFR(5),o[1],0,0,0), C0,12); \
    KRD(GL,2); GAPB(o[0]=__builtin_amdgcn_mfma_f32_32x32x16_bf16(PAF(2),VFR(2),o[0],0,0,0), C1,0); \
    KRD(GL,3); GAPB(o[1]=__builtin_amdgcn_mfma_f32_32x32x16_bf16(PAF(2),VFR(6),o[1],0,0,0), C1,4); \
    GAPB(o[0]=__builtin_amdgcn_mfma_f32_32x32x16_bf16(PAF(3),VFR(3),o[0],0,0,0), C1,8); \
    GAPB(o[1]=__builtin_amdgcn_mfma_f32_32x32x16_bf16(PAF(3),VFR(7),o[1],0,0,0), C1,12); \
    }while(0)
  int t=1;
  #define ENDW(tt) do{ if((tt)+3<NT){WAIT_BAR(2);} else if((tt)+2<NT){WAIT_BAR(1);} else {WAIT_BAR(0);} }while(0)
  for(;t+1<NT;t+=2){
    STEP(pB0,pB1,pA0,pA1,t,(t+3<NT),(t+1<NT),(t+1<NT));       ENDW(t);   RESC(); ROT();
    STEP(pA0,pA1,pB0,pB1,t+1,(t+4<NT),(t+2<NT),(t+2<NT));     ENDW(t+1); RESC(); ROT();
  }
  STEP(pB0,pB1,pA0,pA1,NT-1,false,false,false); RESC();
  { float sacc=pB0[0]+pB0[1]; _Pragma("unroll") for(int r=2;r<16;++r)sacc+=pB0[r]; _Pragma("unroll") for(int r=0;r<16;++r)sacc+=pB1[r]; l_reg+=sacc;
    pw0=(u32x4){PKW(pB0,0),PKW(pB0,2),PKW(pB0,4),PKW(pB0,6)};pw1=(u32x4){PKW(pB0,8),PKW(pB0,10),PKW(pB0,12),PKW(pB0,14)};pw2=(u32x4){PKW(pB1,0),PKW(pB1,2),PKW(pB1,4),PKW(pB1,6)};pw3=(u32x4){PKW(pB1,8),PKW(pB1,10),PKW(pB1,12),PKW(pB1,14)};
    SBAR(); pv(o,vb0+sl_cur,PAF(0),PAF(1),PAF(2),PAF(3)); }
  #undef PKW
  #undef PAF
  #undef VFR
  #undef PIN
  #undef MX3
  #undef GAPA
  #undef GAPB
  #undef EX
  #undef VRD
  #undef KRD
  #undef STEP
  #undef ENDW
  {auto rr=__builtin_amdgcn_permlane32_swap(__float_as_uint(l_reg),__float_as_uint(l_reg),false,false);l_reg=__uint_as_float(rr[0])+__uint_as_float(rr[1]);}
  if(hi==0)wsf[32+r32]=l_reg;asm volatile("s_waitcnt lgkmcnt(0)":::"memory");
  float rli[16];
  #pragma unroll
  for(int r=0;r<16;++r)rli[r]=__builtin_amdgcn_rcpf(wsf[32+crow(r,hi)]);
  bf16*Ow=O+(rowbase+q0+wid*QBLK)*ODM+h*D;
  { bf16*stg=(bf16*)(shm+LDS_OST)+wid*2048;
    #pragma unroll
    for(int r=0;r<16;++r){const int orow=crow(r,hi);
      #pragma unroll
      for(int d0=0;d0<2;++d0)stg[orow*64+d0*32+r32]=__float2bfloat16(o[d0][r]*rli[r]);}
    asm volatile("s_waitcnt lgkmcnt(0)":::"memory");
    #pragma unroll
    for(int i=0;i<4;++i){const int row=i*8+(lane>>3),ch=lane&7; const u32x4 v=*(const u32x4*)(stg+row*64+ch*8); ATTN_STORE16(Ow+(long)row*ODM+ch*8,v);} }
  asm volatile("s_waitcnt lgkmcnt(0)\n\ts_barrier":::"memory");
  #undef DMA_K
  #undef TA
  #undef CINIT
  #undef CINIT1
  #undef DMA_V
  #undef CMASK
  #undef START
  #undef RESC
  #undef ROT
}
constexpr int ATTN_LDS_BYTES=LDS_END;
#undef SBAR
#undef WAIT_BAR
}
constexpr int NWAVES = 8, NTHREADS = 512;
constexpr int BATCH = 2, T = 8192, D = 1024, FF = 4096, M = BATCH * T, DEPTH = 2;
constexpr int IN_COLS = 3592, NIN = 3840;
constexpr size_t MiB = 1u << 20;
constexpr size_t WS_CTL = 0, CTL_ZERO_BYTES = 1 * MiB;
constexpr size_t WS_SSQ = 64 * 1024;
constexpr size_t WS_LSIG = 512 * 1024;
constexpr size_t WS_WIN = 1 * MiB, WIN_BYTES = (size_t)NIN * D * 2;
constexpr size_t WS_WOUT = 16 * MiB, WS_WUP = 20 * MiB, WS_WDN = 36 * MiB;
constexpr size_t WS_XB = 52 * MiB;
constexpr size_t WS_ST = 84 * MiB;
constexpr size_t WS_HQ = 116 * MiB, WS_LF = 132 * MiB, WS_HV = 164 * MiB, WS_HG = 180 * MiB, WS_Q = 196 * MiB, WS_K = 212 * MiB, WS_V = 228 * MiB, WS_END = 244 * MiB;
constexpr size_t WS_H = 116 * MiB;
constexpr size_t WS_DL = 244 * MiB;
constexpr int LDS_BYTES = 147456;

#define GAS __attribute__((address_space(1)))
#define LAS __attribute__((address_space(3)))
typedef unsigned short bf16;
typedef unsigned v4u __attribute__((ext_vector_type(4)));
typedef float f32x4 __attribute__((ext_vector_type(4)));
typedef float f32x16 __attribute__((ext_vector_type(16)));
typedef short bf16x8 __attribute__((ext_vector_type(8)));
#define LDS_WAIT() asm volatile("s_waitcnt lgkmcnt(0)" ::: "memory")
__device__ __forceinline__ unsigned f2bf(float f) { unsigned u = __builtin_bit_cast(unsigned, f); return (u + 0x7fffu + ((u >> 16) & 1u)) >> 16; }
__device__ __forceinline__ unsigned pk2(float lo, float hi) { return f2bf(lo) | (f2bf(hi) << 16); }
__device__ __forceinline__ float bf2f(unsigned short b) { return __builtin_bit_cast(float, (unsigned)b << 16); }
__device__ __forceinline__ int crow16(int r, int hi) { return (r & 3) + 8 * (r >> 2) + 4 * hi; }

struct Frame {
    LAS unsigned char* lds; int tid, lane, wave, vcu, G;
};
__device__ __forceinline__ float wave_sum(float v) {
#pragma unroll
    for (int o = 1; o < 64; o <<= 1) v += __shfl_xor(v, o);
    return v;
}
__device__ __forceinline__ void p0_transpose_item(const float* W, int pitch, int K, const float* sc, bf16* WT, int dst_row0, int k0, int n0, LAS float* scr, int lane) {
#pragma unroll 8
    for (int i = 0; i < 32; ++i) { const int kk = 2 * i + (lane >> 5); float v = W[(size_t)(k0 + kk) * pitch + n0 + (lane & 31)]; if (sc) v *= sc[k0 + kk]; scr[kk * 33 + (lane & 31)] = v; }
    LDS_WAIT(); asm volatile("" ::: "memory");
    const int c = lane & 7;
#pragma unroll
    for (int j = 0; j < 4; ++j) { const int n = (lane >> 3) + 8 * j; const LAS float* s = scr + (8 * c) * 33 + n;
        v4u o; o.x = pk2(s[0 * 33], s[1 * 33]); o.y = pk2(s[2 * 33], s[3 * 33]); o.z = pk2(s[4 * 33], s[5 * 33]); o.w = pk2(s[6 * 33], s[7 * 33]);
        *(GAS v4u*)(WT + (size_t)(dst_row0 + n) * K + k0 + 8 * c) = o; }
    LDS_WAIT(); asm volatile("" ::: "memory");
}
__device__ __forceinline__ int map_in_row(int n) {
    const int sem = n >> 8, base = pg8::in_tile_log(sem) * 256;
    if (n < 2048 || n >= 3072) return base + (n & 255);
    const int o = n & 255, wc = o >> 6, w = o & 63, bj = w >> 5, x = w & 31;
    return base + bj * 128 + wc * 32 + x;
}
struct Ptrs {
    const float *x, *lower_bounds, *norm1_w, *w_in, *fox_f_bias, *q_norm_w, *k_norm_w, *hgrn_norm_w, *w_out, *norm2_w, *w_up, *w_down;
    float* out; unsigned char* ws;
};
constexpr int TI_FULL = 12288, TI_VIRT = TI_FULL + 4 * (2 * (16 * 112 + 16 * 32 + 16 * 128 + 64 * 32) - TI_FULL);
struct TItem { const float* W; const float* sc; bf16* WT; int pitch, K, dst_row0, k0, n0, kc; };
__device__ __forceinline__ void titem_decode(const Ptrs& P, int vit, TItem& t) {
    constexpr int I_IN = 16 * 112, I_OUT = 16 * 32, I_UP = 16 * 128, I_DN = 64 * 32, I_L = I_IN + I_OUT + I_UP + I_DN;
    int it = vit, kq = 0, kcnt = 64;
    if (vit >= TI_FULL) { it = TI_FULL + ((vit - TI_FULL) >> 2); kq = (vit - TI_FULL) & 3; kcnt = 16; }
    const int l = it / I_L; int r = it % I_L;
    if (r < I_IN) { const int kb = r / 112, nb = r % 112; t = TItem{P.w_in + (size_t)l * D * IN_COLS, P.norm1_w + l * D, (bf16*)(P.ws + WS_WIN + l * WIN_BYTES), IN_COLS, D, map_in_row(32 * nb), 64 * kb + 16 * kq, 32 * nb, kcnt}; return; } r -= I_IN;
    if (r < I_OUT) { const int kb = r / 32, nb = r % 32; t = TItem{P.w_out + (size_t)l * D * D, nullptr, (bf16*)(P.ws + WS_WOUT + l * 2 * MiB), D, D, 32 * nb, 64 * kb + 16 * kq, 32 * nb, kcnt}; return; } r -= I_OUT;
    if (r < I_UP) { const int kb = r / 128, nb = r % 128; t = TItem{P.w_up + (size_t)l * D * FF, P.norm2_w + l * D, (bf16*)(P.ws + WS_WUP + l * 8 * MiB), FF, D, 32 * nb, 64 * kb + 16 * kq, 32 * nb, kcnt}; return; } r -= I_UP;
    { const int kb = r / 32, nb = r % 32; t = TItem{P.w_down + (size_t)l * FF * D, nullptr, (bf16*)(P.ws + WS_WDN + l * 8 * MiB), D, FF, 32 * nb, 64 * kb + 16 * kq, 32 * nb, kcnt}; }
}
__device__ __forceinline__ void titem_load(const TItem& t, int lane, float (&v)[32], float (&s)[32]) {
#pragma unroll
    for (int i = 0; i < 32; ++i) { const int kk = 2 * i + (lane >> 5); if (2 * i < t.kc) { v[i] = t.W[(size_t)(t.k0 + kk) * t.pitch + t.n0 + (lane & 31)]; s[i] = t.sc ? t.sc[t.k0 + kk] : 1.0f; } else { v[i] = 0.f; s[i] = 0.f; } }
}
__device__ __forceinline__ void titem_store(const TItem& t, LAS float* scr, int lane, const float (&v)[32], const float (&s)[32]) {
#pragma unroll
    for (int i = 0; i < 32; ++i) { const int kk = 2 * i + (lane >> 5); if (2 * i < t.kc) scr[kk * 33 + (lane & 31)] = v[i] * s[i]; }
    LDS_WAIT(); asm volatile("" ::: "memory");
    const int c = lane & 7;
#pragma unroll
    for (int j = 0; j < 4; ++j) { const int n = (lane >> 3) + 8 * j; const LAS float* sp = scr + (8 * c) * 33 + n;
        v4u o; o.x = pk2(sp[0 * 33], sp[1 * 33]); o.y = pk2(sp[2 * 33], sp[3 * 33]); o.z = pk2(sp[4 * 33], sp[5 * 33]); o.w = pk2(sp[6 * 33], sp[7 * 33]);
        if (8 * c < t.kc) *(GAS v4u*)(t.WT + (size_t)(t.dst_row0 + n) * t.K + t.k0 + 8 * c) = o; }
    LDS_WAIT(); asm volatile("" ::: "memory");
}
__device__ __forceinline__ void p0_prologue(Frame& F, const Ptrs& P) {
    LAS float* scr = (LAS float*)(F.lds + F.wave * 16384);
    const int gw = F.vcu * NWAVES + F.wave, NGW = F.G * NWAVES;
    constexpr int I_L = 16 * 112 + 16 * 32 + 16 * 128 + 64 * 32;
    { TItem cur, nxt; float v[32], s[32], nv[32], ns[32]; int it = gw; bool has = it < TI_VIRT;
      if (has) { titem_decode(P, it, cur); titem_load(cur, F.lane, v, s); }
      while (has) { const int itn = it + NGW; const bool hn = itn < TI_VIRT;
          if (hn) { titem_decode(P, itn, nxt); titem_load(nxt, F.lane, nv, ns); }
          titem_store(cur, scr, F.lane, v, s);
          if (hn) { cur = nxt;
#pragma unroll
              for (int i = 0; i < 32; ++i) { v[i] = nv[i]; s[i] = ns[i]; } }
          it = itn; has = hn; } }
    { const int x = gw;
      if (F.lane == 0) for (int e = x; e < DEPTH * 8 * 128; e += NGW) { const int l = e >> 10, j = (e >> 7) & 7, kc = e & 127; float v[8];
#pragma unroll
          for (int i = 0; i < 8; ++i) v[i] = P.w_in[(size_t)l * D * IN_COLS + (size_t)(8 * kc + i) * IN_COLS + 3584 + j] * P.norm1_w[l * D + 8 * kc + i];
          v4u o; o.x = pk2(v[0], v[1]); o.y = pk2(v[2], v[3]); o.z = pk2(v[4], v[5]); o.w = pk2(v[6], v[7]);
          *(GAS v4u*)((bf16*)(P.ws + WS_WIN + l * WIN_BYTES) + (size_t)(3584 + j) * D + 8 * kc) = o; }
      const int gt = F.vcu * NTHREADS + F.tid;
      for (int e = gt; e < DEPTH * 248 * 128; e += F.G * NTHREADS) { const int l = e / (248 * 128), r = e % (248 * 128), j = 8 + (r >> 7), kc = r & 127;
          *(GAS v4u*)((bf16*)(P.ws + WS_WIN + l * WIN_BYTES) + (size_t)(3584 + j) * D + 8 * kc) = (v4u){0u, 0u, 0u, 0u}; } }
    bf16* XB = (bf16*)(P.ws + WS_XB); float* ssq = (float*)(P.ws + WS_SSQ);
    for (int m = gw; m < M; m += 2 * NGW) { const int m2 = m + NGW;
        const GAS f32x4* xr = (const GAS f32x4*)(P.x + (size_t)m * D) + F.lane; const GAS f32x4* xr2 = (const GAS f32x4*)(P.x + (size_t)(m2 < M ? m2 : m) * D) + F.lane; f32x4 v[4], w[4]; float s = 0.f, s2 = 0.f;
#pragma unroll
        for (int j = 0; j < 4; ++j) { v[j] = xr[64 * j]; w[j] = xr2[64 * j]; }
#pragma unroll
        for (int j = 0; j < 4; ++j) { s += (v[j].x * v[j].x + v[j].y * v[j].y) + (v[j].z * v[j].z + v[j].w * v[j].w); s2 += (w[j].x * w[j].x + w[j].y * w[j].y) + (w[j].z * w[j].z + w[j].w * w[j].w); }
        s = wave_sum(s); s2 = wave_sum(s2); if (F.lane == 0) { ssq[m] = s; if (m2 < M) ssq[m2] = s2; }
        GAS unsigned long long* o8 = (GAS unsigned long long*)(XB + (size_t)m * D) + F.lane;
#pragma unroll
        for (int j = 0; j < 4; ++j) o8[64 * j] = (unsigned long long)pk2(v[j].x, v[j].y) | ((unsigned long long)pk2(v[j].z, v[j].w) << 32);
        if (m2 < M) { GAS unsigned long long* p8 = (GAS unsigned long long*)(XB + (size_t)m2 * D) + F.lane;
#pragma unroll
            for (int j = 0; j < 4; ++j) p8[64 * j] = (unsigned long long)pk2(w[j].x, w[j].y) | ((unsigned long long)pk2(w[j].z, w[j].w) << 32); } }
}

constexpr int HC = 64, NCH = T / HC;
constexpr int H_KD = 0, H_QE = 0, H_QM = 17408, H_KM = 34816, H_VT = 52224, H_AM = 70656, H_OS = 79872, H_TOT = 113664, H_BM = 115712;
__device__ __forceinline__ f32x16 mfma32(bf16x8 a, bf16x8 b, f32x16 c) { return __builtin_amdgcn_mfma_f32_32x32x16_bf16(a, b, c, 0, 0, 0); }
#define HBAR() asm volatile("s_waitcnt lgkmcnt(0)\n\ts_barrier" ::: "memory")
#define HGRN_ITEM(it_) const int bh = (it_) >> 7, c = (it_) & 127, b = bh >> 2, h = bh & 3; const int m0 = b * T + c * HC; (void)c; (void)m0;
#define HGRN_LD16F(dst, base) { const float* p_ = (base) + (size_t)(m0 + part * 16) * 512 + h * 128 + k; _Pragma("unroll") for (int i = 0; i < 16; ++i) dst[i] = p_[(size_t)i * 512]; }
#define HGRN_LD16H(dst, base) { const bf16* p_ = (base) + (size_t)(m0 + part * 16) * 512 + h * 128 + k; _Pragma("unroll") for (int i = 0; i < 16; ++i) dst[i] = p_[(size_t)i * 512]; }
#define HGRN_SCAN(lfv, bv, blast)  \
    float bv[16]; float blast, bmid_; { \
      float run = 0.f; _Pragma("unroll") for (int i = 0; i < 16; ++i) { run += lfv[i]; bv[i] = run; } \
      LAS float* TOT = (LAS float*)(F.lds + H_TOT); TOT[part * 128 + k] = run; HBAR(); \
      const float t0 = TOT[k], t1 = TOT[128 + k], t2 = TOT[256 + k], t3 = TOT[384 + k]; \
      const float off = (part > 0 ? t0 : 0.f) + (part > 1 ? t1 : 0.f) + (part > 2 ? t2 : 0.f); blast = (t0 + t1) + (t2 + t3); bmid_ = t0 + t1; \
      _Pragma("unroll") for (int i = 0; i < 16; ++i) bv[i] += off; }
#define HGRN_VT_STORE(vw) { unsigned w_[8]; _Pragma("unroll") for (int i = 0; i < 8; ++i) w_[i] = (unsigned)vw[2 * i] | ((unsigned)vw[2 * i + 1] << 16); \
      LAS v4u* d_ = (LAS v4u*)(F.lds + H_VT + k * 144 + part * 32); d_[0] = (v4u){w_[0], w_[1], w_[2], w_[3]}; d_[1] = (v4u){w_[4], w_[5], w_[6], w_[7]}; }
__device__ __forceinline__ int pa_next(int it, int vcu, int G) {
    if (G != 256) return it + G;
    const int nx = it + 256;
    if (vcu < 16) return (nx >= 512) ? 8 * NCH : nx;
    if (vcu < 48) { if ((it & 255) != vcu) return 8 * NCH;
                    if (nx < 8 * NCH) return nx;
                    return (vcu < 32) ? vcu - 16 + 512 : vcu - 32 + 768; }
    return nx;
}
template <class ScanFn>
__device__ __forceinline__ void hgrn_pass_a(Frame& F, const bf16* lf, const bf16* hv, bf16* ST, float* DL, const ScanFn& scan) {
    const int k = F.tid & 127, part = F.tid >> 7, l31 = F.lane & 31, hi = F.lane >> 5;
    unsigned short nlf[16], nvw[16];
    if (F.vcu < 8 * NCH) { HGRN_ITEM(F.vcu) HGRN_LD16H(nlf, lf) HGRN_LD16H(nvw, hv) }
    scan();
    for (int it = F.vcu; it < 8 * NCH; it = pa_next(it, F.vcu, F.G)) {
        float lfv[16]; unsigned short vw[16];
#pragma unroll
        for (int i = 0; i < 16; ++i) { lfv[i] = bf2f(nlf[i]); vw[i] = nvw[i]; }
        { const int nit = pa_next(it, F.vcu, F.G); if (nit < 8 * NCH) { HGRN_ITEM(nit) HGRN_LD16H(nlf, lf) HGRN_LD16H(nvw, hv) } }
        HGRN_ITEM(it)
        HGRN_SCAN(lfv, bv, blast)
        (void)bmid_;
        { unsigned w_[8];
#pragma unroll
          for (int i = 0; i < 8; ++i) { const float a0 = (1.0f - __expf(lfv[2 * i])) * __expf(blast - bv[2 * i]), a1 = (1.0f - __expf(lfv[2 * i + 1])) * __expf(blast - bv[2 * i + 1]); w_[i] = pk2(a0, a1); }
          LAS v4u* d_ = (LAS v4u*)(F.lds + H_KD + k * 144 + part * 32); d_[0] = (v4u){w_[0], w_[1], w_[2], w_[3]}; d_[1] = (v4u){w_[4], w_[5], w_[6], w_[7]}; }
        if (part == 0) DL[(size_t)it * 128 + k] = __expf(blast);
        HGRN_VT_STORE(vw)
        HBAR();
        const int mt = F.wave >> 1, nt0 = (F.wave & 1) * 2; f32x16 a0 = {}, a1 = {};
#pragma unroll
        for (int ks = 0; ks < 4; ++ks) { const bf16x8 av = *(const LAS bf16x8*)(F.lds + H_VT + (32 * mt + l31) * 144 + (16 * ks + 8 * hi) * 2);
            const bf16x8 b0 = *(const LAS bf16x8*)(F.lds + H_KD + (32 * nt0 + l31) * 144 + (16 * ks + 8 * hi) * 2), b1 = *(const LAS bf16x8*)(F.lds + H_KD + (32 * nt0 + 32 + l31) * 144 + (16 * ks + 8 * hi) * 2);
            a0 = mfma32(av, b0, a0); a1 = mfma32(av, b1, a1); }
        bf16* U = ST + (size_t)it * 16384;
#pragma unroll
        for (int r = 0; r < 16; ++r) { const int v = 32 * mt + crow16(r, hi); U[v * 128 + 32 * nt0 + l31] = (bf16)f2bf(a0[r]); U[v * 128 + 32 * nt0 + 32 + l31] = (bf16)f2bf(a1[r]); }
    }
    HBAR();
}
__device__ __forceinline__ void hgrn_pass_b_item(Frame& F, bf16* ST, const float* DL, int item) {
    int tid_ = F.tid; asm volatile("" : "+v"(tid_));
    const int e = item * NTHREADS + tid_, bh = e >> 14, rem = e & 16383, k = rem & 127;
    bf16* up = ST + (size_t)bh * NCH * 16384 + rem; const float* dp = DL + (size_t)bh * NCH * 128 + k;
    float s = 0.f; unsigned short ua[16], ub[16]; float da[16], db[16];
#define PB_LOAD(u_, d_, c0_) { _Pragma("unroll") for (int j = 0; j < 16; ++j) { u_[j] = up[(size_t)((c0_) + j) * 16384]; d_[j] = dp[((c0_) + j) * 128]; } }
#define PB_PROC(u_, d_, c0_) { _Pragma("unroll") for (int j = 0; j < 16; ++j) { up[(size_t)((c0_) + j) * 16384] = (bf16)f2bf(s); s = d_[j] * s + bf2f(u_[j]); } }
    PB_LOAD(ua, da, 0)
#pragma unroll 1
    for (int c0 = 0; c0 < NCH; c0 += 32) {
        PB_LOAD(ub, db, c0 + 16)
        PB_PROC(ua, da, c0)
        if (c0 + 32 < NCH) PB_LOAD(ua, da, c0 + 32)
        PB_PROC(ub, db, c0 + 16)
    }
#undef PB_LOAD
#undef PB_PROC
}
__device__ __forceinline__ void hgrn_pass_c(Frame& F, const bf16* hq, const bf16* lf, const bf16* hv, const bf16* hg, const bf16* ST, const float* nw, bf16* mix) {
    const int k = F.tid & 127, part = F.tid >> 7, l31 = F.lane & 31, hi = F.lane >> 5;
    const int mt = F.wave >> 2, nt = F.wave & 3; const int t_o = F.tid >> 3, seg_o = F.tid & 7;
#define HGRN_C_LOADS(it_) { HGRN_ITEM(it_) HGRN_LD16H(nlf, lf) HGRN_LD16H(nqw, hq) HGRN_LD16H(nvw, hv) \
      { const bf16* sp = ST + (size_t)(it_) * 16384 + (size_t)(32 * nt + l31) * 128 + 8 * hi; _Pragma("unroll") for (int ks = 0; ks < 8; ++ks) nsf[ks] = *(const bf16x8*)(sp + 16 * ks); } \
      ng0 = *(const v4u*)(hg + (size_t)(m0 + t_o) * 512 + h * 128 + seg_o * 16); ng1 = *(const v4u*)(hg + (size_t)(m0 + t_o) * 512 + h * 128 + seg_o * 16 + 8); }
    unsigned short nlf[16], nqw[16], nvw[16]; bf16x8 nsf[8]; v4u ng0, ng1;
    f32x4 nwv[4];
#pragma unroll
    for (int j = 0; j < 4; ++j) nwv[j] = *(const f32x4*)(nw + seg_o * 16 + 4 * j);
    if (F.vcu < 8 * NCH) HGRN_C_LOADS(F.vcu)
    for (int it = F.vcu; it < 8 * NCH; it += F.G) {
        float lfv[16]; unsigned short qw_[16], vw[16]; bf16x8 sfr[8];
#pragma unroll
        for (int i = 0; i < 16; ++i) { lfv[i] = bf2f(nlf[i]); qw_[i] = nqw[i]; vw[i] = nvw[i]; }
#pragma unroll
        for (int i = 0; i < 8; ++i) sfr[i] = nsf[i];
        const v4u g0 = ng0, g1 = ng1;
        if (it + F.G < 8 * NCH) HGRN_C_LOADS(it + F.G)
        HGRN_ITEM(it)
        HGRN_SCAN(lfv, bv, blast)
        (void)blast;
        const float bm = bmid_;
        {
#pragma unroll
          for (int i = 0; i < 16; ++i) { const int t = part * 16 + i; const float q = bf2f(qw_[i]);
              *(LAS bf16*)(F.lds + H_QE + t * 272 + k * 2) = (bf16)f2bf(q * __expf(bv[i]));
              *(LAS bf16*)(F.lds + H_QM + t * 272 + k * 2) = (bf16)f2bf(q * __expf(fminf(bv[i] - bm, 80.f)));
              *(LAS bf16*)(F.lds + H_KM + t * 272 + k * 2) = (bf16)f2bf((1.0f - __expf(lfv[i])) * __expf(fminf(bm - bv[i], 80.f))); } }
        HGRN_VT_STORE(vw)
        HBAR();
        f32x16 acc = {};
        {
#pragma unroll
          for (int ks = 0; ks < 8; ++ks) { const bf16x8 av = *(const LAS bf16x8*)(F.lds + H_QE + (32 * mt + l31) * 272 + (16 * ks + 8 * hi) * 2); acc = mfma32(av, sfr[ks], acc); } }
        if (F.wave < 4) { const int mt2 = F.wave >> 1, nt2 = F.wave & 1; f32x16 am = {};
#pragma unroll
            for (int ks = 0; ks < 8; ++ks) { const bf16x8 av = *(const LAS bf16x8*)(F.lds + H_QM + (32 * mt2 + l31) * 272 + (16 * ks + 8 * hi) * 2), bvv = *(const LAS bf16x8*)(F.lds + H_KM + (32 * nt2 + l31) * 272 + (16 * ks + 8 * hi) * 2); am = mfma32(av, bvv, am); }
#pragma unroll
            for (int r = 0; r < 16; ++r) { const int t = 32 * mt2 + crow16(r, hi), s = 32 * nt2 + l31; *(LAS bf16*)(F.lds + H_AM + t * 144 + s * 2) = (bf16)f2bf(s <= t ? am[r] : 0.f); } }
        HBAR();
#pragma unroll
        for (int ks = 0; ks < 4; ++ks) { const bf16x8 av = *(const LAS bf16x8*)(F.lds + H_AM + (32 * mt + l31) * 144 + (16 * ks + 8 * hi) * 2), bvv = *(const LAS bf16x8*)(F.lds + H_VT + (32 * nt + l31) * 144 + (16 * ks + 8 * hi) * 2); acc = mfma32(av, bvv, acc); }
#pragma unroll
        for (int r = 0; r < 16; ++r) *(LAS float*)(F.lds + H_OS + (32 * mt + crow16(r, hi)) * 528 + (32 * nt + l31) * 4) = acc[r];
        HBAR();
        { const int t = t_o, seg = seg_o; f32x4 o[4]; float ss = 0.f;
#pragma unroll
          for (int j = 0; j < 4; ++j) { o[j] = *(const LAS f32x4*)(F.lds + H_OS + t * 528 + (seg * 16 + 4 * j) * 4); ss += (o[j][0] * o[j][0] + o[j][1] * o[j][1]) + (o[j][2] * o[j][2] + o[j][3] * o[j][3]); }
          ss += __shfl_xor(ss, 1); ss += __shfl_xor(ss, 2); ss += __shfl_xor(ss, 4);
          const float rs = rsqrtf(ss * (1.0f / 128.0f) + 1e-6f);
          const unsigned gw_[8] = {g0.x, g0.y, g0.z, g0.w, g1.x, g1.y, g1.z, g1.w}; unsigned w_[8];
#pragma unroll
          for (int j = 0; j < 4; ++j) { const f32x4 wv = nwv[j];
              const float e0 = o[j][0] * rs * wv[0] * bf2f((unsigned short)(gw_[2 * j] & 0xffffu)), e1 = o[j][1] * rs * wv[1] * bf2f((unsigned short)(gw_[2 * j] >> 16));
              const float e2 = o[j][2] * rs * wv[2] * bf2f((unsigned short)(gw_[2 * j + 1] & 0xffffu)), e3 = o[j][3] * rs * wv[3] * bf2f((unsigned short)(gw_[2 * j + 1] >> 16));
              w_[2 * j] = pk2(e0, e1); w_[2 * j + 1] = pk2(e2, e3); }
          v4u* op = (v4u*)(mix + (size_t)(m0 + t) * 1024 + h * 128 + seg * 16); op[0] = (v4u){w_[0], w_[1], w_[2], w_[3]}; op[1] = (v4u){w_[4], w_[5], w_[6], w_[7]}; }
    }
    HBAR();
#undef HGRN_C_LOADS
}
#ifndef PROBE_LO
#define PROBE_LO -1
#define PROBE_HI -1
#define PROBE_BLK 0
#endif
#ifndef REP_MASK
#define REP_MASK 0
#endif
#define RLX_AGENT __ATOMIC_RELAXED, __HIP_MEMORY_SCOPE_AGENT
#define XB_TMO      128
#define XB_XCNT(j)  (256  + 64 * (j))
#define XB_XSUB(j)  (1280 + 64 * (j))
#define XB_XGEN(j)  (2304 + 64 * (j))
#define XB_TOP      3328
#define XB_TOPGEN   3392
#define XCD_BAR_WORDS 3456
#define XB_SPIN_CAP (1u << 18)

__device__ __forceinline__ unsigned xb_ld(unsigned* p)              { return __hip_atomic_load(p, __ATOMIC_RELAXED, __HIP_MEMORY_SCOPE_AGENT); }
__device__ __forceinline__ unsigned xb_add(unsigned* p, unsigned v) { return __hip_atomic_fetch_add(p, v, __ATOMIC_RELAXED, __HIP_MEMORY_SCOPE_AGENT); }
__device__ __forceinline__ unsigned xb_xcc_id() { return (unsigned)__builtin_amdgcn_s_getreg((3 << 11) | 20) & 0xFu; }
#define XB_SPIN(cond, bar) do { unsigned _sp = 0; while (cond) { __builtin_amdgcn_s_sleep(1); \
    if ((++_sp & 255u) == 0u) { if (xb_ld(&(bar)[XB_TMO])) break; if (_sp > XB_SPIN_CAP) { atomicAdd(&(bar)[XB_TMO], 1u); break; } } } } while (0)

struct XcdBarrier {
    unsigned* bar; unsigned x;
    volatile LAS unsigned* st;
};

__device__ __forceinline__ XcdBarrier xcd_barrier_post(unsigned* bar, volatile LAS unsigned* st) {
    XcdBarrier b; b.bar = bar; b.x = xb_xcc_id(); b.st = st;
    if (threadIdx.x == 0) (void)xb_add(&bar[XB_XCNT(b.x)], 1u);
    return b;
}
__device__ __forceinline__ void xcd_barrier_complete(unsigned* bar, unsigned x, unsigned& nloc, unsigned& nx) {
    const unsigned G = gridDim.x * gridDim.y * gridDim.z;
    unsigned sum, cnt, mine, sp = 0u;
    for (;;) {
        sum = 0u; cnt = 0u; mine = 0u;
#pragma unroll
        for (unsigned j = 0; j < 16; ++j) { const unsigned c = xb_ld(&bar[XB_XCNT(j)]); sum += c; cnt += (c > 0u) ? 1u : 0u; mine = (j == x) ? c : mine; }
        if (sum == G) break;
        __builtin_amdgcn_s_sleep(1);
        if ((++sp & 255u) == 0u) { if (xb_ld(&bar[XB_TMO])) break; if (sp > XB_SPIN_CAP) { atomicAdd(&bar[XB_TMO], 1u); break; } }
    }
    nloc = mine > 0u ? mine : 1u; nx = cnt > 0u ? cnt : 1u;
}

__device__ __forceinline__ void xcd_barrier(const XcdBarrier& b) {
    asm volatile("s_waitcnt vmcnt(0)" ::: "memory");
    __syncthreads();
    if (threadIdx.x == 0) {
        unsigned* bar = b.bar;
        __builtin_amdgcn_s_waitcnt(0);
        unsigned nloc = b.st[0], nx = b.st[1];
        if (nloc == 0u) { xcd_barrier_complete(bar, b.x, nloc, nx); b.st[0] = nloc; b.st[1] = nx; }
        const unsigned old = xb_add(&bar[XB_XSUB(b.x)], 1u);
        const unsigned gen = old / nloc;
        if (old + 1u == (gen + 1u) * nloc) {
            __builtin_amdgcn_fence(__ATOMIC_RELEASE, "agent");
            asm volatile("s_waitcnt vmcnt(0)" ::: "memory");
            const unsigned og = xb_add(&bar[XB_TOP], 1u);
            const unsigned tg = og / nx;
            if (og + 1u == (tg + 1u) * nx) xb_add(&bar[XB_TOPGEN], 1u);
            else XB_SPIN(xb_ld(&bar[XB_TOPGEN]) == tg, bar);
            __builtin_amdgcn_fence(__ATOMIC_ACQUIRE, "agent");
            xb_add(&bar[XB_XGEN(b.x)], 1u);
            asm volatile("s_waitcnt vmcnt(0)" ::: "memory");
        } else {
            XB_SPIN(xb_ld(&bar[XB_XGEN(b.x)]) == gen, bar);
            __builtin_amdgcn_fence(__ATOMIC_ACQUIRE, "agent");
            asm volatile("s_waitcnt vmcnt(0)" ::: "memory");
        }
    }
    __syncthreads();
}

#ifndef FOX_SKIP
#define FOX_SKIP 1
#endif
__device__ __forceinline__ void fox_scan(Frame& F, const float* lsig, float* DKG, int* NTG, const float* qnw, const float* knw) {
    LAS double* wtot = (LAS double*)(F.lds + attn_body::LDS_WS);
    LAS float* dk = (LAS float*)(F.lds + attn_body::LDS_DK);
    for (int bh = F.vcu; bh < 16; bh += F.G) {
        const int b = bh >> 3, h = bh & 7;
        const float* lp = lsig + ((size_t)b * T + F.tid * 16) * 8 + h; double v[16]; double run = 0.0;
#pragma unroll
        for (int i = 0; i < 16; ++i) { run -= (double)lp[i * 8]; v[i] = run; }
        double inc = run;
#pragma unroll
        for (int o = 1; o < 64; o <<= 1) { const double t = __shfl_up(inc, o); if (F.lane >= o) inc += t; }
        if (F.lane == 63) wtot[F.wave] = inc;
        if (F.wave == 0) { float mq = fabsf(qnw[F.lane]), mk = fabsf(knw[F.lane]);
#pragma unroll
            for (int o = 1; o < 64; o <<= 1) { mq = fmaxf(mq, __shfl_xor(mq, o)); mk = fmaxf(mk, __shfl_xor(mk, o)); }
            if (F.lane == 0) *(LAS float*)(wtot + 8) = 158.0f + 2.0f * 11.66f * mq * mk + 1.0f; }
        __syncthreads();
        double off = inc - run;
        for (int w = 0; w < F.wave; ++w) off += wtot[w];
        f32x4* dst = (f32x4*)(DKG + (size_t)bh * T + F.tid * 16); LAS f32x4* dl = (LAS f32x4*)(dk + F.tid * 16);
#pragma unroll
        for (int i = 0; i < 4; ++i) { const f32x4 o4 = (f32x4){(float)((v[4 * i] + off) * 1.4426950408889634), (float)((v[4 * i + 1] + off) * 1.4426950408889634), (float)((v[4 * i + 2] + off) * 1.4426950408889634), (float)((v[4 * i + 3] + off) * 1.4426950408889634)}; dst[i] = o4; dl[i] = o4; }
        __syncthreads();
        if (F.tid < 32) { const int qb = F.tid, NTA = 4 * qb + 4; int NT = NTA;
            const float TH = *(LAS float*)(wtot + 8);
#if FOX_SKIP
            { const float ref = dk[qb * 256]; int lo = 0, hi_ = NTA - 4;
              while (lo < hi_) { const int mid = (lo + hi_) >> 1; if (dk[64 * mid + 63] - ref < -TH) lo = mid + 1; else hi_ = mid; }
              int nold = (NTA - 4) - lo; nold += (nold & 1); NT = 4 + nold; }
#endif
            (void)TH; NTG[bh * 32 + qb] = NT; }
        __syncthreads();
    }
}
__device__ __forceinline__ void fox_queue_phase(unsigned long long& ts0, unsigned long long& ts1, Frame& F, unsigned char* lds_generic, unsigned* queue, const int* NTG, const float* DKG, const bf16* Q, const bf16* Kb, const bf16* V, bf16* mix, bf16* ST, const float* DL) {
    using attn_body::LDS_DK; using attn_body::attn_unit;
    LAS float* dk = (LAS float*)(F.lds + LDS_DK);
    volatile LAS int* qslot = (volatile LAS int*)(F.lds + 131072 + 128);
    LAS int* cost = (LAS int*)(F.lds + 131072 + 256); LAS int* order = cost + 512;
    if (F.tid == 0) qslot[0] = (int)__hip_atomic_fetch_add(queue, 1u, __ATOMIC_RELAXED, __HIP_MEMORY_SCOPE_AGENT);
    { int tid_ = F.tid; asm volatile("" : "+v"(tid_)); const int mine = NTG[tid_]; cost[tid_] = mine; __syncthreads();
      int rk = 0; typedef int i32x4 __attribute__((ext_vector_type(4)));
#pragma unroll 4
      for (int v = 0; v < 512; v += 4) { const i32x4 c = *(const LAS i32x4*)(cost + v);
          rk += (c.x > mine || (c.x == mine && v < tid_)) ? 1 : 0; rk += (c.y > mine || (c.y == mine && v + 1 < tid_)) ? 1 : 0;
          rk += (c.z > mine || (c.z == mine && v + 2 < tid_)) ? 1 : 0; rk += (c.w > mine || (c.w == mine && v + 3 < tid_)) ? 1 : 0; }
      order[rk] = tid_; }
    __syncthreads();
    for (;;) {
        const int u = qslot[0];
        if (u >= 768) break;
        int nxt = 0;
        if (F.tid == 0) nxt = (int)__hip_atomic_fetch_add(queue, 1u, __ATOMIC_RELAXED, __HIP_MEMORY_SCOPE_AGENT);
        if (u < 512) {
            const int unit = order[u], bh = unit >> 5, qb = unit & 31, b = bh >> 3, h = bh & 7, NT = cost[unit], NTA = 4 * qb + 4;
            if (PROBE_LO == 101) ts0 = __builtin_amdgcn_s_memrealtime();
            attn_unit<8>(b, h, qb, NT, DKG + (size_t)bh * T, (const attn_body::bf16*)Q, (const attn_body::bf16*)Kb, (const attn_body::bf16*)V, (attn_body::bf16*)(mix + 512), (char*)lds_generic);
            if (PROBE_LO == 101) { ts1 = __builtin_amdgcn_s_memrealtime(); ts0 = ts1 - (ts1 - ts0) / (unsigned)NT * 16u; }
        } else {
            if (PROBE_LO == 100) ts0 = __builtin_amdgcn_s_memrealtime();
            hgrn_pass_b_item(F, ST, DL, u - 512);
            if (PROBE_LO == 100) { asm volatile("s_waitcnt vmcnt(0)" ::: "memory"); ts1 = __builtin_amdgcn_s_memrealtime(); }
        }
        __syncthreads();
        if (F.tid == 0) qslot[0] = nxt;
        __syncthreads();
    }
}

struct Args { Ptrs p; int ph_lo, ph_hi; };
constexpr int N_PHASES = 1 + 7 * DEPTH;
__global__ void __launch_bounds__(NTHREADS, 2) hymba_fwd(Args args) {
    extern __shared__ __attribute__((aligned(16))) unsigned char lds[];
    Frame F; F.lds = (LAS unsigned char*)lds; F.tid = threadIdx.x; F.lane = F.tid & 63; F.wave = __builtin_amdgcn_readfirstlane(F.tid >> 6);
    F.G = gridDim.x; { const int bx = blockIdx.x; F.vcu = (F.G % 8 == 0) ? (bx % 8) * (F.G / 8) + bx / 8 : bx; }
    const Ptrs& P = args.p;
    const int lo = args.ph_lo, hi = args.ph_hi;
    volatile LAS unsigned* bst = (volatile LAS unsigned*)(F.lds + 131072 + 64);
    if (F.tid < 2) bst[F.tid] = 0u;
    __syncthreads();
    XcdBarrier bar; bar.bar = (unsigned*)(P.ws + WS_CTL + 16384); bar.x = 0; bar.st = bst;
    if (hi - lo > 1) bar = xcd_barrier_post((unsigned*)(P.ws + WS_CTL + 16384), bst);
#define PHASE_ENV() int t__ = threadIdx.x; asm volatile("" : "+v"(t__)); F.tid = t__; F.lane = t__ & 63; unsigned char* ws = P.ws; asm volatile("" : "+s"(ws)); \
    float* ssq = (float*)(ws + WS_SSQ); float* lsig = (float*)(ws + WS_LSIG); \
    bf16* XB = (bf16*)(ws + WS_XB); bf16* ST = (bf16*)(ws + WS_ST); float* DL = (float*)(ws + WS_DL); float* DKG = (float*)(ws + WS_DL + 512 * 1024); (void)DKG; int* NTGp = (int*)(ws + WS_DL + 1024 * 1024); (void)NTGp; \
    bf16* HQ = (bf16*)(ws + WS_HQ); bf16* LF = (bf16*)(ws + WS_LF); bf16* HV = (bf16*)(ws + WS_HV); bf16* HG = (bf16*)(ws + WS_HG); \
    bf16* Qb = (bf16*)(ws + WS_Q); bf16* Kb = (bf16*)(ws + WS_K); bf16* Vb = (bf16*)(ws + WS_V); bf16* HB = (bf16*)(ws + WS_H); \
    (void)ssq; (void)lsig; (void)XB; (void)ST; (void)DL; (void)HQ; (void)LF; (void)HV; (void)HG; (void)Qb; (void)Kb; (void)Vb; (void)HB;
#define IN(k) (lo <= (k) && (k) < hi)
    unsigned long long ts0 = 0, ts1 = 0;
#define STAMP(k) do { if (PROBE_LO >= 0) { if ((k) == PROBE_LO) ts0 = __builtin_amdgcn_s_memrealtime(); if ((k) == PROBE_HI) ts1 = __builtin_amdgcn_s_memrealtime(); } } while (0)
    STAMP(0);
#define SEAM(k) do { if (IN(k) && IN((k) + 1)) { if (lo == -12345) cg::this_grid().sync(); else { if (PROBE_LO == 110 + (k)) ts0 = __builtin_amdgcn_s_memrealtime(); xcd_barrier(bar); if (PROBE_LO == 110 + (k)) ts1 = __builtin_amdgcn_s_memrealtime(); if (REP_MASK & 64) { xcd_barrier(bar); xcd_barrier(bar); } } } STAMP((k) + 1); } while (0)
    if (IN(0)) { PHASE_ENV() p0_prologue(F, P); if (REP_MASK & 1) { __syncthreads(); p0_prologue(F, P); } }
    SEAM(0);
#pragma unroll 1
    for (int l = 0; l < DEPTH; ++l) {
        const int pb = 1 + 7 * l;
        if (IN(pb)) { PHASE_ENV()
            pg8::Gemm g{l == 0 ? XB : (const bf16*)P.out, (const bf16*)(ws + WS_WIN + l * WIN_BYTES), M, NIN, D}; pg8::StaticOrder S; S.init(M, NIN, F.G, (int)blockIdx.x);
            pg8::EpiIn E{ssq + (size_t)(2 * l) * M, HQ, HV, HG, Qb, Kb, Vb, LF, lsig, P.lower_bounds, P.lower_bounds + 512, l, P.q_norm_w + l * 64, P.k_norm_w + l * 64, P.fox_f_bias + l * 8};
            pg8::gemm_phase<pg8::EpiIn, pg8::StaticOrder, true, true, PROBE_LO == 102>(F.lds, g, S, E, ts1);
            if (REP_MASK & 2) pg8::gemm_phase<pg8::EpiIn, pg8::StaticOrder, true, true>(F.lds, g, S, E, ts1);
        }
        SEAM(pb);
        if (IN(pb + 1)) { PHASE_ENV()
            struct ScanCall { Frame& F; const float* lsig; float* DKG; int* NTG; const float* qw; const float* kw;
                __device__ __forceinline__ void operator()() const { fox_scan(F, lsig, DKG, NTG, qw, kw); } };
            hgrn_pass_a(F, LF, HV, ST, DL, ScanCall{F, lsig, DKG, NTGp, P.q_norm_w + l * 64, P.k_norm_w + l * 64});
        }
        SEAM(pb + 1);
        if (IN(pb + 2)) { PHASE_ENV()
            fox_queue_phase(ts0, ts1, F, lds, (unsigned*)(ws + WS_CTL + 40960) + 64 * l, NTGp, DKG, Qb, Kb, Vb, XB, ST, DL);
        }
        SEAM(pb + 2);
        if (IN(pb + 3)) { PHASE_ENV() hgrn_pass_c(F, HQ, LF, HV, HG, ST, P.hgrn_norm_w + l * 128, XB); if (REP_MASK & 16) hgrn_pass_c(F, HQ, LF, HV, HG, ST, P.hgrn_norm_w + l * 128, XB); }
        SEAM(pb + 3);
        if (IN(pb + 4)) { PHASE_ENV()
            pg8::Gemm g{XB, (const bf16*)(ws + WS_WOUT + l * 2 * MiB), M, D, D}; pg8::StaticOrder S; S.init(M, D, F.G, (int)blockIdx.x);
            bf16* X2 = (bf16*)P.out;
            pg8::EpiRes E{l == 0 ? P.x : nullptr, l == 0 ? nullptr : X2, nullptr, ST, ssq + (size_t)(2 * l + 1) * M};
            pg8::gemm_phase<pg8::EpiRes, pg8::StaticOrder, true, true>(F.lds, g, S, E, ts1);
        }
        SEAM(pb + 4);
        if (IN(pb + 5)) { PHASE_ENV()
            pg8::Gemm g{ST, (const bf16*)(ws + WS_WUP + l * 8 * MiB), M, FF, D}; pg8::StaticOrder S; S.init(M, FF, F.G, (int)blockIdx.x);
            pg8::EpiUp E{ssq + (size_t)(2 * l + 1) * M, HB};
            pg8::gemm_phase<pg8::EpiUp, pg8::StaticOrder, true, true, PROBE_LO == 103>(F.lds, g, S, E, ts1);
            if (REP_MASK & 32) pg8::gemm_phase<pg8::EpiUp, pg8::StaticOrder, true, true>(F.lds, g, S, E, ts1);
        }
        SEAM(pb + 5);
        if (IN(pb + 6)) { PHASE_ENV()
            pg8::Gemm g{HB, (const bf16*)(ws + WS_WDN + l * 8 * MiB), M, D, FF}; pg8::StaticOrder S; S.init(M, D, F.G, (int)blockIdx.x);
            const bool last = (l == DEPTH - 1);
            pg8::EpiRes E{nullptr, ST, last ? P.out : nullptr, last ? nullptr : (bf16*)P.out, last ? nullptr : ssq + (size_t)(2 * l + 2) * M};
            pg8::gemm_phase<pg8::EpiRes, pg8::StaticOrder, true, true>(F.lds, g, S, E, ts1);
        }
        SEAM(pb + 6);
    }
    if (PROBE_LO >= 0 && hi - lo > 1) {
        if (PROBE_HI == N_PHASES) ts1 = __builtin_amdgcn_s_memrealtime();
        xcd_barrier(bar);
        if (blockIdx.x == PROBE_BLK) { int n = (int)((ts1 - ts0) / 10ull); if (n < 0 || n > 100000) n = 100000; for (int i = F.tid; i < n; i += NTHREADS) P.out[i] += 0.125f; }
    }
#undef IN
#undef SEAM
}

#ifndef MK_PER_PHASE
#define MK_PER_PHASE 0
#endif
extern "C" void kernel_launch(void* const* d_in, const int* in_sizes, int n_in, void* d_out, int out_size, void* d_ws, size_t ws_size, hipStream_t stream) {
    static int grid = 0;
    if (grid == 0) {
        if (n_in != 12 || out_size != M * D || ws_size < WS_DL + 2 * MiB) { fprintf(stderr, "kernel_launch: unexpected sizes (n_in %d out %d ws %zu)\n", n_in, out_size, ws_size); grid = -1; return; }
        int dev = 0, cus = 0, per_cu = 0;
        (void)hipGetDevice(&dev); (void)hipDeviceGetAttribute(&cus, hipDeviceAttributeMultiprocessorCount, dev);
        if (hipFuncSetAttribute((const void*)hymba_fwd, hipFuncAttributeMaxDynamicSharedMemorySize, LDS_BYTES) != hipSuccess) { fprintf(stderr, "kernel_launch: hipFuncSetAttribute failed\n"); grid = -1; return; }
        if (hipOccupancyMaxActiveBlocksPerMultiprocessor(&per_cu, (const void*)hymba_fwd, NTHREADS, LDS_BYTES) != hipSuccess || per_cu < 1) { fprintf(stderr, "kernel_launch: occupancy query gave %d\n", per_cu); per_cu = 1; }
        (void)hipGetLastError();
        grid = cus * 1;
        fprintf(stderr, "kernel_launch: cus %d per_cu %d grid %d\n", cus, per_cu, grid);
    }
    if (grid < 0) return;
    (void)hipMemsetAsync((char*)d_ws + WS_CTL, 0, CTL_ZERO_BYTES, stream);
    Args a{};
    a.p.x = (const float*)d_in[0]; a.p.lower_bounds = (const float*)d_in[1]; a.p.norm1_w = (const float*)d_in[2]; a.p.w_in = (const float*)d_in[3];
    a.p.fox_f_bias = (const float*)d_in[4]; a.p.q_norm_w = (const float*)d_in[5]; a.p.k_norm_w = (const float*)d_in[6]; a.p.hgrn_norm_w = (const float*)d_in[7];
    a.p.w_out = (const float*)d_in[8]; a.p.norm2_w = (const float*)d_in[9]; a.p.w_up = (const float*)d_in[10]; a.p.w_down = (const float*)d_in[11];
    a.p.out = (float*)d_out; a.p.ws = (unsigned char*)d_ws;
#if MK_PER_PHASE
    for (int ph = 0; ph < N_PHASES; ++ph) { a.ph_lo = ph; a.ph_hi = ph + 1; hipLaunchKernelGGL(hymba_fwd, dim3(grid), dim3(NTHREADS), LDS_BYTES, stream, a); }
#else
    a.ph_lo = 0; a.ph_hi = N_PHASES;
    void* kargs[] = {&a};
    const hipError_t e = hipLaunchCooperativeKernel((const void*)hymba_fwd, dim3(grid), dim3(NTHREADS), kargs, LDS_BYTES, stream);
    if (e != hipSuccess) fprintf(stderr, "kernel_launch: cooperative launch failed: %s (grid %d)\n", hipGetErrorString(e), grid);
#endif
}
```

```cpp
#include <hip/hip_runtime.h>
#include <hip/hip_cooperative_groups.h>
#include <cstdio>
#include <cstdint>
namespace cg = cooperative_groups;
namespace pg8 {
#define PG8_LAS __attribute__((address_space(3)))
typedef unsigned short bf16_t;
typedef short bf16x8 __attribute__((ext_vector_type(8)));
typedef float f32x4 __attribute__((ext_vector_type(4)));
typedef unsigned u32x4 __attribute__((ext_vector_type(4)));
constexpr int BM = 256, BK = 64, HALF = 128, HTB = HALF * BK * 2  , STAGE_BYTES = 8 * HTB, NXCD = 8, WGM = 8;

__host__ __device__ __forceinline__ int lds_byte(int r, int c) { const int st = (r >> 4) * 2 + (c >> 5), rr = r & 15, cc = c & 31, ob = rr * 64 + cc * 2; return st * 1024 + (ob ^ (((ob >> 9) & 1) << 5)); }
__host__ __device__ __forceinline__ void stage_rc(int b, int& R, int& C) { const int st = b / 1024, sb = b % 1024, swz = sb ^ (((sb >> 9) & 1) << 5); R = (st >> 1) * 16 + swz / 64; C = (st & 1) * 32 + (swz % 64) / 2; }
__host__ __device__ __forceinline__ int perm32(int rho) { const int n = rho >> 4, i = rho & 15; return 8 * (i >> 2) + 4 * n + (i & 3); }

struct Unit { int pm, pn; };
struct Gemm { const bf16_t* A; const bf16_t* Bt; int M, N, K; };

struct StaticOrder {
    int nM, nN, nwg, G, c;
    __host__ __device__ void init(int M, int N, int G_, int c_) { nM = M / BM; nN = N / BM; nwg = nM * nN; G = G_; c = c_; }
    __host__ __device__ bool next(int i, Unit& u) const {
        const long L = (long)i * G + c; if (L >= nwg) return false;
        int wgid = (int)L; { const int q = nwg / NXCD, r = nwg % NXCD, xcd = wgid % NXCD, off = wgid / NXCD; wgid = (xcd < r ? xcd * (q + 1) : r * (q + 1) + (xcd - r) * q) + off; }
        const int nig = WGM * nN, gid = wgid / nig, fm = gid * WGM, gsz = (nM - fm) < WGM ? (nM - fm) : WGM;
        u.pm = fm + ((wgid % nig) % gsz); u.pn = (wgid % nig) / gsz; return true;
    }
    __device__ __forceinline__ void a_ready(const Unit&) const {}
    __device__ __forceinline__ void done(const Unit&) const {}
};

__device__ __forceinline__ unsigned cvt_pk_bf16(float lo, float hi) { unsigned r; asm volatile("v_cvt_pk_bf16_f32 %0, %1, %2" : "=v"(r) : "v"(lo), "v"(hi)); return r; }
typedef float f32x2 __attribute__((ext_vector_type(2)));
template <class Epi, class Sched, bool ALIGN_EPI = false, bool SP2 = false, bool PROBE_EPI = false>
__device__ __forceinline__ void gemm_phase(PG8_LAS unsigned char* lds, const Gemm g, const Sched& S, const Epi& E, unsigned long long& eacc) {
    int tid_o = threadIdx.x; asm volatile("" : "+v"(tid_o));
    const int tid = tid_o, wid = __builtin_amdgcn_readfirstlane(tid >> 6), lane = tid & 63, wr = wid >> 2, wc = wid & 3, fr = lane & 15, fq = lane >> 4;
    const int K = g.K, nt = K / BK;
    unsigned voffA[2], voffB[2];
#pragma unroll
    for (int i = 0; i < 2; ++i) { int R, C; stage_rc(tid * 16 + i * 8192, R, C); const int Rb = Epi::PERM ? ((R & ~31) + perm32(R & 31)) : R;
        voffA[i] = (unsigned)(R * K + C) * 2u; voffB[i] = (unsigned)(Rb * K + C) * 2u; }
    const size_t kstep = (size_t)(BK * 2);
    const size_t hstep = (size_t)HALF * K * 2;
    const size_t tstep = 2 * hstep;
    const unsigned ldsw = (unsigned)wid * 1024u;
    const int aoff = lds_byte(wr * 64 + fr, fq * 8), boff = lds_byte(wc * 32 + fr, fq * 8);
#define PG8_SA(b, h) (((b) * 2 + (h)) * HTB)
#define PG8_SB(b, h) ((4 + (b) * 2 + (h)) * HTB)
#define PG8_STAGE(bufoff, gbase, voff) do { _Pragma("unroll") for (int _i = 0; _i < 2; ++_i) \
        __builtin_amdgcn_global_load_lds((const unsigned*)((const char*)(gbase) + (voff)[_i]), (PG8_LAS unsigned*)(lds + (bufoff) + ldsw + _i * 8192), 16, 0, 0); } while (0)
#define PG8_LDA(dst, b, h) do { _Pragma("unroll") for (int m = 0; m < 4; ++m) _Pragma("unroll") for (int k = 0; k < 2; ++k) dst[m][k] = *(const PG8_LAS bf16x8*)(lds + PG8_SA(b, h) + aoff + m * 2048 + k * 1024); } while (0)
#define PG8_LDB(dst, b, h) do { _Pragma("unroll") for (int n = 0; n < 2; ++n) _Pragma("unroll") for (int k = 0; k < 2; ++k) dst[n][k] = *(const PG8_LAS bf16x8*)(lds + PG8_SB(b, h) + boff + n * 2048 + k * 1024); } while (0)
#define PG8_MMA(ai, bj, At, Bt) do { __builtin_amdgcn_s_setprio(1); _Pragma("unroll") for (int m = 0; m < 4; ++m) _Pragma("unroll") for (int n = 0; n < 2; ++n) _Pragma("unroll") for (int k = 0; k < 2; ++k) \
        acc[ai][bj][m][n] = __builtin_amdgcn_mfma_f32_16x16x32_bf16(Bt[n][k], At[m][k], acc[ai][bj][m][n], 0, 0, 0); __builtin_amdgcn_s_setprio(0); } while (0)
#define PG8_WAIT_V(n) asm volatile("s_waitcnt vmcnt(" #n ")" ::: "memory")
#define PG8_WAIT_L(n) asm volatile("s_waitcnt lgkmcnt(" #n ")" ::: "memory")
#define PG8_BAR __builtin_amdgcn_s_barrier()
#define PG8_SCHED __builtin_amdgcn_sched_barrier(0)
    Unit cur, nxt; int ui = 0;
    if (!S.next(0, cur)) return;
    f32x4 acc[2][2][4][2];
#pragma unroll
    for (int a = 0; a < 2; ++a)
#pragma unroll
        for (int b = 0; b < 2; ++b)
#pragma unroll
            for (int m = 0; m < 4; ++m)
#pragma unroll
                for (int n = 0; n < 2; ++n) acc[a][b][m][n] = (f32x4){0.f, 0.f, 0.f, 0.f};
    bf16x8 At[4][2], B0[2][2], B1[2][2];
    const char* cA = (const char*)g.A + (size_t)cur.pm * tstep; const char* cB = (const char*)g.Bt + (size_t)cur.pn * tstep;
    S.a_ready(cur);
    if constexpr (SP2) {
        PG8_STAGE(PG8_SB(0, 0), cB, voffB); PG8_STAGE(PG8_SB(0, 1), cB + hstep, voffB); PG8_STAGE(PG8_SA(0, 0), cA, voffA); PG8_STAGE(PG8_SA(0, 1), cA + hstep, voffA);
        if (wr == 1) PG8_BAR;
        PG8_WAIT_V(2); PG8_BAR;
        PG8_STAGE(PG8_SB(1, 0), cB + kstep, voffB); PG8_STAGE(PG8_SA(1, 0), cA + kstep, voffA); PG8_STAGE(PG8_SB(1, 1), cB + hstep + kstep, voffB);
        PG8_WAIT_V(6); PG8_BAR;
    } else {
        PG8_STAGE(PG8_SB(0, 0), cB, voffB); PG8_STAGE(PG8_SA(0, 0), cA, voffA); PG8_STAGE(PG8_SB(0, 1), cB + hstep, voffB); PG8_STAGE(PG8_SA(0, 1), cA + hstep, voffA);
        if (wr == 1) PG8_BAR;
        PG8_WAIT_V(4); PG8_BAR;
        PG8_STAGE(PG8_SB(1, 0), cB + kstep, voffB); PG8_STAGE(PG8_SA(1, 0), cA + kstep, voffA); PG8_STAGE(PG8_SB(1, 1), cB + hstep + kstep, voffB);
        PG8_WAIT_V(6); PG8_BAR;
    }
    for (;;) {
        const bool has_next = S.next(ui + 1, nxt);
        const char* nA = has_next ? (const char*)g.A + (size_t)nxt.pm * tstep : cA; const char* nB = has_next ? (const char*)g.Bt + (size_t)nxt.pn * tstep : cB;
        for (int t = 0; t < nt; t += 2) {
            const bool last = (t == nt - 2);
            const char* a1 = cA + (size_t)(t + 1) * kstep;
            const char* a2 = last ? nA : cA + (size_t)(t + 2) * kstep; const char* b2 = last ? nB : cB + (size_t)(t + 2) * kstep;
            const char* a3 = a2 + kstep; const char* b3 = b2 + kstep;
            if (last && has_next) S.a_ready(nxt);
            if constexpr (SP2) {
            PG8_LDB(B0, 0, 0); PG8_LDB(B1, 0, 1); PG8_SCHED; PG8_LDA(At, 0, 0); PG8_STAGE(PG8_SA(1, 1), a1 + hstep, voffA);
            PG8_WAIT_V(8); PG8_WAIT_L(0); PG8_BAR; PG8_MMA(0, 0, At, B0); PG8_MMA(0, 1, At, B1); PG8_BAR; PG8_SCHED;
            PG8_LDA(At, 0, 1); PG8_STAGE(PG8_SB(0, 0), b2, voffB); PG8_STAGE(PG8_SB(0, 1), b2 + hstep, voffB); PG8_STAGE(PG8_SA(0, 0), a2, voffA);
            PG8_WAIT_V(8); PG8_WAIT_L(0); PG8_BAR; PG8_MMA(1, 0, At, B0); PG8_MMA(1, 1, At, B1); PG8_BAR; PG8_SCHED;
            PG8_LDB(B0, 1, 0); PG8_LDB(B1, 1, 1); PG8_SCHED; PG8_LDA(At, 1, 0); PG8_STAGE(PG8_SA(0, 1), a2 + hstep, voffA);
            PG8_WAIT_V(8); PG8_WAIT_L(0); PG8_BAR; PG8_MMA(0, 0, At, B0); PG8_MMA(0, 1, At, B1); PG8_BAR; PG8_SCHED;
            PG8_LDA(At, 1, 1); PG8_STAGE(PG8_SB(1, 0), b3, voffB); PG8_STAGE(PG8_SB(1, 1), b3 + hstep, voffB); PG8_STAGE(PG8_SA(1, 0), a3, voffA);
            PG8_WAIT_V(8); PG8_WAIT_L(0); PG8_BAR; PG8_MMA(1, 0, At, B0); PG8_MMA(1, 1, At, B1); PG8_BAR; PG8_SCHED;
            } else {
            PG8_LDB(B0, 0, 0); PG8_SCHED; PG8_LDA(At, 0, 0); PG8_STAGE(PG8_SA(1, 1), a1 + hstep, voffA);
            PG8_WAIT_L(8); PG8_BAR; PG8_WAIT_L(0); PG8_MMA(0, 0, At, B0); PG8_BAR; PG8_SCHED;
            PG8_LDB(B1, 0, 1); PG8_STAGE(PG8_SB(0, 0), b2, voffB);
            PG8_BAR; PG8_WAIT_L(0); PG8_MMA(0, 1, At, B1); PG8_BAR;
            PG8_LDA(At, 0, 1); PG8_STAGE(PG8_SA(0, 0), a2, voffA);
            PG8_BAR; PG8_WAIT_L(0); PG8_MMA(1, 0, At, B0); PG8_BAR; PG8_SCHED;
            PG8_STAGE(PG8_SB(0, 1), b2 + hstep, voffB);
            PG8_WAIT_V(6); PG8_BAR; PG8_MMA(1, 1, At, B1); PG8_BAR;
            PG8_LDB(B0, 1, 0); PG8_SCHED; PG8_LDA(At, 1, 0); PG8_STAGE(PG8_SA(0, 1), a2 + hstep, voffA);
            PG8_WAIT_L(8); PG8_BAR; PG8_WAIT_L(0); PG8_MMA(0, 0, At, B0); PG8_BAR; PG8_SCHED;
            PG8_LDB(B1, 1, 1); PG8_STAGE(PG8_SB(1, 0), b3, voffB);
            PG8_BAR; PG8_WAIT_L(0); PG8_MMA(0, 1, At, B1); PG8_BAR;
            PG8_LDA(At, 1, 1); PG8_STAGE(PG8_SA(1, 0), a3, voffA);
            PG8_BAR; PG8_WAIT_L(0); PG8_MMA(1, 0, At, B0); PG8_BAR; PG8_SCHED;
            PG8_STAGE(PG8_SB(1, 1), b3 + hstep, voffB);
            PG8_WAIT_V(6); PG8_BAR; PG8_MMA(1, 1, At, B1); PG8_BAR;
            }
        }
        if constexpr (ALIGN_EPI) { if (wr == 0) PG8_BAR; }
        if constexpr (!Epi::AFTER_DRAIN) { unsigned long long t0_ = 0; if constexpr (PROBE_EPI) t0_ = __builtin_amdgcn_s_memrealtime(); E(acc, cur, wr, wc, fr, fq); if constexpr (PROBE_EPI) { asm volatile("s_waitcnt vmcnt(0)" ::: "memory"); eacc += __builtin_amdgcn_s_memrealtime() - t0_; } S.done(cur); }
        if (!has_next) break;
#pragma unroll
        for (int a = 0; a < 2; ++a)
#pragma unroll
            for (int b = 0; b < 2; ++b)
#pragma unroll
                for (int m = 0; m < 4; ++m)
#pragma unroll
                    for (int n = 0; n < 2; ++n) acc[a][b][m][n] = (f32x4){0.f, 0.f, 0.f, 0.f};
        cur = nxt; cA = nA; cB = nB; ++ui;
        if constexpr (ALIGN_EPI) { if (wr == 1) PG8_BAR; }
    }
    PG8_WAIT_V(0);
    if constexpr (!ALIGN_EPI) { if (wr == 0) PG8_BAR; }
    PG8_BAR;
    if constexpr (Epi::AFTER_DRAIN) { E.fused(acc, cur, wr, wc, fr, fq, lds, wid, lane); S.done(cur); }
#undef PG8_SA
#undef PG8_SB
#undef PG8_STAGE
#undef PG8_LDA
#undef PG8_LDB
#undef PG8_MMA
#undef PG8_WAIT_V
#undef PG8_WAIT_L
#undef PG8_BAR
#undef PG8_SCHED
}
}
namespace pg8 {
typedef unsigned u32x2 __attribute__((ext_vector_type(2)));
__device__ __forceinline__ float fsigmoid(float v) { return __builtin_amdgcn_rcpf(1.0f + __expf(-v)); }
__host__ __device__ __forceinline__ int in_tile_sem(int t) { const int m[15] = {7, 8, 10, 2, 0, 9, 11, 3, 4, 1, 5, 6, 12, 13, 14}; int r = 14;
#pragma unroll
    for (int i = 0; i < 15; ++i) r = (t == i) ? m[i] : r;
    return r; }
__host__ __device__ __forceinline__ int in_tile_log(int s) { const int m[15] = {4, 9, 3, 7, 8, 10, 11, 0, 1, 5, 2, 6, 12, 13, 14}; int r = 14;
#pragma unroll
    for (int i = 0; i < 15; ++i) r = (s == i) ? m[i] : r;
    return r; }
struct EpiIn {
    static constexpr bool PERM = true, AFTER_DRAIN = false;
    const float* ssq;
    bf16_t *hq, *hv, *hg, *Q, *Kb, *V; bf16_t* lf; float* lsig;
    const float* lba; const float* lbb;
    int layer; const float* qw; const float* kw; const float* fbias;
    __device__ __forceinline__ void operator()(const f32x4 (&acc)[2][2][4][2], const Unit& u, int wr, int wc, int fr, int fq) const {
        const int pn = in_tile_sem(u.pn), g = pn >> 1, half = pn & 1;
        const int row0 = u.pm * BM + wr * 64 + fr;
        if (pn == 14) {
            if (wc == 0 && fq == 0) {
                const f32x4 b0 = *(const f32x4*)(fbias), b1 = *(const f32x4*)(fbias + 4);
#pragma unroll
                for (int ai = 0; ai < 2; ++ai)
#pragma unroll
                    for (int m = 0; m < 4; ++m) { const int row = row0 + ai * HALF + m * 16; const float rs = rsqrtf(ssq[row] * (1.0f / 1024.0f) + 1e-6f);
                        f32x4 v0 = acc[ai][0][m][0] * rs + b0, v1 = acc[ai][0][m][1] * rs + b1;
#pragma unroll
                        for (int j = 0; j < 4; ++j) { v0[j] = fminf(v0[j], 0.f) - __logf(1.0f + __expf(-fabsf(v0[j]))); v1[j] = fminf(v1[j], 0.f) - __logf(1.0f + __expf(-fabsf(v1[j]))); }
                        *(f32x4*)(lsig + (size_t)row * 8) = v0; *(f32x4*)(lsig + (size_t)row * 8 + 4) = v1; }
            }
            return;
        }
        if (g == 4 || g == 5) {
            bf16_t* dst = (g == 4) ? Q : Kb; const float* nw = (g == 4) ? qw : kw; const float osc = (g == 4) ? 0.125f * 1.4426950408889634f : 1.0f;
            f32x4 w[2][2];
#pragma unroll
            for (int bj = 0; bj < 2; ++bj)
#pragma unroll
                for (int n = 0; n < 2; ++n) w[bj][n] = *(const f32x4*)(nw + 32 * bj + 8 * fq + 4 * n) * osc;
            const int col0 = (half * 4 + wc) * 64 + 8 * fq;
#pragma unroll
            for (int ai = 0; ai < 2; ++ai)
#pragma unroll
                for (int m = 0; m < 4; ++m) { const int row = row0 + ai * HALF + m * 16; const float rs = rsqrtf(ssq[row] * (1.0f / 1024.0f) + 1e-6f);
                    f32x4 v[2][2]; float ss = 0.f;
#pragma unroll
                    for (int bj = 0; bj < 2; ++bj)
#pragma unroll
                        for (int n = 0; n < 2; ++n) { v[bj][n] = acc[ai][bj][m][n] * rs; ss += (v[bj][n][0] * v[bj][n][0] + v[bj][n][1] * v[bj][n][1]) + (v[bj][n][2] * v[bj][n][2] + v[bj][n][3] * v[bj][n][3]); }
                    ss += __shfl_xor(ss, 16); ss += __shfl_xor(ss, 32);
                    const float hr = rsqrtf(ss * (1.0f / 64.0f) + 1e-6f);
#pragma unroll
                    for (int bj = 0; bj < 2; ++bj) { const f32x4 a = v[bj][0] * hr * w[bj][0], b = v[bj][1] * hr * w[bj][1];
                        u32x4 o; o.x = cvt_pk_bf16(a[0], a[1]); o.y = cvt_pk_bf16(a[2], a[3]); o.z = cvt_pk_bf16(b[0], b[1]); o.w = cvt_pk_bf16(b[2], b[3]);
                        *(u32x4*)(dst + (size_t)row * 512 + col0 + 32 * bj) = o; } }
            return;
        }
        const int col0 = half * 256 + wc * 32 + 8 * fq;
        if (g == 1) {
            f32x4 lbv[2][2];
#pragma unroll
            for (int bj = 0; bj < 2; ++bj)
#pragma unroll
                for (int n = 0; n < 2; ++n) { f32x4 t = (f32x4){0.f, 0.f, 0.f, 0.f};
                    if (layer == 1) { const f32x4 a0 = *(const f32x4*)(lba + col0 + 128 * bj + 4 * n), a1 = *(const f32x4*)(lbb + col0 + 128 * bj + 4 * n);
#pragma unroll
                        for (int j = 0; j < 4; ++j) t[j] = fsigmoid(a1[j] - a0[j]); }
                    lbv[bj][n] = t; }
#pragma unroll
            for (int ai = 0; ai < 2; ++ai)
#pragma unroll
                for (int m = 0; m < 4; ++m) { const int row = row0 + ai * HALF + m * 16; const float rs = rsqrtf(ssq[row] * (1.0f / 1024.0f) + 1e-6f);
#pragma unroll
                    for (int bj = 0; bj < 2; ++bj) { f32x4 v[2];
#pragma unroll
                        for (int n = 0; n < 2; ++n) { v[n] = acc[ai][bj][m][n] * rs;
#pragma unroll
                            for (int j = 0; j < 4; ++j) v[n][j] = __logf(lbv[bj][n][j] + (1.0f - lbv[bj][n][j]) * fsigmoid(v[n][j])); }
                        u32x4 o; o.x = cvt_pk_bf16(v[0][0], v[0][1]); o.y = cvt_pk_bf16(v[0][2], v[0][3]); o.z = cvt_pk_bf16(v[1][0], v[1][1]); o.w = cvt_pk_bf16(v[1][2], v[1][3]);
                        *(u32x4*)(lf + (size_t)row * 512 + col0 + 128 * bj) = o; } }
            return;
        }
        bf16_t* dst = (g == 0) ? hq : (g == 2) ? hv : (g == 3) ? hg : V;
        const float sc = (g == 0) ? 0.08838834764831845f : 1.0f;
#pragma unroll
        for (int ai = 0; ai < 2; ++ai)
#pragma unroll
            for (int m = 0; m < 4; ++m) { const int row = row0 + ai * HALF + m * 16; const float rs = rsqrtf(ssq[row] * (1.0f / 1024.0f) + 1e-6f) * sc;
#pragma unroll
                for (int bj = 0; bj < 2; ++bj) { f32x4 a = acc[ai][bj][m][0] * rs, b = acc[ai][bj][m][1] * rs;
                    if (g == 3) {
#pragma unroll
                        for (int j = 0; j < 4; ++j) { a[j] = a[j] * fsigmoid(a[j]); b[j] = b[j] * fsigmoid(b[j]); } }
                    u32x4 o; o.x = cvt_pk_bf16(a[0], a[1]); o.y = cvt_pk_bf16(a[2], a[3]); o.z = cvt_pk_bf16(b[0], b[1]); o.w = cvt_pk_bf16(b[2], b[3]);
                    *(u32x4*)(dst + (size_t)row * 512 + col0 + 128 * bj) = o; } }
    }
};
struct EpiRes {
    static constexpr bool PERM = false, AFTER_DRAIN = false;
    const float* base32; const bf16_t* base16; float* out32; bf16_t* out16; float* ssq;
    __device__ __forceinline__ void operator()(const f32x4 (&acc)[2][2][4][2], const Unit& u, int wr, int wc, int fr, int fq) const {
        const int col0 = u.pn * BM + wc * 32 + 4 * fq;
#pragma unroll
        for (int ai = 0; ai < 2; ++ai)
#pragma unroll
            for (int m = 0; m < 4; ++m) { const int row = u.pm * BM + ai * HALF + wr * 64 + m * 16 + fr; const size_t off = (size_t)row * 1024 + col0; float ss = 0.f;
#pragma unroll
                for (int bj = 0; bj < 2; ++bj)
#pragma unroll
                    for (int n = 0; n < 2; ++n) { const size_t o_ = off + bj * HALF + n * 16; f32x4 b;
                        if (base32) b = *(const f32x4*)(base32 + o_);
                        else { const u32x2 w = *(const u32x2*)(base16 + o_); b = (f32x4){__builtin_bit_cast(float, w.x << 16), __builtin_bit_cast(float, w.x & 0xffff0000u), __builtin_bit_cast(float, w.y << 16), __builtin_bit_cast(float, w.y & 0xffff0000u)}; }
                        const f32x4 o = b + acc[ai][bj][m][n];
                        ss += (o[0] * o[0] + o[1] * o[1]) + (o[2] * o[2] + o[3] * o[3]);
                        if (out32) *(f32x4*)(out32 + o_) = o;
                        else { u32x2 w; w.x = cvt_pk_bf16(o[0], o[1]); w.y = cvt_pk_bf16(o[2], o[3]); *(u32x2*)(out16 + o_) = w; } }
                if (ssq) { ss += __shfl_xor(ss, 16); ss += __shfl_xor(ss, 32); if (fq == 0) unsafeAtomicAdd(ssq + row, ss); } }
    }
};
struct EpiUp {
    static constexpr bool PERM = true, AFTER_DRAIN = false;
    const float* ssq; bf16_t* H;
    __device__ __forceinline__ void operator()(const f32x4 (&acc)[2][2][4][2], const Unit& u, int wr, int wc, int fr, int fq) const {
        const int row0 = u.pm * BM + wr * 64 + fr, col0 = u.pn * BM + wc * 32 + 8 * fq;
#pragma unroll
        for (int ai = 0; ai < 2; ++ai)
#pragma unroll
            for (int m = 0; m < 4; ++m) { const int row = row0 + ai * HALF + m * 16; const float rs = rsqrtf(ssq[row] * (1.0f / 1024.0f) + 1e-6f);
#pragma unroll
                for (int bj = 0; bj < 2; ++bj) { f32x4 a = acc[ai][bj][m][0] * rs, b = acc[ai][bj][m][1] * rs;
#pragma unroll
                    for (int j = 0; j < 4; ++j) { a[j] = fmaxf(a[j], 0.f); a[j] *= a[j]; b[j] = fmaxf(b[j], 0.f); b[j] *= b[j]; }
                    u32x4 o; o.x = cvt_pk_bf16(a[0], a[1]); o.y = cvt_pk_bf16(a[2], a[3]); o.z = cvt_pk_bf16(b[0], b[1]); o.w = cvt_pk_bf16(b[2], b[3]);
                    *(u32x4*)(H + (size_t)row * 4096 + col0 + 128 * bj) = o; } }
    }
};
}
#include <hip/hip_bf16.h>
#include <cmath>
namespace attn_body {
using bf16=__hip_bfloat16;
using bf16x8=__attribute__((ext_vector_type(8)))short;
using s16x4=__attribute__((ext_vector_type(4)))short;
using f32x16=__attribute__((ext_vector_type(16)))float;
using u32x4=__attribute__((ext_vector_type(4)))unsigned;
using f32x4v=__attribute__((ext_vector_type(4)))float;
constexpr int BATCH=2,NHEAD=8,SEQ=8192,D=64,DM=NHEAD*D,ODM=1024;
constexpr int NW=8,QBLK=32,QB=QBLK*NW,KVBLK=64,NQB=SEQ/QB;
constexpr int ATTN_PITCH=DM, ATTN_UNIT_ROWS=QB;
__device__ __forceinline__ int crow(int r,int hi){return (r&3)+8*(r>>2)+4*hi;}
#define SBAR() __builtin_amdgcn_sched_barrier(0)
__device__ __forceinline__ void cmask(f32x16&p0,f32x16&p1,int jb,int qrel,int hi){
  const float NEG=-INFINITY; int kb=64*jb+4*hi;
  #pragma unroll
  for(int r=0;r<16;++r){int kv=kb+(r&3)+8*(r>>2); if(kv>qrel)p0[r]=NEG; if(kv+32>qrel)p1[r]=NEG;}
}

constexpr int NSLOT=3, SLOTB=8192;
constexpr int LDS_K=0, LDS_V=NSLOT*SLOTB, LDS_WS=2*NSLOT*SLOTB, LDS_OST=LDS_WS+NW*64*4, LDS_BYTES=LDS_OST+NW*4096, LDS_DK=86016, LDS_END=LDS_DK+SEQ*4;
constexpr float C2=0.125f*1.4426950408889634f;
__device__ __forceinline__ void glds16(const void*gsrc,unsigned lds_dst){unsigned keep;
  asm volatile("s_mov_b32 %0, m0\n\ts_mov_b32 m0, %2\n\ts_nop 0\n\tglobal_load_lds_dwordx4 %1, off\n\ts_mov_b32 m0, %0":"=&s"(keep):"v"(gsrc),"s"(lds_dst):"memory");}
__device__ __forceinline__ float max3f(float a,float b,float c){float r;asm("v_max3_f32 %0, %1, %2, %3":"=v"(r):"v"(a),"v"(b),"v"(c));return r;}
__device__ __forceinline__ float max2f(float a,float b){float r;asm("v_max_f32_e32 %0, %1, %2":"=v"(r):"v"(a),"v"(b));return r;}
__device__ __forceinline__ float fadd_s(float a,float b){float r;asm("v_add_f32_e32 %0, %1, %2":"=v"(r):"v"(a),"v"(b));return r;}
__device__ __forceinline__ float fsub_s(float a,float b){float r;asm("v_sub_f32_e32 %0, %1, %2":"=v"(r):"v"(a),"v"(b));return r;}
typedef float f32x2_t __attribute__((ext_vector_type(2))); typedef __bf16 bf16x2_t __attribute__((ext_vector_type(2)));
__device__ __forceinline__ unsigned cvtpk_s(float lo,float hi){f32x2_t v={lo,hi};bf16x2_t b=__builtin_convertvector(v,bf16x2_t);return __builtin_bit_cast(unsigned,b);}
#define WAIT_BAR(N) asm volatile("s_waitcnt vmcnt(" #N ") lgkmcnt(0)\n\ts_barrier":::"memory")

__device__ __forceinline__ void qkt(f32x16&p0,f32x16&p1,const char*Kslot,const bf16x8*qr,int r32,int hi){
  const char*kb=Kslot+hi*1024+r32*16;
  #pragma unroll
  for(int d0=0;d0<4;++d0){
    const bf16x8 b0=*reinterpret_cast<const bf16x8*>(kb+d0*2048);
    const bf16x8 b1=*reinterpret_cast<const bf16x8*>(kb+d0*2048+512);
    {p0=__builtin_amdgcn_mfma_f32_32x32x16_bf16(b0,qr[d0],p0,0,0,0);p1=__builtin_amdgcn_mfma_f32_32x32x16_bf16(b1,qr[d0],p1,0,0,0);}}
}
typedef __attribute__((address_space(3))) const char* lds_cptr;
typedef short v4i16_t __attribute__((ext_vector_type(4)));
__device__ __forceinline__ void kload8(bf16x8*kf,lds_cptr kp){
  kf[0]=*(const __attribute__((address_space(3))) bf16x8*)(kp);      kf[1]=*(const __attribute__((address_space(3))) bf16x8*)(kp+512);
  kf[2]=*(const __attribute__((address_space(3))) bf16x8*)(kp+2048); kf[3]=*(const __attribute__((address_space(3))) bf16x8*)(kp+2560);
  kf[4]=*(const __attribute__((address_space(3))) bf16x8*)(kp+4096); kf[5]=*(const __attribute__((address_space(3))) bf16x8*)(kp+4608);
  kf[6]=*(const __attribute__((address_space(3))) bf16x8*)(kp+6144); kf[7]=*(const __attribute__((address_space(3))) bf16x8*)(kp+6656);
}
__device__ __forceinline__ void kload2(bf16x8*kf,lds_cptr kp,int j){ kf[2*j]=*(const __attribute__((address_space(3))) bf16x8*)(kp+j*2048); kf[2*j+1]=*(const __attribute__((address_space(3))) bf16x8*)(kp+j*2048+512); }
__device__ __forceinline__ s16x4 vtr(lds_cptr p){ return __builtin_bit_cast(s16x4,__builtin_amdgcn_ds_read_tr16_b64_v4i16((__attribute__((address_space(3))) v4i16_t*)p)); }
__device__ __forceinline__ float rowmax(const f32x16&p0,const f32x16&p1){
  float a=max3f(p0[0],p0[1],p1[0]),b=max3f(p0[2],p0[3],p1[1]);a=max3f(a,p1[2],p1[3]);
  #pragma unroll
  for(int r=4;r<16;r+=4){a=max3f(a,p0[r],p0[r+1]);b=max3f(b,p0[r+2],p0[r+3]);a=max3f(a,p1[r],p1[r+1]);b=max3f(b,p1[r+2],p1[r+3]);}
  const float m=max2f(a,b);
  auto rr=__builtin_amdgcn_permlane32_swap(__float_as_uint(m),__float_as_uint(m),false,false);
  return max2f(__uint_as_float(rr[0]),__uint_as_float(rr[1]));
}
__device__ __forceinline__ void pv(f32x16*o,int vb,bf16x8 pa0,bf16x8 pa1,bf16x8 pa2,bf16x8 pa3){
  #pragma unroll
  for(int d0=0;d0<2;++d0){s16x4 lo[4],hi[4];
    #pragma unroll
    for(int ks=0;ks<4;++ks){
      asm volatile("ds_read_b64_tr_b16 %0,%1 offset:%c2":"=&v"(lo[ks]):"v"(vb),"i"(d0*4096+ks*1024):"memory");
      asm volatile("ds_read_b64_tr_b16 %0,%1 offset:%c2":"=&v"(hi[ks]):"v"(vb),"i"(d0*4096+ks*1024+512):"memory");}
    asm volatile("s_waitcnt lgkmcnt(0)":::"memory");SBAR();
    #define PK(k) (bf16x8){lo[k][0],lo[k][1],lo[k][2],lo[k][3],hi[k][0],hi[k][1],hi[k][2],hi[k][3]}
    o[d0]=__builtin_amdgcn_mfma_f32_32x32x16_bf16(pa0,PK(0),o[d0],0,0,0);
    o[d0]=__builtin_amdgcn_mfma_f32_32x32x16_bf16(pa1,PK(1),o[d0],0,0,0);
    o[d0]=__builtin_amdgcn_mfma_f32_32x32x16_bf16(pa2,PK(2),o[d0],0,0,0);
    o[d0]=__builtin_amdgcn_mfma_f32_32x32x16_bf16(pa3,PK(3),o[d0],0,0,0);
    #undef PK
  }
}

#ifndef ATTN_STORE16
#define ATTN_STORE16(p,v) (*(u32x4*)(p)=(v))
#endif
template<int THRL> __device__ __forceinline__ void attn_unit(int b,int h,int qb,int NT,const float*dkg,const bf16*Q,const bf16*__restrict__ K,const bf16*__restrict__ V,bf16*O,char*shm){
  int tid_o=threadIdx.x; asm volatile("":"+v"(tid_o));
  const int tid=tid_o,lane=tid&63,r32=lane&31,hi=lane>>5; const int wid=__builtin_amdgcn_readfirstlane(tid>>6);
  const long rowbase=(long)b*SEQ; const int q0=qb*QB;
  const bf16*Qw=Q+(rowbase+q0+wid*QBLK)*DM+h*D;
  const bf16*Kh=K+rowbase*DM+h*D,*Vh=V+rowbase*DM+h*D;
  const unsigned lds0=(unsigned)(uintptr_t)shm;
  float*wsf=(float*)(shm+LDS_WS)+wid*64;
  const bf16*ksrc=Kh+(long)lane*DM+wid*8;
  const bf16*vsrc=Vh+(long)(16*(wid&3)+(lane>>2))*DM+(wid>>2)*32+(lane&3)*8;
  const unsigned kdst=lds0+LDS_K+wid*1024, vdst=lds0+LDS_V+wid*1024;
  #define TA(t) (((t)<4)?(NTA-4+(t)):(NTA-1-(t)))
  #define DMA_K(t,slot) glds16(ksrc+(long)TA(t)*KVBLK*DM,(unsigned)__builtin_amdgcn_readfirstlane(kdst+(slot)))
  #define DMA_V(t,slot) glds16(vsrc+(long)TA(t)*KVBLK*DM,(unsigned)__builtin_amdgcn_readfirstlane(vdst+(slot)))
  const int vb0=(int)(lds0+LDS_V)+((lane>>4)&1)*32+(lane&3)*8+(4*hi+((lane&15)>>2))*64;
  const char*Kbase=shm+LDS_K; bf16x8 kf[8];
  const lds_cptr shm3=(lds_cptr)shm; const lds_cptr kp0=shm3+LDS_K+hi*1024+r32*16; const lds_cptr vp0=shm3+LDS_V+((lane>>4)&1)*32+(lane&3)*8+(4*hi+((lane&15)>>2))*64;
  const int NTA=(q0+QB)/KVBLK;
  typedef __attribute__((address_space(3))) const f32x4v* dk_cptr; const dk_cptr dkp=(dk_cptr)(shm3+LDS_DK+hi*16);
  #define CINIT1(C0,t,o8) do{ const dk_cptr dp_=dkp+TA(t)*16+(o8); _Pragma("unroll") for(int j_=0;j_<4;++j_){ const f32x4v a_=dp_[2*j_]; \
      C0[4*j_]=a_[0]+nmh;C0[4*j_+1]=a_[1]+nmh;C0[4*j_+2]=a_[2]+nmh;C0[4*j_+3]=a_[3]+nmh; } }while(0)
  #define CINIT(C0,C1,t) do{ CINIT1(C0,t,0); SBAR(); CINIT1(C1,t,8); }while(0)
  DMA_K(0,0);DMA_V(0,0);DMA_K(1,SLOTB);
  bf16x8 qr[4];
  #pragma unroll
  for(int d0=0;d0<4;++d0)qr[d0]=*reinterpret_cast<const bf16x8*>(&Qw[(long)r32*DM+d0*16+hi*8]);
  float mhat=0.f,l_reg=0.f,nmh=0.f;f32x16 o[2];o[0]=f32x16{};o[1]=f32x16{};
  const int qrel=wid*QBLK+r32;
  #define CMASK(P0,P1,t) do{int jb_=(t); if(jb_<4)cmask(P0,P1,jb_,qrel,hi);}while(0)
  bool resc=false;
  #define START(P0,P1) do{ const float rm=rowmax(P0,P1); resc=false; \
    { const float dl=rm; mhat=fadd_s(mhat,dl); \
      _Pragma("unroll") for(int r=0;r<16;++r){P0[r]=fsub_s(P0[r],dl);P1[r]=fsub_s(P1[r],dl);} \
      nmh=-mhat; } \
    _Pragma("unroll") for(int r=0;r<16;++r)P0[r]=__builtin_amdgcn_exp2f(P0[r]); }while(0)
  #define RESC() do{ if(resc){ asm volatile("s_waitcnt lgkmcnt(0)":::"memory"); \
      _Pragma("unroll") for(int d_=0;d_<2;++d_) _Pragma("unroll") for(int r=0;r<16;++r)o[d_][r]*=wsf[crow(r,hi)]; } }while(0)
  f32x16 pA0,pA1,pB0,pB1;
  int sl_prev=0,sl_cur=0,sl_next=SLOTB;
  #define ROT() do{sl_prev=sl_cur;sl_cur=sl_next;sl_next=(sl_next==(NSLOT-1)*SLOTB)?0:sl_next+SLOTB;}while(0)
  DMA_K(2,2*SLOTB);
  { typedef __attribute__((address_space(3))) f32x4v* dk_wptr; for(int p=64*(NTA-NT)+4*tid;p<64*NTA;p+=2048) *(dk_wptr)(shm3+LDS_DK+p*4)=*reinterpret_cast<const f32x4v*>(dkg+p); }
  WAIT_BAR(3);
  CINIT(pA0,pA1,0); qkt(pA0,pA1,Kbase,qr,r32,hi);asm volatile("s_nop 15\n\ts_nop 7":"+v"(pA0),"+v"(pA1));CMASK(pA0,pA1,0);
  START(pA0,pA1);
  _Pragma("unroll") for(int r=0;r<16;++r)pA1[r]=__builtin_amdgcn_exp2f(pA1[r]);
  WAIT_BAR(0);
  DMA_K(3,0);DMA_V(1,SLOTB);
  ROT();
  kload8(kf,kp0+sl_cur);
  WAIT_BAR(2);
  s16x4 vlo[8],vhi[8]; u32x4 pw0,pw1,pw2,pw3;
  #define PKW(P,B) cvtpk_s(P[B],P[B+1])
  #define PAF(k) __builtin_bit_cast(bf16x8,pw##k)
  #define VFR(i) (bf16x8){vlo[i][0],vlo[i][1],vlo[i][2],vlo[i][3],vhi[i][0],vhi[i][1],vhi[i][2],vhi[i][3]}
  #define PIN(x) asm volatile("":"+v"(x))
  #define MX3(a,b,c) __builtin_fmaxf(__builtin_fmaxf((a),(b)),(c))
  #define GAPA(MF,A0,A1,A2,A3,W0,W1,PW) do{ MF; sacc+=A0; sacc+=A1; sacc+=A2; sacc+=A3; PIN(sacc); W0; W1; PIN(PW); SBAR(); }while(0)
  #define EX(v) __builtin_amdgcn_exp2f(v)
  #define GAPB(MF,X,B) do{ MF; X[B]=EX(X[B]); X[B+1]=EX(X[B+1]); X[B+2]=EX(X[B+2]); X[B+3]=EX(X[B+3]); PIN(X); SBAR(); }while(0)
  #define VRD(i) do{ vlo[i]=vtr(vp_+(((i)>>2)*4096+((i)&3)*1024)); vhi[i]=vtr(vp_+(((i)>>2)*4096+((i)&3)*1024+512)); }while(0)
  #define KRD(G,j) do{ if(G){ kload2(kf,kp0+sl_next,j); SBAR(); } }while(0)
  #define STEP(C0,C1,P0,P1,t,GK,GV,GL) do{ SBAR(); CINIT(C0,C1,t); SBAR(); \
    const lds_cptr vp_=vp0+sl_prev; \
    VRD(0); SBAR(); float sacc=(P0[0]+P0[1]); \
    GAPA(C0=__builtin_amdgcn_mfma_f32_32x32x16_bf16(kf[0],qr[0],C0,0,0,0), P0[2],P0[3],P0[4],P0[5],     pw0[0]=PKW(P0,0), pw0[1]=PKW(P0,2), pw0); \
    VRD(4); SBAR(); GAPA(C1=__builtin_amdgcn_mfma_f32_32x32x16_bf16(kf[1],qr[0],C1,0,0,0), P0[6],P0[7],P0[8],P0[9],     pw0[2]=PKW(P0,4), pw0[3]=PKW(P0,6), pw0); \
    VRD(1); SBAR(); GAPA(C0=__builtin_amdgcn_mfma_f32_32x32x16_bf16(kf[2],qr[1],C0,0,0,0),   P0[10],P0[11],P0[12],P0[13], pw1[0]=PKW(P0,8), pw1[1]=PKW(P0,10), pw1); \
    VRD(5); SBAR(); GAPA(C1=__builtin_amdgcn_mfma_f32_32x32x16_bf16(kf[3],qr[1],C1,0,0,0),   P0[14],P0[15],P1[0],P1[1],   pw1[2]=PKW(P0,12),pw1[3]=PKW(P0,14), pw1); \
    VRD(2); SBAR(); GAPA(C0=__builtin_amdgcn_mfma_f32_32x32x16_bf16(kf[4],qr[2],C0,0,0,0),   P1[2],P1[3],P1[4],P1[5],     pw2[0]=PKW(P1,0), pw2[1]=PKW(P1,2), pw2); \
    VRD(6); SBAR(); GAPA(C1=__builtin_amdgcn_mfma_f32_32x32x16_bf16(kf[5],qr[2],C1,0,0,0),   P1[6],P1[7],P1[8],P1[9],     pw2[2]=PKW(P1,4), pw2[3]=PKW(P1,6), pw2); \
    VRD(3); SBAR(); GAPA(C0=__builtin_amdgcn_mfma_f32_32x32x16_bf16(kf[6],qr[3],C0,0,0,0),   P1[10],P1[11],P1[12],P1[13], pw3[0]=PKW(P1,8), pw3[1]=PKW(P1,10), pw3); \
    VRD(7); SBAR(); GAPA(C1=__builtin_amdgcn_mfma_f32_32x32x16_bf16(kf[7],qr[3],C1,0,0,0),   P1[14],P1[15],0.f,0.f,       pw3[2]=PKW(P1,12),pw3[3]=PKW(P1,14), pw3); \
    l_reg+=sacc; \
    if(GK){DMA_K((t)+3,sl_cur);} if(GV){DMA_V((t)+1,sl_next);} \
    CMASK(C0,C1,t); \
    { float a=MX3(C0[0],C0[1],C1[0]),b=MX3(C0[2],C0[3],C1[1]); a=MX3(a,C1[2],C1[3]); \
      _Pragma("unroll") for(int r=4;r<16;r+=4){a=MX3(a,C0[r],C0[r+1]);b=MX3(b,C0[r+2],C0[r+3]);a=MX3(a,C1[r],C1[r+1]);b=MX3(b,C1[r+2],C1[r+3]);} \
      float rm=__builtin_fmaxf(a,b); { auto rr=__builtin_amdgcn_permlane32_swap(__float_as_uint(rm),__float_as_uint(rm),false,false); rm=__builtin_fmaxf(__uint_as_float(rr[0]),__uint_as_float(rr[1])); } \
      resc=false; \
      if(__builtin_expect(__any(rm>(float)THRL),0)){ const float dl=__builtin_fmaxf(rm,0.f); mhat+=dl; \
        _Pragma("unroll") for(int r=0;r<16;++r){C0[r]-=dl;C1[r]-=dl;} \
        nmh=-mhat; \
        const float f=__builtin_amdgcn_exp2f(-dl); l_reg*=f; if(hi==0)wsf[r32]=f; resc=true; } } \
    SBAR(); \
    GAPB(o[0]=__builtin_amdgcn_mfma_f32_32x32x16_bf16(PAF(0),VFR(0),o[0],0,0,0), C0,0); \
    GAPB(o[1]=__builtin_amdgcn_mfma_f32_32x32x16_bf16(PAF(0),VFR(4),o[1],0,0,0), C0,4); \
    KRD(GL,0); GAPB(o[0]=__builtin_amdgcn_mfma_f32_32x32x16_bf16(PAF(1),VFR(1),o[0],0,0,0), C0,8); \
    KRD(GL,1); GAPB(o[1]=__builtin_amdgcn_mfma_f32_32x32x16_bf16(PAF(1),VFR(5),o[1],0,0,0), C0,12); \
    KRD(GL,2); GAPB(o[0]=__builtin_amdgcn_mfma_f32_32x32x16_bf16(PAF(2),VFR(2),o[0],0,0,0), C1,0); \
    KRD(GL,3); GAPB(o[1]=__builtin_amdgcn_mfma_f32_32x32x16_bf16(PAF(2),VFR(6),o[1],0,0,0), C1,4); \
    GAPB(o[0]=__builtin_amdgcn_mfma_f32_32x32x16_bf16(PAF(3),VFR(3),o[0],0,0,0), C1,8); \
    GAPB(o[1]=__builtin_amdgcn_mfma_f32_32x32x16_bf16(PAF(3),VFR(7),o[1],0,0,0), C1,12); \
    }while(0)
  int t=1;
  #define ENDW(tt) do{ if((tt)+3<NT){WAIT_BAR(2);} else if((tt)+2<NT){WAIT_BAR(1);} else {WAIT_BAR(0);} }while(0)
  for(;t+1<NT;t+=2){
    STEP(pB0,pB1,pA0,pA1,t,(t+3<NT),(t+1<NT),(t+1<NT));       ENDW(t);   RESC(); ROT();
    STEP(pA0,pA1,pB0,pB1,t+1,(t+4<NT),(t+2<NT),(t+2<NT));     ENDW(t+1); RESC(); ROT();
  }
  STEP(pB0,pB1,pA0,pA1,NT-1,false,false,false); RESC();
  { float sacc=pB0[0]+pB0[1]; _Pragma("unroll") for(int r=2;r<16;++r)sacc+=pB0[r]; _Pragma("unroll") for(int r=0;r<16;++r)sacc+=pB1[r]; l_reg+=sacc;
    pw0=(u32x4){PKW(pB0,0),PKW(pB0,2),PKW(pB0,4),PKW(pB0,6)};pw1=(u32x4){PKW(pB0,8),PKW(pB0,10),PKW(pB0,12),PKW(pB0,14)};pw2=(u32x4){PKW(pB1,0),PKW(pB1,2),PKW(pB1,4),PKW(pB1,6)};pw3=(u32x4){PKW(pB1,8),PKW(pB1,10),PKW(pB1,12),PKW(pB1,14)};
    SBAR(); pv(o,vb0+sl_cur,PAF(0),PAF(1),PAF(2),PAF(3)); }
  #undef PKW
  #undef PAF
  #undef VFR
  #undef PIN
  #undef MX3
  #undef GAPA
  #undef GAPB
  #undef EX
  #undef VRD
  #undef KRD
  #undef STEP
  #undef ENDW
  {auto rr=__builtin_amdgcn_permlane32_swap(__float_as_uint(l_reg),__float_as_uint(l_reg),false,false);l_reg=__uint_as_float(rr[0])+__uint_as_float(rr[1]);}
  if(hi==0)wsf[32+r32]=l_reg;asm volatile("s_waitcnt lgkmcnt(0)":::"memory");
  float rli[16];
  #pragma unroll
  for(int r=0;r<16;++r)rli[r]=__builtin_amdgcn_rcpf(wsf[32+crow(r,hi)]);
  bf16*Ow=O+(rowbase+q0+wid*QBLK)*ODM+h*D;
  { bf16*stg=(bf16*)(shm+LDS_OST)+wid*2048;
    #pragma unroll
    for(int r=0;r<16;++r){const int orow=crow(r,hi);
      #pragma unroll
      for(int d0=0;d0<2;++d0)stg[orow*64+d0*32+r32]=__float2bfloat16(o[d0][r]*rli[r]);}
    asm volatile("s_waitcnt lgkmcnt(0)":::"memory");
    #pragma unroll
    for(int i=0;i<4;++i){const int row=i*8+(lane>>3),ch=lane&7; const u32x4 v=*(const u32x4*)(stg+row*64+ch*8); ATTN_STORE16(Ow+(long)row*ODM+ch*8,v);} }
  asm volatile("s_waitcnt lgkmcnt(0)\n\ts_barrier":::"memory");
  #undef DMA_K
  #undef TA
  #undef CINIT
  #undef CINIT1
  #undef DMA_V
  #undef CMASK
  #undef START
  #undef RESC
  #undef ROT
}
constexpr int ATTN_LDS_BYTES=LDS_END;
#undef SBAR
#undef WAIT_BAR
}
constexpr int NWAVES = 8, NTHREADS = 512;
constexpr int BATCH = 2, T = 8192, D = 1024, FF = 4096, M = BATCH * T, DEPTH = 2;
constexpr int IN_COLS = 3592, NIN = 3840;
constexpr size_t MiB = 1u << 20;
constexpr size_t WS_CTL = 0, CTL_ZERO_BYTES = 1 * MiB;
constexpr size_t WS_SSQ = 64 * 1024;
constexpr size_t WS_LSIG = 512 * 1024;
constexpr size_t WS_WIN = 1 * MiB, WIN_BYTES = (size_t)NIN * D * 2;
constexpr size_t WS_WOUT = 16 * MiB, WS_WUP = 20 * MiB, WS_WDN = 36 * MiB;
constexpr size_t WS_XB = 52 * MiB;
constexpr size_t WS_ST = 84 * MiB;
constexpr size_t WS_HQ = 116 * MiB, WS_LF = 132 * MiB, WS_HV = 164 * MiB, WS_HG = 180 * MiB, WS_Q = 196 * MiB, WS_K = 212 * MiB, WS_V = 228 * MiB, WS_END = 244 * MiB;
constexpr size_t WS_H = 116 * MiB;
constexpr size_t WS_DL = 244 * MiB;
constexpr int LDS_BYTES = 147456;

#define GAS __attribute__((address_space(1)))
#define LAS __attribute__((address_space(3)))
typedef unsigned short bf16;
typedef unsigned v4u __attribute__((ext_vector_type(4)));
typedef float f32x4 __attribute__((ext_vector_type(4)));
typedef float f32x16 __attribute__((ext_vector_type(16)));
typedef short bf16x8 __attribute__((ext_vector_type(8)));
#define LDS_WAIT() asm volatile("s_waitcnt lgkmcnt(0)" ::: "memory")
typedef float f32x2_hw __attribute__((ext_vector_type(2))); typedef __bf16 bf16x2_hw __attribute__((ext_vector_type(2)));
__device__ __forceinline__ unsigned pk2(float lo, float hi) { const f32x2_hw v = {lo, hi}; return __builtin_bit_cast(unsigned, __builtin_convertvector(v, bf16x2_hw)); }
__device__ __forceinline__ unsigned f2bf(float f) { return pk2(f, 0.f) & 0xffffu; }
__device__ __forceinline__ float bf2f(unsigned short b) { return __builtin_bit_cast(float, (unsigned)b << 16); }
__device__ __forceinline__ int crow16(int r, int hi) { return (r & 3) + 8 * (r >> 2) + 4 * hi; }

struct Frame {
    LAS unsigned char* lds; int tid, lane, wave, vcu, G;
};
__device__ __forceinline__ float wave_sum(float v) {
#pragma unroll
    for (int o = 1; o < 64; o <<= 1) v += __shfl_xor(v, o);
    return v;
}
__device__ __forceinline__ void p0_transpose_item(const float* W, int pitch, int K, const float* sc, bf16* WT, int dst_row0, int k0, int n0, LAS float* scr, int lane) {
#pragma unroll 8
    for (int i = 0; i < 32; ++i) { const int kk = 2 * i + (lane >> 5); float v = W[(size_t)(k0 + kk) * pitch + n0 + (lane & 31)]; if (sc) v *= sc[k0 + kk]; scr[kk * 33 + (lane & 31)] = v; }
    LDS_WAIT(); asm volatile("" ::: "memory");
    const int c = lane & 7;
#pragma unroll
    for (int j = 0; j < 4; ++j) { const int n = (lane >> 3) + 8 * j; const LAS float* s = scr + (8 * c) * 33 + n;
        v4u o; o.x = pk2(s[0 * 33], s[1 * 33]); o.y = pk2(s[2 * 33], s[3 * 33]); o.z = pk2(s[4 * 33], s[5 * 33]); o.w = pk2(s[6 * 33], s[7 * 33]);
        *(GAS v4u*)(WT + (size_t)(dst_row0 + n) * K + k0 + 8 * c) = o; }
    LDS_WAIT(); asm volatile("" ::: "memory");
}
__device__ __forceinline__ int map_in_row(int n) {
    const int sem = n >> 8, base = pg8::in_tile_log(sem) * 256;
    if (n < 2048 || n >= 3072) return base + (n & 255);
    const int o = n & 255, wc = o >> 6, w = o & 63, bj = w >> 5, x = w & 31;
    return base + bj * 128 + wc * 32 + x;
}
struct Ptrs {
    const float *x, *lower_bounds, *norm1_w, *w_in, *fox_f_bias, *q_norm_w, *k_norm_w, *hgrn_norm_w, *w_out, *norm2_w, *w_up, *w_down;
    float* out; unsigned char* ws;
};
constexpr int TI_FULL = 12288, TI_VIRT = TI_FULL + 4 * (2 * (16 * 112 + 16 * 32 + 16 * 128 + 64 * 32) - TI_FULL);
struct TItem { const float* W; const float* sc; bf16* WT; int pitch, K, dst_row0, k0, n0, kc; };
__device__ __forceinline__ void titem_decode(const Ptrs& P, int vit, TItem& t) {
    constexpr int I_IN = 16 * 112, I_OUT = 16 * 32, I_UP = 16 * 128, I_DN = 64 * 32, I_L = I_IN + I_OUT + I_UP + I_DN;
    int it = vit, kq = 0, kcnt = 64;
    if (vit >= TI_FULL) { it = TI_FULL + ((vit - TI_FULL) >> 2); kq = (vit - TI_FULL) & 3; kcnt = 16; }
    const int l = it / I_L; int r = it % I_L;
    if (r < I_IN) { const int kb = r / 112, nb = r % 112; t = TItem{P.w_in + (size_t)l * D * IN_COLS, P.norm1_w + l * D, (bf16*)(P.ws + WS_WIN + l * WIN_BYTES), IN_COLS, D, map_in_row(32 * nb), 64 * kb + 16 * kq, 32 * nb, kcnt}; return; } r -= I_IN;
    if (r < I_OUT) { const int kb = r / 32, nb = r % 32; t = TItem{P.w_out + (size_t)l * D * D, nullptr, (bf16*)(P.ws + WS_WOUT + l * 2 * MiB), D, D, 32 * nb, 64 * kb + 16 * kq, 32 * nb, kcnt}; return; } r -= I_OUT;
    if (r < I_UP) { const int kb = r / 128, nb = r % 128; t = TItem{P.w_up + (size_t)l * D * FF, P.norm2_w + l * D, (bf16*)(P.ws + WS_WUP + l * 8 * MiB), FF, D, 32 * nb, 64 * kb + 16 * kq, 32 * nb, kcnt}; return; } r -= I_UP;
    { const int kb = r / 32, nb = r % 32; t = TItem{P.w_down + (size_t)l * FF * D, nullptr, (bf16*)(P.ws + WS_WDN + l * 8 * MiB), D, FF, 32 * nb, 64 * kb + 16 * kq, 32 * nb, kcnt}; }
}
__device__ __forceinline__ void titem_load(const TItem& t, int lane, float (&v)[32], float (&s)[32]) {
#pragma unroll
    for (int i = 0; i < 32; ++i) { const int kk = 2 * i + (lane >> 5); if (2 * i < t.kc) { v[i] = t.W[(size_t)(t.k0 + kk) * t.pitch + t.n0 + (lane & 31)]; s[i] = t.sc ? t.sc[t.k0 + kk] : 1.0f; } else { v[i] = 0.f; s[i] = 0.f; } }
}
__device__ __forceinline__ void titem_store(const TItem& t, LAS float* scr, int lane, const float (&v)[32], const float (&s)[32]) {
#pragma unroll
    for (int i = 0; i < 32; ++i) { const int kk = 2 * i + (lane >> 5); if (2 * i < t.kc) scr[kk * 33 + (lane & 31)] = v[i] * s[i]; }
    LDS_WAIT(); asm volatile("" ::: "memory");
    const int c = lane & 7;
#pragma unroll
    for (int j = 0; j < 4; ++j) { const int n = (lane >> 3) + 8 * j; const LAS float* sp = scr + (8 * c) * 33 + n;
        v4u o; o.x = pk2(sp[0 * 33], sp[1 * 33]); o.y = pk2(sp[2 * 33], sp[3 * 33]); o.z = pk2(sp[4 * 33], sp[5 * 33]); o.w = pk2(sp[6 * 33], sp[7 * 33]);
        if (8 * c < t.kc) *(GAS v4u*)(t.WT + (size_t)(t.dst_row0 + n) * t.K + t.k0 + 8 * c) = o; }
    LDS_WAIT(); asm volatile("" ::: "memory");
}
__device__ __forceinline__ void p0_prologue(Frame& F, const Ptrs& P) {
    LAS float* scr = (LAS float*)(F.lds + F.wave * 16384);
    const int gw = F.vcu * NWAVES + F.wave, NGW = F.G * NWAVES;
    constexpr int I_L = 16 * 112 + 16 * 32 + 16 * 128 + 64 * 32;
    { TItem cur, nxt; float v[32], s[32], nv[32], ns[32]; int it = gw; bool has = it < TI_VIRT;
      if (has) { titem_decode(P, it, cur); titem_load(cur, F.lane, v, s); }
      while (has) { const int itn = it + NGW; const bool hn = itn < TI_VIRT;
          if (hn) { titem_decode(P, itn, nxt); titem_load(nxt, F.lane, nv, ns); }
          titem_store(cur, scr, F.lane, v, s);
          if (hn) { cur = nxt;
#pragma unroll
              for (int i = 0; i < 32; ++i) { v[i] = nv[i]; s[i] = ns[i]; } }
          it = itn; has = hn; } }
    { const int x = gw;
      if (F.lane == 0) for (int e = x; e < DEPTH * 8 * 128; e += NGW) { const int l = e >> 10, j = (e >> 7) & 7, kc = e & 127; float v[8];
#pragma unroll
          for (int i = 0; i < 8; ++i) v[i] = P.w_in[(size_t)l * D * IN_COLS + (size_t)(8 * kc + i) * IN_COLS + 3584 + j] * P.norm1_w[l * D + 8 * kc + i];
          v4u o; o.x = pk2(v[0], v[1]); o.y = pk2(v[2], v[3]); o.z = pk2(v[4], v[5]); o.w = pk2(v[6], v[7]);
          *(GAS v4u*)((bf16*)(P.ws + WS_WIN + l * WIN_BYTES) + (size_t)(3584 + j) * D + 8 * kc) = o; }
      const int gt = F.vcu * NTHREADS + F.tid;
      for (int e = gt; e < DEPTH * 248 * 128; e += F.G * NTHREADS) { const int l = e / (248 * 128), r = e % (248 * 128), j = 8 + (r >> 7), kc = r & 127;
          *(GAS v4u*)((bf16*)(P.ws + WS_WIN + l * WIN_BYTES) + (size_t)(3584 + j) * D + 8 * kc) = (v4u){0u, 0u, 0u, 0u}; } }
    bf16* XB = (bf16*)(P.ws + WS_XB); float* ssq = (float*)(P.ws + WS_SSQ);
    for (int m = gw; m < M; m += 2 * NGW) { const int m2 = m + NGW;
        const GAS f32x4* xr = (const GAS f32x4*)(P.x + (size_t)m * D) + F.lane; const GAS f32x4* xr2 = (const GAS f32x4*)(P.x + (size_t)(m2 < M ? m2 : m) * D) + F.lane; f32x4 v[4], w[4]; float s = 0.f, s2 = 0.f;
#pragma unroll
        for (int j = 0; j < 4; ++j) { v[j] = xr[64 * j]; w[j] = xr2[64 * j]; }
#pragma unroll
        for (int j = 0; j < 4; ++j) { s += (v[j].x * v[j].x + v[j].y * v[j].y) + (v[j].z * v[j].z + v[j].w * v[j].w); s2 += (w[j].x * w[j].x + w[j].y * w[j].y) + (w[j].z * w[j].z + w[j].w * w[j].w); }
        s = wave_sum(s); s2 = wave_sum(s2); if (F.lane == 0) { ssq[m] = s; if (m2 < M) ssq[m2] = s2; }
        GAS unsigned long long* o8 = (GAS unsigned long long*)(XB + (size_t)m * D) + F.lane;
#pragma unroll
        for (int j = 0; j < 4; ++j) o8[64 * j] = (unsigned long long)pk2(v[j].x, v[j].y) | ((unsigned long long)pk2(v[j].z, v[j].w) << 32);
        if (m2 < M) { GAS unsigned long long* p8 = (GAS unsigned long long*)(XB + (size_t)m2 * D) + F.lane;
#pragma unroll
            for (int j = 0; j < 4; ++j) p8[64 * j] = (unsigned long long)pk2(w[j].x, w[j].y) | ((unsigned long long)pk2(w[j].z, w[j].w) << 32); } }
}

constexpr int HC = 64, NCH = T / HC;
constexpr int H_KD = 0, H_QE = 0, H_QM = 17408, H_KM = 34816, H_VT = 52224, H_AM = 70656, H_OS = 79872, H_TOT = 113664, H_BM = 115712;
__device__ __forceinline__ f32x16 mfma32(bf16x8 a, bf16x8 b, f32x16 c) { return __builtin_amdgcn_mfma_f32_32x32x16_bf16(a, b, c, 0, 0, 0); }
#define HBAR() asm volatile("s_waitcnt lgkmcnt(0)\n\ts_barrier" ::: "memory")
#define HGRN_ITEM(it_) const int bh = (it_) >> 7, c = (it_) & 127, b = bh >> 2, h = bh & 3; const int m0 = b * T + c * HC; (void)c; (void)m0;
#define HGRN_LD16F(dst, base) { const float* p_ = (base) + (size_t)(m0 + part * 16) * 512 + h * 128 + k; _Pragma("unroll") for (int i = 0; i < 16; ++i) dst[i] = p_[(size_t)i * 512]; }
#define HGRN_LD16H(dst, base) { const bf16* p_ = (base) + (size_t)(m0 + part * 16) * 512 + h * 128 + k; _Pragma("unroll") for (int i = 0; i < 16; ++i) dst[i] = p_[(size_t)i * 512]; }
#define HGRN_SCAN(lfv, bv, blast)  \
    float bv[16]; float blast, bmid_; { \
      float run = 0.f; _Pragma("unroll") for (int i = 0; i < 16; ++i) { run += lfv[i]; bv[i] = run; } \
      LAS float* TOT = (LAS float*)(F.lds + H_TOT); TOT[part * 128 + k] = run; HBAR(); \
      const float t0 = TOT[k], t1 = TOT[128 + k], t2 = TOT[256 + k], t3 = TOT[384 + k]; \
      const float off = (part > 0 ? t0 : 0.f) + (part > 1 ? t1 : 0.f) + (part > 2 ? t2 : 0.f); blast = (t0 + t1) + (t2 + t3); bmid_ = t0 + t1; \
      _Pragma("unroll") for (int i = 0; i < 16; ++i) bv[i] += off; }
#define HGRN_VT_STORE(vw) { unsigned w_[8]; _Pragma("unroll") for (int i = 0; i < 8; ++i) w_[i] = (unsigned)vw[2 * i] | ((unsigned)vw[2 * i + 1] << 16); \
      LAS v4u* d_ = (LAS v4u*)(F.lds + H_VT + k * 144 + part * 32); d_[0] = (v4u){w_[0], w_[1], w_[2], w_[3]}; d_[1] = (v4u){w_[4], w_[5], w_[6], w_[7]}; }
__device__ __forceinline__ int pa_next(int it, int vcu, int G) {
    if (G != 256) return it + G;
    const int nx = it + 256;
    if (vcu < 16) return (nx >= 512) ? 8 * NCH : nx;
    if (vcu < 48) { if ((it & 255) != vcu) return 8 * NCH;
                    if (nx < 8 * NCH) return nx;
                    return (vcu < 32) ? vcu - 16 + 512 : vcu - 32 + 768; }
    return nx;
}
template <class ScanFn>
__device__ __forceinline__ void hgrn_pass_a(Frame& F, const bf16* lf, const bf16* hv, bf16* ST, float* DL, const ScanFn& scan) {
    const int k = F.tid & 127, part = F.tid >> 7, l31 = F.lane & 31, hi = F.lane >> 5;
    unsigned short nlf[16], nvw[16];
    if (F.vcu < 8 * NCH) { HGRN_ITEM(F.vcu) HGRN_LD16H(nlf, lf) HGRN_LD16H(nvw, hv) }
    scan();
    for (int it = F.vcu; it < 8 * NCH; it = pa_next(it, F.vcu, F.G)) {
        float lfv[16]; unsigned short vw[16];
#pragma unroll
        for (int i = 0; i < 16; ++i) { lfv[i] = bf2f(nlf[i]); vw[i] = nvw[i]; }
        { const int nit = pa_next(it, F.vcu, F.G); if (nit < 8 * NCH) { HGRN_ITEM(nit) HGRN_LD16H(nlf, lf) HGRN_LD16H(nvw, hv) } }
        HGRN_ITEM(it)
        HGRN_SCAN(lfv, bv, blast)
        (void)bmid_;
        { unsigned w_[8];
#pragma unroll
          for (int i = 0; i < 8; ++i) { const float a0 = (1.0f - __expf(lfv[2 * i])) * __expf(blast - bv[2 * i]), a1 = (1.0f - __expf(lfv[2 * i + 1])) * __expf(blast - bv[2 * i + 1]); w_[i] = pk2(a0, a1); }
          LAS v4u* d_ = (LAS v4u*)(F.lds + H_KD + k * 144 + part * 32); d_[0] = (v4u){w_[0], w_[1], w_[2], w_[3]}; d_[1] = (v4u){w_[4], w_[5], w_[6], w_[7]}; }
        if (part == 0) DL[(size_t)it * 128 + k] = __expf(blast);
        HGRN_VT_STORE(vw)
        HBAR();
        const int mt = F.wave >> 1, nt0 = (F.wave & 1) * 2; f32x16 a0 = {}, a1 = {};
#pragma unroll
        for (int ks = 0; ks < 4; ++ks) { const bf16x8 av = *(const LAS bf16x8*)(F.lds + H_VT + (32 * mt + l31) * 144 + (16 * ks + 8 * hi) * 2);
            const bf16x8 b0 = *(const LAS bf16x8*)(F.lds + H_KD + (32 * nt0 + l31) * 144 + (16 * ks + 8 * hi) * 2), b1 = *(const LAS bf16x8*)(F.lds + H_KD + (32 * nt0 + 32 + l31) * 144 + (16 * ks + 8 * hi) * 2);
            a0 = mfma32(av, b0, a0); a1 = mfma32(av, b1, a1); }
        bf16* U = ST + (size_t)it * 16384;
#pragma unroll
        for (int r = 0; r < 16; ++r) { const int v = 32 * mt + crow16(r, hi); U[v * 128 + 32 * nt0 + l31] = (bf16)f2bf(a0[r]); U[v * 128 + 32 * nt0 + 32 + l31] = (bf16)f2bf(a1[r]); }
    }
    HBAR();
}
__device__ __forceinline__ void hgrn_pass_b_item(Frame& F, bf16* ST, const float* DL, int item) {
    int tid_ = F.tid; asm volatile("" : "+v"(tid_));
    const int e = item * NTHREADS + tid_, bh = e >> 14, rem = e & 16383, k = rem & 127;
    bf16* up = ST + (size_t)bh * NCH * 16384 + rem; const float* dp = DL + (size_t)bh * NCH * 128 + k;
    float s = 0.f; unsigned short ua[16], ub[16]; float da[16], db[16];
#define PB_LOAD(u_, d_, c0_) { _Pragma("unroll") for (int j = 0; j < 16; ++j) { u_[j] = up[(size_t)((c0_) + j) * 16384]; d_[j] = dp[((c0_) + j) * 128]; } }
#define PB_PROC(u_, d_, c0_) { _Pragma("unroll") for (int j = 0; j < 16; ++j) { up[(size_t)((c0_) + j) * 16384] = (bf16)f2bf(s); s = d_[j] * s + bf2f(u_[j]); } }
    PB_LOAD(ua, da, 0)
#pragma unroll 1
    for (int c0 = 0; c0 < NCH; c0 += 32) {
        PB_LOAD(ub, db, c0 + 16)
        PB_PROC(ua, da, c0)
        if (c0 + 32 < NCH) PB_LOAD(ua, da, c0 + 32)
        PB_PROC(ub, db, c0 + 16)
    }
#undef PB_LOAD
#undef PB_PROC
}
__device__ __forceinline__ void hgrn_pass_c(Frame& F, const bf16* hq, const bf16* lf, const bf16* hv, const bf16* hg, const bf16* ST, const float* nw, bf16* mix) {
    const int k = F.tid & 127, part = F.tid >> 7, l31 = F.lane & 31, hi = F.lane >> 5;
    const int mt = F.wave >> 2, nt = F.wave & 3; const int t_o = F.tid >> 3, seg_o = F.tid & 7;
#define HGRN_C_LOADS(it_) { HGRN_ITEM(it_) HGRN_LD16H(nlf, lf) HGRN_LD16H(nqw, hq) HGRN_LD16H(nvw, hv) \
      { const bf16* sp = ST + (size_t)(it_) * 16384 + (size_t)(32 * nt + l31) * 128 + 8 * hi; _Pragma("unroll") for (int ks = 0; ks < 8; ++ks) nsf[ks] = *(const bf16x8*)(sp + 16 * ks); } \
      ng0 = *(const v4u*)(hg + (size_t)(m0 + t_o) * 512 + h * 128 + seg_o * 16); ng1 = *(const v4u*)(hg + (size_t)(m0 + t_o) * 512 + h * 128 + seg_o * 16 + 8); }
    unsigned short nlf[16], nqw[16], nvw[16]; bf16x8 nsf[8]; v4u ng0, ng1;
    f32x4 nwv[4];
#pragma unroll
    for (int j = 0; j < 4; ++j) nwv[j] = *(const f32x4*)(nw + seg_o * 16 + 4 * j);
    if (F.vcu < 8 * NCH) HGRN_C_LOADS(F.vcu)
    for (int it = F.vcu; it < 8 * NCH; it += F.G) {
        float lfv[16]; unsigned short qw_[16], vw[16]; bf16x8 sfr[8];
#pragma unroll
        for (int i = 0; i < 16; ++i) { lfv[i] = bf2f(nlf[i]); qw_[i] = nqw[i]; vw[i] = nvw[i]; }
#pragma unroll
        for (int i = 0; i < 8; ++i) sfr[i] = nsf[i];
        const v4u g0 = ng0, g1 = ng1;
        if (it + F.G < 8 * NCH) HGRN_C_LOADS(it + F.G)
        HGRN_ITEM(it)
        HGRN_SCAN(lfv, bv, blast)
        (void)blast;
        const float bm = bmid_;
        {
#pragma unroll
          for (int i = 0; i < 16; ++i) { const int t = part * 16 + i; const float q = bf2f(qw_[i]);
              *(LAS bf16*)(F.lds + H_QE + t * 272 + k * 2) = (bf16)f2bf(q * __expf(bv[i]));
              *(LAS bf16*)(F.lds + H_QM + t * 272 + k * 2) = (bf16)f2bf(q * __expf(fminf(bv[i] - bm, 80.f)));
              *(LAS bf16*)(F.lds + H_KM + t * 272 + k * 2) = (bf16)f2bf((1.0f - __expf(lfv[i])) * __expf(fminf(bm - bv[i], 80.f))); } }
        HGRN_VT_STORE(vw)
        HBAR();
        f32x16 acc = {};
        {
#pragma unroll
          for (int ks = 0; ks < 8; ++ks) { const bf16x8 av = *(const LAS bf16x8*)(F.lds + H_QE + (32 * mt + l31) * 272 + (16 * ks + 8 * hi) * 2); acc = mfma32(av, sfr[ks], acc); } }
        if (F.wave < 4) { const int mt2 = F.wave >> 1, nt2 = F.wave & 1; f32x16 am = {};
#pragma unroll
            for (int ks = 0; ks < 8; ++ks) { const bf16x8 av = *(const LAS bf16x8*)(F.lds + H_QM + (32 * mt2 + l31) * 272 + (16 * ks + 8 * hi) * 2), bvv = *(const LAS bf16x8*)(F.lds + H_KM + (32 * nt2 + l31) * 272 + (16 * ks + 8 * hi) * 2); am = mfma32(av, bvv, am); }
#pragma unroll
            for (int r = 0; r < 16; ++r) { const int t = 32 * mt2 + crow16(r, hi), s = 32 * nt2 + l31; *(LAS bf16*)(F.lds + H_AM + t * 144 + s * 2) = (bf16)f2bf(s <= t ? am[r] : 0.f); } }
        HBAR();
#pragma unroll
        for (int ks = 0; ks < 4; ++ks) { const bf16x8 av = *(const LAS bf16x8*)(F.lds + H_AM + (32 * mt + l31) * 144 + (16 * ks + 8 * hi) * 2), bvv = *(const LAS bf16x8*)(F.lds + H_VT + (32 * nt + l31) * 144 + (16 * ks + 8 * hi) * 2); acc = mfma32(av, bvv, acc); }
#pragma unroll
        for (int r = 0; r < 16; ++r) *(LAS float*)(F.lds + H_OS + (32 * mt + crow16(r, hi)) * 528 + (32 * nt + l31) * 4) = acc[r];
        HBAR();
        { const int t = t_o, seg = seg_o; f32x4 o[4]; float ss = 0.f;
#pragma unroll
          for (int j = 0; j < 4; ++j) { o[j] = *(const LAS f32x4*)(F.lds + H_OS + t * 528 + (seg * 16 + 4 * j) * 4); ss += (o[j][0] * o[j][0] + o[j][1] * o[j][1]) + (o[j][2] * o[j][2] + o[j][3] * o[j][3]); }
          ss += __shfl_xor(ss, 1); ss += __shfl_xor(ss, 2); ss += __shfl_xor(ss, 4);
          const float rs = rsqrtf(ss * (1.0f / 128.0f) + 1e-6f);
          const unsigned gw_[8] = {g0.x, g0.y, g0.z, g0.w, g1.x, g1.y, g1.z, g1.w}; unsigned w_[8];
#pragma unroll
          for (int j = 0; j < 4; ++j) { const f32x4 wv = nwv[j];
              const float e0 = o[j][0] * rs * wv[0] * bf2f((unsigned short)(gw_[2 * j] & 0xffffu)), e1 = o[j][1] * rs * wv[1] * bf2f((unsigned short)(gw_[2 * j] >> 16));
              const float e2 = o[j][2] * rs * wv[2] * bf2f((unsigned short)(gw_[2 * j + 1] & 0xffffu)), e3 = o[j][3] * rs * wv[3] * bf2f((unsigned short)(gw_[2 * j + 1] >> 16));
              w_[2 * j] = pk2(e0, e1); w_[2 * j + 1] = pk2(e2, e3); }
          v4u* op = (v4u*)(mix + (size_t)(m0 + t) * 1024 + h * 128 + seg * 16); op[0] = (v4u){w_[0], w_[1], w_[2], w_[3]}; op[1] = (v4u){w_[4], w_[5], w_[6], w_[7]}; }
    }
    HBAR();
#undef HGRN_C_LOADS
}
#ifndef PROBE_LO
#define PROBE_LO -1
#define PROBE_HI -1
#define PROBE_BLK 0
#endif
#ifndef REP_MASK
#define REP_MASK 0
#endif
#define RLX_AGENT __ATOMIC_RELAXED, __HIP_MEMORY_SCOPE_AGENT
#define XB_TMO      128
#define XB_XCNT(j)  (256  + 64 * (j))
#define XB_XSUB(j)  (1280 + 64 * (j))
#define XB_XGEN(j)  (2304 + 64 * (j))
#define XB_TOP      3328
#define XB_TOPGEN   3392
#define XCD_BAR_WORDS 3456
#define XB_SPIN_CAP (1u << 18)

__device__ __forceinline__ unsigned xb_ld(unsigned* p)              { return __hip_atomic_load(p, __ATOMIC_RELAXED, __HIP_MEMORY_SCOPE_AGENT); }
__device__ __forceinline__ unsigned xb_add(unsigned* p, unsigned v) { return __hip_atomic_fetch_add(p, v, __ATOMIC_RELAXED, __HIP_MEMORY_SCOPE_AGENT); }
__device__ __forceinline__ unsigned xb_xcc_id() { return (unsigned)__builtin_amdgcn_s_getreg((3 << 11) | 20) & 0xFu; }
#define XB_SPIN(cond, bar) do { unsigned _sp = 0; while (cond) { __builtin_amdgcn_s_sleep(1); \
    if ((++_sp & 255u) == 0u) { if (xb_ld(&(bar)[XB_TMO])) break; if (_sp > XB_SPIN_CAP) { atomicAdd(&(bar)[XB_TMO], 1u); break; } } } } while (0)

struct XcdBarrier {
    unsigned* bar; unsigned x;
    volatile LAS unsigned* st;
};

__device__ __forceinline__ XcdBarrier xcd_barrier_post(unsigned* bar, volatile LAS unsigned* st) {
    XcdBarrier b; b.bar = bar; b.x = xb_xcc_id(); b.st = st;
    if (threadIdx.x == 0) (void)xb_add(&bar[XB_XCNT(b.x)], 1u);
    return b;
}
__device__ __forceinline__ void xcd_barrier_complete(unsigned* bar, unsigned x, unsigned& nloc, unsigned& nx) {
    const unsigned G = gridDim.x * gridDim.y * gridDim.z;
    unsigned sum, cnt, mine, sp = 0u;
    for (;;) {
        sum = 0u; cnt = 0u; mine = 0u;
#pragma unroll
        for (unsigned j = 0; j < 16; ++j) { const unsigned c = xb_ld(&bar[XB_XCNT(j)]); sum += c; cnt += (c > 0u) ? 1u : 0u; mine = (j == x) ? c : mine; }
        if (sum == G) break;
        __builtin_amdgcn_s_sleep(1);
        if ((++sp & 255u) == 0u) { if (xb_ld(&bar[XB_TMO])) break; if (sp > XB_SPIN_CAP) { atomicAdd(&bar[XB_TMO], 1u); break; } }
    }
    nloc = mine > 0u ? mine : 1u; nx = cnt > 0u ? cnt : 1u;
}

__device__ __forceinline__ void xcd_barrier(const XcdBarrier& b) {
    asm volatile("s_waitcnt vmcnt(0)" ::: "memory");
    __syncthreads();
    if (threadIdx.x == 0) {
        unsigned* bar = b.bar;
        __builtin_amdgcn_s_waitcnt(0);
        unsigned nloc = b.st[0], nx = b.st[1];
        if (nloc == 0u) { xcd_barrier_complete(bar, b.x, nloc, nx); b.st[0] = nloc; b.st[1] = nx; }
        const unsigned old = xb_add(&bar[XB_XSUB(b.x)], 1u);
        const unsigned gen = old / nloc;
        if (old + 1u == (gen + 1u) * nloc) {
            __builtin_amdgcn_fence(__ATOMIC_RELEASE, "agent");
            asm volatile("s_waitcnt vmcnt(0)" ::: "memory");
            const unsigned og = xb_add(&bar[XB_TOP], 1u);
            const unsigned tg = og / nx;
            if (og + 1u == (tg + 1u) * nx) xb_add(&bar[XB_TOPGEN], 1u);
            else XB_SPIN(xb_ld(&bar[XB_TOPGEN]) == tg, bar);
            __builtin_amdgcn_fence(__ATOMIC_ACQUIRE, "agent");
            xb_add(&bar[XB_XGEN(b.x)], 1u);
            asm volatile("s_waitcnt vmcnt(0)" ::: "memory");
        } else {
            XB_SPIN(xb_ld(&bar[XB_XGEN(b.x)]) == gen, bar);
            __builtin_amdgcn_fence(__ATOMIC_ACQUIRE, "agent");
            asm volatile("s_waitcnt vmcnt(0)" ::: "memory");
        }
    }
    __syncthreads();
}

#ifndef FOX_SKIP
#define FOX_SKIP 1
#endif
__device__ __forceinline__ void fox_scan(Frame& F, const float* lsig, float* DKG, int* NTG, const float* qnw, const float* knw) {
    LAS double* wtot = (LAS double*)(F.lds + attn_body::LDS_WS);
    LAS float* dk = (LAS float*)(F.lds + attn_body::LDS_DK);
    for (int bh = F.vcu; bh < 16; bh += F.G) {
        const int b = bh >> 3, h = bh & 7;
        const float* lp = lsig + ((size_t)b * T + F.tid * 16) * 8 + h; double v[16]; double run = 0.0;
#pragma unroll
        for (int i = 0; i < 16; ++i) { run -= (double)lp[i * 8]; v[i] = run; }
        double inc = run;
#pragma unroll
        for (int o = 1; o < 64; o <<= 1) { const double t = __shfl_up(inc, o); if (F.lane >= o) inc += t; }
        if (F.lane == 63) wtot[F.wave] = inc;
        if (F.wave == 0) { float mq = fabsf(qnw[F.lane]), mk = fabsf(knw[F.lane]);
#pragma unroll
            for (int o = 1; o < 64; o <<= 1) { mq = fmaxf(mq, __shfl_xor(mq, o)); mk = fmaxf(mk, __shfl_xor(mk, o)); }
            if (F.lane == 0) *(LAS float*)(wtot + 8) = 158.0f + 2.0f * 11.66f * mq * mk + 1.0f; }
        __syncthreads();
        double off = inc - run;
        for (int w = 0; w < F.wave; ++w) off += wtot[w];
        f32x4* dst = (f32x4*)(DKG + (size_t)bh * T + F.tid * 16); LAS f32x4* dl = (LAS f32x4*)(dk + F.tid * 16);
#pragma unroll
        for (int i = 0; i < 4; ++i) { const f32x4 o4 = (f32x4){(float)((v[4 * i] + off) * 1.4426950408889634), (float)((v[4 * i + 1] + off) * 1.4426950408889634), (float)((v[4 * i + 2] + off) * 1.4426950408889634), (float)((v[4 * i + 3] + off) * 1.4426950408889634)}; dst[i] = o4; dl[i] = o4; }
        __syncthreads();
        if (F.tid < 32) { const int qb = F.tid, NTA = 4 * qb + 4; int NT = NTA;
            const float TH = *(LAS float*)(wtot + 8);
#if FOX_SKIP
            { const float ref = dk[qb * 256]; int lo = 0, hi_ = NTA - 4;
              while (lo < hi_) { const int mid = (lo + hi_) >> 1; if (dk[64 * mid + 63] - ref < -TH) lo = mid + 1; else hi_ = mid; }
              int nold = (NTA - 4) - lo; nold += (nold & 1); NT = 4 + nold; }
#endif
            (void)TH; NTG[bh * 32 + qb] = NT; }
        __syncthreads();
    }
}
__device__ __forceinline__ void fox_queue_phase(unsigned long long& ts0, unsigned long long& ts1, Frame& F, unsigned char* lds_generic, unsigned* queue, const int* NTG, const float* DKG, const bf16* Q, const bf16* Kb, const bf16* V, bf16* mix, bf16* ST, const float* DL) {
    using attn_body::LDS_DK; using attn_body::attn_unit;
    LAS float* dk = (LAS float*)(F.lds + LDS_DK);
    volatile LAS int* qslot = (volatile LAS int*)(F.lds + 131072 + 128);
    LAS int* cost = (LAS int*)(F.lds + 131072 + 256); LAS int* order = cost + 512;
    if (F.tid == 0) qslot[0] = (int)__hip_atomic_fetch_add(queue, 1u, __ATOMIC_RELAXED, __HIP_MEMORY_SCOPE_AGENT);
    { int tid_ = F.tid; asm volatile("" : "+v"(tid_)); const int mine = NTG[tid_]; cost[tid_] = mine; __syncthreads();
      int rk = 0; typedef int i32x4 __attribute__((ext_vector_type(4)));
#pragma unroll 4
      for (int v = 0; v < 512; v += 4) { const i32x4 c = *(const LAS i32x4*)(cost + v);
          rk += (c.x > mine || (c.x == mine && v < tid_)) ? 1 : 0; rk += (c.y > mine || (c.y == mine && v + 1 < tid_)) ? 1 : 0;
          rk += (c.z > mine || (c.z == mine && v + 2 < tid_)) ? 1 : 0; rk += (c.w > mine || (c.w == mine && v + 3 < tid_)) ? 1 : 0; }
      order[rk] = tid_; }
    __syncthreads();
    for (;;) {
        const int u = qslot[0];
        if (u >= 768) break;
        int nxt = 0;
        if (F.tid == 0) nxt = (int)__hip_atomic_fetch_add(queue, 1u, __ATOMIC_RELAXED, __HIP_MEMORY_SCOPE_AGENT);
        if (u < 512) {
            const int unit = order[u], bh = unit >> 5, qb = unit & 31, b = bh >> 3, h = bh & 7, NT = cost[unit], NTA = 4 * qb + 4;
            if (PROBE_LO == 101) ts0 = __builtin_amdgcn_s_memrealtime();
            attn_unit<8>(b, h, qb, NT, DKG + (size_t)bh * T, (const attn_body::bf16*)Q, (const attn_body::bf16*)Kb, (const attn_body::bf16*)V, (attn_body::bf16*)(mix + 512), (char*)lds_generic);
            if (PROBE_LO == 101) { ts1 = __builtin_amdgcn_s_memrealtime(); ts0 = ts1 - (ts1 - ts0) / (unsigned)NT * 16u; }
        } else {
            if (PROBE_LO == 100) ts0 = __builtin_amdgcn_s_memrealtime();
            hgrn_pass_b_item(F, ST, DL, u - 512);
            if (PROBE_LO == 100) { asm volatile("s_waitcnt vmcnt(0)" ::: "memory"); ts1 = __builtin_amdgcn_s_memrealtime(); }
        }
        __syncthreads();
        if (F.tid == 0) qslot[0] = nxt;
        __syncthreads();
    }
}

struct Args { Ptrs p; int ph_lo, ph_hi; };
constexpr int N_PHASES = 1 + 7 * DEPTH;
__global__ void __launch_bounds__(NTHREADS, 2) hymba_fwd(Args args) {
    extern __shared__ __attribute__((aligned(16))) unsigned char lds[];
    Frame F; F.lds = (LAS unsigned char*)lds; F.tid = threadIdx.x; F.lane = F.tid & 63; F.wave = __builtin_amdgcn_readfirstlane(F.tid >> 6);
    F.G = gridDim.x; { const int bx = blockIdx.x; F.vcu = (F.G % 8 == 0) ? (bx % 8) * (F.G / 8) + bx / 8 : bx; }
    const Ptrs& P = args.p;
    const int lo = args.ph_lo, hi = args.ph_hi;
    volatile LAS unsigned* bst = (volatile LAS unsigned*)(F.lds + 131072 + 64);
    if (F.tid < 2) bst[F.tid] = 0u;
    __syncthreads();
    XcdBarrier bar; bar.bar = (unsigned*)(P.ws + WS_CTL + 16384); bar.x = 0; bar.st = bst;
    if (hi - lo > 1) bar = xcd_barrier_post((unsigned*)(P.ws + WS_CTL + 16384), bst);
#define PHASE_ENV() int t__ = threadIdx.x; asm volatile("" : "+v"(t__)); F.tid = t__; F.lane = t__ & 63; unsigned char* ws = P.ws; asm volatile("" : "+s"(ws)); \
    float* ssq = (float*)(ws + WS_SSQ); float* lsig = (float*)(ws + WS_LSIG); \
    bf16* XB = (bf16*)(ws + WS_XB); bf16* ST = (bf16*)(ws + WS_ST); float* DL = (float*)(ws + WS_DL); float* DKG = (float*)(ws + WS_DL + 512 * 1024); (void)DKG; int* NTGp = (int*)(ws + WS_DL + 1024 * 1024); (void)NTGp; \
    bf16* HQ = (bf16*)(ws + WS_HQ); bf16* LF = (bf16*)(ws + WS_LF); bf16* HV = (bf16*)(ws + WS_HV); bf16* HG = (bf16*)(ws + WS_HG); \
    bf16* Qb = (bf16*)(ws + WS_Q); bf16* Kb = (bf16*)(ws + WS_K); bf16* Vb = (bf16*)(ws + WS_V); bf16* HB = (bf16*)(ws + WS_H); \
    (void)ssq; (void)lsig; (void)XB; (void)ST; (void)DL; (void)HQ; (void)LF; (void)HV; (void)HG; (void)Qb; (void)Kb; (void)Vb; (void)HB;
#define IN(k) (lo <= (k) && (k) < hi)
    unsigned long long ts0 = 0, ts1 = 0;
#define STAMP(k) do { if (PROBE_LO >= 0) { if ((k) == PROBE_LO) ts0 = __builtin_amdgcn_s_memrealtime(); if ((k) == PROBE_HI) ts1 = __builtin_amdgcn_s_memrealtime(); } } while (0)
    STAMP(0);
#define SEAM(k) do { if (IN(k) && IN((k) + 1)) { if (lo == -12345) cg::this_grid().sync(); else { if (PROBE_LO == 110 + (k)) ts0 = __builtin_amdgcn_s_memrealtime(); xcd_barrier(bar); if (PROBE_LO == 110 + (k)) ts1 = __builtin_amdgcn_s_memrealtime(); if (REP_MASK & 64) { xcd_barrier(bar); xcd_barrier(bar); } } } STAMP((k) + 1); } while (0)
    if (IN(0)) { PHASE_ENV() p0_prologue(F, P); if (REP_MASK & 1) { __syncthreads(); p0_prologue(F, P); } }
    SEAM(0);
#pragma unroll 1
    for (int l = 0; l < DEPTH; ++l) {
        const int pb = 1 + 7 * l;
        if (IN(pb)) { PHASE_ENV()
            pg8::Gemm g{l == 0 ? XB : (const bf16*)P.out, (const bf16*)(ws + WS_WIN + l * WIN_BYTES), M, NIN, D}; pg8::StaticOrder S; S.init(M, NIN, F.G, (int)blockIdx.x);
            pg8::EpiIn E{ssq + (size_t)(2 * l) * M, HQ, HV, HG, Qb, Kb, Vb, LF, lsig, P.lower_bounds, P.lower_bounds + 512, l, P.q_norm_w + l * 64, P.k_norm_w + l * 64, P.fox_f_bias + l * 8};
            pg8::gemm_phase<pg8::EpiIn, pg8::StaticOrder, true, true, PROBE_LO == 102>(F.lds, g, S, E, ts1);
            if (REP_MASK & 2) pg8::gemm_phase<pg8::EpiIn, pg8::StaticOrder, true, true>(F.lds, g, S, E, ts1);
        }
        SEAM(pb);
        if (IN(pb + 1)) { PHASE_ENV()
            struct ScanCall { Frame& F; const float* lsig; float* DKG; int* NTG; const float* qw; const float* kw;
                __device__ __forceinline__ void operator()() const { fox_scan(F, lsig, DKG, NTG, qw, kw); } };
            hgrn_pass_a(F, LF, HV, ST, DL, ScanCall{F, lsig, DKG, NTGp, P.q_norm_w + l * 64, P.k_norm_w + l * 64});
        }
        SEAM(pb + 1);
        if (IN(pb + 2)) { PHASE_ENV()
            fox_queue_phase(ts0, ts1, F, lds, (unsigned*)(ws + WS_CTL + 40960) + 64 * l, NTGp, DKG, Qb, Kb, Vb, XB, ST, DL);
        }
        SEAM(pb + 2);
        if (IN(pb + 3)) { PHASE_ENV() hgrn_pass_c(F, HQ, LF, HV, HG, ST, P.hgrn_norm_w + l * 128, XB); if (REP_MASK & 16) hgrn_pass_c(F, HQ, LF, HV, HG, ST, P.hgrn_norm_w + l * 128, XB); }
        SEAM(pb + 3);
        if (IN(pb + 4)) { PHASE_ENV()
            pg8::Gemm g{XB, (const bf16*)(ws + WS_WOUT + l * 2 * MiB), M, D, D}; pg8::StaticOrder S; S.init(M, D, F.G, (int)blockIdx.x);
            bf16* X2 = (bf16*)P.out;
            pg8::EpiRes E{l == 0 ? P.x : nullptr, l == 0 ? nullptr : X2, nullptr, ST, ssq + (size_t)(2 * l + 1) * M};
            pg8::gemm_phase<pg8::EpiRes, pg8::StaticOrder, true, true>(F.lds, g, S, E, ts1);
        }
        SEAM(pb + 4);
        if (IN(pb + 5)) { PHASE_ENV()
            pg8::Gemm g{ST, (const bf16*)(ws + WS_WUP + l * 8 * MiB), M, FF, D}; pg8::StaticOrder S; S.init(M, FF, F.G, (int)blockIdx.x);
            pg8::EpiUp E{ssq + (size_t)(2 * l + 1) * M, HB};
            pg8::gemm_phase<pg8::EpiUp, pg8::StaticOrder, true, true, PROBE_LO == 103>(F.lds, g, S, E, ts1);
            if (REP_MASK & 32) pg8::gemm_phase<pg8::EpiUp, pg8::StaticOrder, true, true>(F.lds, g, S, E, ts1);
        }
        SEAM(pb + 5);
        if (IN(pb + 6)) { PHASE_ENV()
            pg8::Gemm g{HB, (const bf16*)(ws + WS_WDN + l * 8 * MiB), M, D, FF}; pg8::StaticOrder S; S.init(M, D, F.G, (int)blockIdx.x);
            const bool last = (l == DEPTH - 1);
            pg8::EpiRes E{nullptr, ST, last ? P.out : nullptr, last ? nullptr : (bf16*)P.out, last ? nullptr : ssq + (size_t)(2 * l + 2) * M};
            pg8::gemm_phase<pg8::EpiRes, pg8::StaticOrder, true, true>(F.lds, g, S, E, ts1);
        }
        SEAM(pb + 6);
    }
    if (PROBE_LO >= 0 && hi - lo > 1) {
        if (PROBE_HI == N_PHASES) ts1 = __builtin_amdgcn_s_memrealtime();
        xcd_barrier(bar);
        if (blockIdx.x == PROBE_BLK) { int n = (int)((ts1 - ts0) / 10ull); if (n < 0 || n > 100000) n = 100000; for (int i = F.tid; i < n; i += NTHREADS) P.out[i] += 0.125f; }
    }
#undef IN
#undef SEAM
}

#ifndef MK_PER_PHASE
#define MK_PER_PHASE 0
#endif
extern "C" void kernel_launch(void* const* d_in, const int* in_sizes, int n_in, void* d_out, int out_size, void* d_ws, size_t ws_size, hipStream_t stream) {
    static int grid = 0;
    if (grid == 0) {
        if (n_in != 12 || out_size != M * D || ws_size < WS_DL + 2 * MiB) { fprintf(stderr, "kernel_launch: unexpected sizes (n_in %d out %d ws %zu)\n", n_in, out_size, ws_size); grid = -1; return; }
        int dev = 0, cus = 0, per_cu = 0;
        (void)hipGetDevice(&dev); (void)hipDeviceGetAttribute(&cus, hipDeviceAttributeMultiprocessorCount, dev);
        if (hipFuncSetAttribute((const void*)hymba_fwd, hipFuncAttributeMaxDynamicSharedMemorySize, LDS_BYTES) != hipSuccess) { fprintf(stderr, "kernel_launch: hipFuncSetAttribute failed\n"); grid = -1; return; }
        if (hipOccupancyMaxActiveBlocksPerMultiprocessor(&per_cu, (const void*)hymba_fwd, NTHREADS, LDS_BYTES) != hipSuccess || per_cu < 1) { fprintf(stderr, "kernel_launch: occupancy query gave %d\n", per_cu); per_cu = 1; }
        (void)hipGetLastError();
        grid = cus * 1;
        fprintf(stderr, "kernel_launch: cus %d per_cu %d grid %d\n", cus, per_cu, grid);
    }
    if (grid < 0) return;
    (void)hipMemsetAsync((char*)d_ws + WS_CTL, 0, CTL_ZERO_BYTES, stream);
    Args a{};
    a.p.x = (const float*)d_in[0]; a.p.lower_bounds = (const float*)d_in[1]; a.p.norm1_w = (const float*)d_in[2]; a.p.w_in = (const float*)d_in[3];
    a.p.fox_f_bias = (const float*)d_in[4]; a.p.q_norm_w = (const float*)d_in[5]; a.p.k_norm_w = (const float*)d_in[6]; a.p.hgrn_norm_w = (const float*)d_in[7];
    a.p.w_out = (const float*)d_in[8]; a.p.norm2_w = (const float*)d_in[9]; a.p.w_up = (const float*)d_in[10]; a.p.w_down = (const float*)d_in[11];
    a.p.out = (float*)d_out; a.p.ws = (unsigned char*)d_ws;
#if MK_PER_PHASE
    for (int ph = 0; ph < N_PHASES; ++ph) { a.ph_lo = ph; a.ph_hi = ph + 1; hipLaunchKernelGGL(hymba_fwd, dim3(grid), dim3(NTHREADS), LDS_BYTES, stream, a); }
#else
    a.ph_lo = 0; a.ph_hi = N_PHASES;
    void* kargs[] = {&a};
    const hipError_t e = hipLaunchCooperativeKernel((const void*)hymba_fwd, dim3(grid), dim3(NTHREADS), kargs, LDS_BYTES, stream);
    if (e != hipSuccess) fprintf(stderr, "kernel_launch: cooperative launch failed: %s (grid %d)\n", hipGetErrorString(e), grid);
#endif
}
```
